# Optimizing an MI355X kernel written in HIP

```python
import jax, jax.numpy as jnp
from jax import lax
import numpy as np

D_MODEL = 1024
BATCH = 8
SEQ = 2048
DEPTH = 1
DEC_BATCH = 2
DEC_SEQ = 8192
PAST_LEN = 128

HEAD_DIM = 64
N_HEADS = 8
N_KV_HEADS = 2
ATTN_W = N_HEADS * HEAD_DIM
KV_W = N_KV_HEADS * HEAD_DIM
CONV_W = D_MODEL - ATTN_W
CONV_GROUPS = 8
CONV_K = 31
WINDOW = 128
BLOCK = 128
D_FF = 2816
FFN_CONV_K = 3
IN_W = ATTN_W + 2 * KV_W + 2 * CONV_W
NEG_INF = -1e30

kernel_name = "hymba_swa_conformer_convffn_encoder"


def _rms(x, g, eps=1e-6):
    xf = x.astype(jnp.float32)
    y = xf * lax.rsqrt(jnp.mean(xf * xf, axis=-1, keepdims=True) + eps)
    return (y * g.astype(jnp.float32)).astype(x.dtype)


def _layernorm(x, g, b, eps=1e-5):
    xf = x.astype(jnp.float32)
    mu = jnp.mean(xf, axis=-1, keepdims=True)
    var = jnp.mean(jnp.square(xf - mu), axis=-1, keepdims=True)
    y = (xf - mu) * lax.rsqrt(var + eps)
    return (y * g.astype(jnp.float32) + b.astype(jnp.float32)).astype(x.dtype)


def _dwconv(x, w, b):
    K, C = w.shape
    y = lax.conv_general_dilated(
        x, w[:, None, :].astype(x.dtype), window_strides=(1,),
        padding=[(K // 2, K // 2)], dimension_numbers=("NWC", "WIO", "NWC"),
        feature_group_count=C)
    return y + b.astype(x.dtype)


def _alibi_slopes(n):
    return jnp.asarray(np.array([2.0 ** (-8.0 * (h + 1) / n) for h in range(n)], dtype=np.float32))


def _window_attention(q, k, v, sink):
    B, T, H, hd = q.shape
    KVH = k.shape[2]
    G = H // KVH
    nb = T // BLOCK
    qb = q.reshape(B, nb, BLOCK, KVH, G, hd).astype(jnp.float32)

    def band(t):
        tb = t.reshape(B, nb, BLOCK, KVH, hd)
        tp = jnp.pad(tb, ((0, 0), (1, 1), (0, 0), (0, 0), (0, 0)))
        return jnp.concatenate([tp[:, :-2], tp[:, 1:-1], tp[:, 2:]], axis=2)

    kb = band(k).astype(jnp.float32)
    vb = band(v)
    s = jnp.einsum("bnqkgd,bnskd->bnkgqs", qb, kb) * (hd ** -0.5)

    blk = jnp.arange(nb)[:, None]
    qpos = blk * BLOCK + jnp.arange(BLOCK)[None, :]
    kpos = (blk - 1) * BLOCK + jnp.arange(3 * BLOCK)[None, :]
    dist = jnp.abs(qpos[:, :, None] - kpos[:, None, :])
    valid = (dist <= WINDOW) & (kpos[:, None, :] >= 0) & (kpos[:, None, :] < T)
    slopes = _alibi_slopes(H).reshape(KVH, G)
    bias = -slopes[None, :, :, None, None] * dist[:, None, None].astype(jnp.float32)
    s = jnp.where(valid[:, None, None], s + bias[None], NEG_INF)

    sink_col = jnp.broadcast_to(sink.astype(jnp.float32).reshape(1, 1, KVH, G, 1, 1), s.shape[:-1] + (1,))
    p = jax.nn.softmax(jnp.concatenate([s, sink_col], axis=-1), axis=-1)[..., :-1]
    o = jnp.einsum("bnkgqs,bnskd->bnqkgd", p.astype(v.dtype), vb)
    return o.reshape(B, T, H * hd)


def _layer(x, norm1_g, w_in, q_norm_g, k_norm_g, attn_sink, conv_dw_w, conv_dw_b,
           conv_ln_g, conv_ln_b, w_out, norm2_g, ffn_w_gate, ffn_w_up, ffn_dw_w,
           ffn_dw_b, ffn_w_down):
    B, T, _ = x.shape
    h = _rms(x, norm1_g)
    proj = h @ w_in
    q, k, v, c = jnp.split(proj, [ATTN_W, ATTN_W + KV_W, ATTN_W + 2 * KV_W], axis=-1)
    q = _rms(q.reshape(B, T, N_HEADS, HEAD_DIM), q_norm_g)
    k = _rms(k.reshape(B, T, N_KV_HEADS, HEAD_DIM), k_norm_g)
    v = v.reshape(B, T, N_KV_HEADS, HEAD_DIM)
    attn = _window_attention(q, k, v, attn_sink)
    a, gate = jnp.split(c, 2, axis=-1)
    u = a * jax.nn.sigmoid(gate)
    u = _dwconv(u, conv_dw_w, conv_dw_b)
    u = jax.nn.silu(_layernorm(u, conv_ln_g, conv_ln_b))
    x = x + jnp.concatenate([attn, u], axis=-1) @ w_out
    h2 = _rms(x, norm2_g)
    g = jax.nn.silu(_dwconv(h2 @ ffn_w_gate, ffn_dw_w, ffn_dw_b))
    x = x + (g * (h2 @ ffn_w_up)) @ ffn_w_down
    return x


def _trunk(x, norm1_g, w_in, q_norm_g, k_norm_g, attn_sink, conv_dw_w, conv_dw_b,
           conv_ln_g, conv_ln_b, w_out, norm2_g, ffn_w_gate, ffn_w_up, ffn_dw_w,
           ffn_dw_b, ffn_w_down):
    for l in range(DEPTH):
        x = _layer(x, norm1_g[l], w_in[l], q_norm_g[l], k_norm_g[l], attn_sink[l],
                   conv_dw_w[l], conv_dw_b[l], conv_ln_g[l], conv_ln_b[l], w_out[l],
                   norm2_g[l], ffn_w_gate[l], ffn_w_up[l], ffn_dw_w[l], ffn_dw_b[l],
                   ffn_w_down[l])
    return x


def setup_inputs(seed: int = 0) -> dict:
    key = jax.random.key(seed)
    ks = jax.random.split(key, 20)
    f32 = jnp.float32
    nrm = lambda k, shape, s: jax.random.normal(k, shape, dtype=f32) * s
    L = DEPTH
    return {
        "x_prompt": nrm(ks[0], (BATCH, SEQ, D_MODEL), 1.0),
        "x_sample": nrm(ks[1], (DEC_BATCH, DEC_SEQ, D_MODEL), 1.0),
        "norm1_g": 1.0 + nrm(ks[2], (L, D_MODEL), 0.02),
        "w_in": nrm(ks[3], (L, D_MODEL, IN_W), D_MODEL ** -0.5),
        "q_norm_g": 1.0 + nrm(ks[4], (L, HEAD_DIM), 0.02),
        "k_norm_g": 1.0 + nrm(ks[5], (L, HEAD_DIM), 0.02),
        "attn_sink": nrm(ks[6], (L, N_HEADS), 0.5),
        "conv_dw_w": nrm(ks[7], (L, CONV_K, CONV_W), CONV_K ** -0.5),
        "conv_dw_b": nrm(ks[8], (L, CONV_W), 0.02),
        "conv_ln_g": 1.0 + nrm(ks[9], (L, CONV_W), 0.02),
        "conv_ln_b": nrm(ks[10], (L, CONV_W), 0.02),
        "w_out": nrm(ks[11], (L, D_MODEL, D_MODEL), D_MODEL ** -0.5),
        "norm2_g": 1.0 + nrm(ks[12], (L, D_MODEL), 0.02),
        "ffn_w_gate": nrm(ks[13], (L, D_MODEL, D_FF), D_MODEL ** -0.5),
        "ffn_w_up": nrm(ks[14], (L, D_MODEL, D_FF), D_MODEL ** -0.5),
        "ffn_dw_w": nrm(ks[15], (L, FFN_CONV_K, D_FF), FFN_CONV_K ** -0.5),
        "ffn_dw_b": nrm(ks[16], (L, D_FF), 0.02),
        "ffn_w_down": nrm(ks[17], (L, D_FF, D_MODEL), D_FF ** -0.5),
    }


def reference(x_prompt, x_sample, norm1_g, w_in, q_norm_g, k_norm_g, attn_sink, conv_dw_w,
              conv_dw_b, conv_ln_g, conv_ln_b, w_out, norm2_g, ffn_w_gate, ffn_w_up,
              ffn_dw_w, ffn_dw_b, ffn_w_down):
    y_prompt = _trunk(x_prompt, norm1_g, w_in, q_norm_g, k_norm_g, attn_sink, conv_dw_w,
                      conv_dw_b, conv_ln_g, conv_ln_b, w_out, norm2_g, ffn_w_gate, ffn_w_up,
                      ffn_dw_w, ffn_dw_b, ffn_w_down)
    y_sample = _trunk(x_sample, norm1_g, w_in, q_norm_g, k_norm_g, attn_sink, conv_dw_w,
                      conv_dw_b, conv_ln_g, conv_ln_b, w_out, norm2_g, ffn_w_gate, ffn_w_up,
                      ffn_dw_w, ffn_dw_b, ffn_w_down)
    return (y_prompt, y_sample)
```

```cpp
#include <hip/hip_runtime.h>
#include <hip/hip_cooperative_groups.h>
#include <cstdio>
#include <cstdint>
namespace cg = cooperative_groups;
namespace pg8 {
#define PG8_LAS __attribute__((address_space(3)))
typedef unsigned short bf16_t;
typedef short bf16x8 __attribute__((ext_vector_type(8)));
typedef float f32x4 __attribute__((ext_vector_type(4)));
typedef unsigned u32x4 __attribute__((ext_vector_type(4)));
constexpr int BM = 256, BK = 64, HALF = 128, HTB = HALF * BK * 2  , STAGE_BYTES = 8 * HTB, NXCD = 8, WGM = 8;

__host__ __device__ __forceinline__ int lds_byte(int r, int c) { const int st = (r >> 4) * 2 + (c >> 5), rr = r & 15, cc = c & 31, ob = rr * 64 + cc * 2; return st * 1024 + (ob ^ (((ob >> 9) & 1) << 5)); }
__host__ __device__ __forceinline__ void stage_rc(int b, int& R, int& C) { const int st = b / 1024, sb = b % 1024, swz = sb ^ (((sb >> 9) & 1) << 5); R = (st >> 1) * 16 + swz / 64; C = (st & 1) * 32 + (swz % 64) / 2; }
__host__ __device__ __forceinline__ int perm32(int rho) { const int n = rho >> 4, i = rho & 15; return 8 * (i >> 2) + 4 * n + (i & 3); }

struct Unit { int pm, pn; };
struct Gemm { const bf16_t* A; const bf16_t* Bt; int M, N, K; };

struct StaticOrder {
    int nM, nN, nwg, G, c;
    __host__ __device__ void init(int M, int N, int G_, int c_) { nM = M / BM; nN = N / BM; nwg = nM * nN; G = G_; c = c_; }
    __host__ __device__ bool next(int i, Unit& u) const {
        const long L = (long)i * G + c; if (L >= nwg) return false;
        int wgid = (int)L; { const int q = nwg / NXCD, r = nwg % NXCD, xcd = wgid % NXCD, off = wgid / NXCD; wgid = (xcd < r ? xcd * (q + 1) : r * (q + 1) + (xcd - r) * q) + off; }
        const int nig = WGM * nN, gid = wgid / nig, fm = gid * WGM, gsz = (nM - fm) < WGM ? (nM - fm) : WGM;
        u.pm = fm + ((wgid % nig) % gsz); u.pn = (wgid % nig) / gsz; return true;
    }
    __device__ __forceinline__ void a_ready(const Unit&) const {}
    __device__ __forceinline__ void done(const Unit&) const {}
};

__device__ __forceinline__ unsigned cvt_pk_bf16(float lo, float hi) { unsigned r; asm volatile("v_cvt_pk_bf16_f32 %0, %1, %2" : "=v"(r) : "v"(lo), "v"(hi)); return r; }
typedef float f32x2 __attribute__((ext_vector_type(2)));
constexpr int M_TOK = 32768, DM = 1024, M_PROMPT = 16384, T_PROMPT = 2048, T_SAMPLE = 8192, DFF = 2816;
constexpr float LOG2E = 1.4426950408889634f;
constexpr float QSCALE = 0.125f * LOG2E;
__device__ __forceinline__ void seq_bounds(int row, int& s0, int& s1) {
    if (row < M_PROMPT) { s0 = row & ~(T_PROMPT - 1); s1 = s0 + T_PROMPT; }
    else { s0 = M_PROMPT + ((row - M_PROMPT) & ~(T_SAMPLE - 1)); s1 = s0 + T_SAMPLE; }
}
__device__ __forceinline__ float fast_sigmoid(float v) { return __builtin_amdgcn_rcpf(1.0f + __builtin_amdgcn_exp2f(-LOG2E * v)); }
__device__ __forceinline__ float fast_silu(float v) { return v * fast_sigmoid(v); }

struct EpiInProj {
    static constexpr bool PERM = true, AFTER_DRAIN = false;
    bf16_t* Q; bf16_t* Kb; bf16_t* VT; bf16_t* U; const float* gq; const float* gk;
    __device__ __forceinline__ void operator()(f32x4 (&acc)[2][2][4][2], const Unit& u, int wr, int wc, int fr, int fq) const {
        asm volatile("" : "+v"(fr), "+v"(fq));
        const int row0 = u.pm * BM + wr * 64 + fr;
        if (u.pn < 3) {
            const bool isq = u.pn < 2, isk = (u.pn == 2) && (wc < 2);
            if (isq || isk) {
                const float* g = isq ? gq : gk; const float sc = isq ? QSCALE : 1.0f;
                f32x4 gv[2][2];
#pragma unroll
                for (int bj = 0; bj < 2; ++bj)
#pragma unroll
                    for (int n = 0; n < 2; ++n) gv[bj][n] = *(const f32x4*)(g + 32 * bj + 8 * fq + 4 * n) * sc;
                bf16_t* dst = isq ? (Q + (size_t)(u.pn * 4 + wc) * 64) : (Kb + (size_t)wc * 64);
                const int pitch = isq ? 512 : 128;
#pragma unroll
                for (int ai = 0; ai < 2; ++ai)
#pragma unroll
                    for (int m = 0; m < 4; ++m) {
                        float s = 0.f;
#pragma unroll
                        for (int bj = 0; bj < 2; ++bj)
#pragma unroll
                            for (int n = 0; n < 2; ++n) { const f32x4 x = acc[ai][bj][m][n]; s += (x[0] * x[0] + x[1] * x[1]) + (x[2] * x[2] + x[3] * x[3]); }
                        s += __shfl_xor(s, 16); s += __shfl_xor(s, 32);
                        const float rs = __builtin_amdgcn_rsqf(s * (1.0f / 64.0f) + 1e-6f);
                        bf16_t* rowp = dst + (size_t)(row0 + ai * HALF + m * 16) * pitch + 8 * fq;
#pragma unroll
                        for (int bj = 0; bj < 2; ++bj) {
                            const f32x4 v0 = acc[ai][bj][m][0] * rs * gv[bj][0], v1 = acc[ai][bj][m][1] * rs * gv[bj][1];
                            u32x4 w; w.x = cvt_pk_bf16(v0[0], v0[1]); w.y = cvt_pk_bf16(v0[2], v0[3]); w.z = cvt_pk_bf16(v1[0], v1[1]); w.w = cvt_pk_bf16(v1[2], v1[3]);
                            *(u32x4*)(rowp + 32 * bj) = w;
                        }
                    }
            } else {
                bf16_t* vt = VT + (size_t)(wc - 2) * 64 * M_TOK;
#pragma unroll
                for (int ai = 0; ai < 2; ++ai)
#pragma unroll
                    for (int m = 0; m < 4; ++m) {
                        const int row = row0 + ai * HALF + m * 16;
#pragma unroll
                        for (int bj = 0; bj < 2; ++bj)
#pragma unroll
                            for (int n = 0; n < 2; ++n) {
                                const f32x4 x = acc[ai][bj][m][n]; const int d0 = 32 * bj + 8 * fq + 4 * n;
                                const unsigned p01 = cvt_pk_bf16(x[0], x[1]), p23 = cvt_pk_bf16(x[2], x[3]);
                                vt[(size_t)(d0 + 0) * M_TOK + row] = (bf16_t)(p01 & 0xffffu); vt[(size_t)(d0 + 1) * M_TOK + row] = (bf16_t)(p01 >> 16);
                                vt[(size_t)(d0 + 2) * M_TOK + row] = (bf16_t)(p23 & 0xffffu); vt[(size_t)(d0 + 3) * M_TOK + row] = (bf16_t)(p23 >> 16);
                            }
                    }
            }
        } else {
            bf16_t* dst = U + (size_t)(u.pn - 3) * 128 + 32 * wc + 8 * fq;
#pragma unroll
            for (int ai = 0; ai < 2; ++ai)
#pragma unroll
                for (int m = 0; m < 4; ++m) {
                    f32x4 o[2];
#pragma unroll
                    for (int n = 0; n < 2; ++n) { const f32x4 a = acc[ai][0][m][n], g = acc[ai][1][m][n];
#pragma unroll
                        for (int j = 0; j < 4; ++j) o[n][j] = a[j] * fast_sigmoid(g[j]); }
                    u32x4 w; w.x = cvt_pk_bf16(o[0][0], o[0][1]); w.y = cvt_pk_bf16(o[0][2], o[0][3]); w.z = cvt_pk_bf16(o[1][0], o[1][1]); w.w = cvt_pk_bf16(o[1][2], o[1][3]);
                    *(u32x4*)(dst + (size_t)(row0 + ai * HALF + m * 16) * 512) = w;
                }
        }
    }
};

struct EpiOutProj {
    static constexpr bool PERM = false, AFTER_DRAIN = false;
    const float* xp; const float* xs; float* out; bf16_t* x1b; float* ssq; PG8_LAS float* red;
    __device__ __forceinline__ void operator()(f32x4 (&acc)[2][2][4][2], const Unit& u, int wr, int wc, int fr, int fq) const {
        asm volatile("" : "+v"(fr), "+v"(fq));
        const int row0 = u.pm * BM + wr * 64 + fr, col0 = u.pn * BM + wc * 32 + 4 * fq;
        const float* xb = (u.pm * BM < M_PROMPT) ? xp : (xs - (size_t)M_PROMPT * DM);
#pragma unroll
        for (int ai = 0; ai < 2; ++ai)
#pragma unroll
            for (int m = 0; m < 4; ++m) {
                const int row = row0 + ai * HALF + m * 16; const size_t ro = (size_t)row * DM + col0; float s = 0.f;
#pragma unroll
                for (int bj = 0; bj < 2; ++bj)
#pragma unroll
                    for (int n = 0; n < 2; ++n) {
                        const f32x4 v = acc[ai][bj][m][n] + *(const f32x4*)(xb + ro + bj * HALF + n * 16);
                        *(f32x4*)(out + ro + bj * HALF + n * 16) = v;
                        s += (v[0] * v[0] + v[1] * v[1]) + (v[2] * v[2] + v[3] * v[3]);
                        uint2 w; w.x = cvt_pk_bf16(v[0], v[1]); w.y = cvt_pk_bf16(v[2], v[3]);
                        *(uint2*)(x1b + ro + bj * HALF + n * 16) = w;
                    }
                s += __shfl_xor(s, 16); s += __shfl_xor(s, 32);
                if (fq == 0) red[(ai * HALF + wr * 64 + m * 16 + fr) * 4 + wc] = s;
            }
        __syncthreads();
        const int t = threadIdx.x;
        if (t < 256) { const f32x4 v = *(const PG8_LAS f32x4*)(red + t * 4); ssq[(size_t)(u.pm * BM + t) * 4 + u.pn] = (v[0] + v[1]) + (v[2] + v[3]); }
    }
};

struct EpiGateUp {
    static constexpr bool PERM = true, AFTER_DRAIN = false;
    bf16_t* act; float* ge; float* ue; const float* ssq; const float* cw; const float* cb; int ncols, chbase;
    __device__ __forceinline__ void operator()(f32x4 (&acc)[2][2][4][2], const Unit& u, int wr, int wc, int fr, int fq) const {
        asm volatile("" : "+v"(fr), "+v"(fq));
        const int lane = fr + 16 * fq;
        const int ch0 = u.pn * 128 + 32 * wc + 8 * fq;
        const int lprev = (lane & 48) | ((fr + 15) & 15), lnext = (lane & 48) | ((fr + 1) & 15);
#pragma unroll
        for (int ai = 0; ai < 2; ++ai) {
            const int crow0 = u.pm * BM + ai * HALF + wr * 64;
            const int chunk = crow0 >> 6;
#pragma unroll
            for (int m = 0; m < 4; ++m) {
                const f32x4 a = *(const f32x4*)(ssq + (size_t)(crow0 + m * 16 + fr) * 4);
                const float t = (a[0] + a[1]) + (a[2] + a[3]);
                const float rstd = __builtin_amdgcn_rsqf(t * (1.0f / 1024.0f) + 1e-6f);
#pragma unroll
                for (int n = 0; n < 2; ++n) { acc[ai][0][m][n] *= rstd; acc[ai][1][m][n] *= rstd; }
            }
            if (fr < 2) {
                float* g = ge + ((size_t)chunk * 4 + fr) * ncols + ch0;
                *(f32x4*)g = acc[ai][0][0][0]; *(f32x4*)(g + 4) = acc[ai][0][0][1];
                if (fr == 0) { float* q = ue + ((size_t)chunk * 2) * ncols + ch0; *(f32x4*)q = acc[ai][1][0][0]; *(f32x4*)(q + 4) = acc[ai][1][0][1]; }
            }
            if (fr >= 14) {
                float* g = ge + ((size_t)chunk * 4 + (fr - 12)) * ncols + ch0;
                *(f32x4*)g = acc[ai][0][3][0]; *(f32x4*)(g + 4) = acc[ai][0][3][1];
                if (fr == 15) { float* q = ue + ((size_t)chunk * 2 + 1) * ncols + ch0; *(f32x4*)q = acc[ai][1][3][0]; *(f32x4*)(q + 4) = acc[ai][1][3][1]; }
            }
        }
#pragma unroll
        for (int n = 0; n < 2; ++n) {
            const int gc = chbase + ch0 + 4 * n;
            const f32x4 w0 = *(const f32x4*)(cw + gc), w1 = *(const f32x4*)(cw + DFF + gc), w2 = *(const f32x4*)(cw + 2 * DFF + gc), bb = *(const f32x4*)(cb + gc);
#pragma unroll
            for (int ai = 0; ai < 2; ++ai) {
                const int crow0 = u.pm * BM + ai * HALF + wr * 64;
                float o[4][4];
#pragma unroll
                for (int j = 0; j < 4; ++j) {
                    float R[4], L[4];
#pragma unroll
                    for (int m = 0; m < 4; ++m) { R[m] = __shfl(acc[ai][0][m][n][j], lprev); L[m] = __shfl(acc[ai][0][m][n][j], lnext); }
#pragma unroll
                    for (int m = 0; m < 4; ++m) {
                        const float pv = (m > 0 && fr == 0) ? R[m > 0 ? m - 1 : 0] : R[m];
                        const float nx = (m < 3 && fr == 15) ? L[m < 3 ? m + 1 : 3] : L[m];
                        const float cv = bb[j] + w0[j] * pv + w1[j] * acc[ai][0][m][n][j] + w2[j] * nx;
                        o[m][j] = fast_silu(cv) * acc[ai][1][m][n][j];
                    }
                }
#pragma unroll
                for (int m = 0; m < 4; ++m) {
                    const bool edge = (m == 0 && fr == 0) || (m == 3 && fr == 15);
                    if (!edge) { uint2 w; w.x = cvt_pk_bf16(o[m][0], o[m][1]); w.y = cvt_pk_bf16(o[m][2], o[m][3]);
                        *(uint2*)(act + (size_t)(crow0 + m * 16 + fr) * ncols + ch0 + 4 * n) = w; }
                }
                __builtin_amdgcn_sched_barrier(0);
            }
        }
    }
};

struct EpiDown {
    static constexpr bool PERM = false, AFTER_DRAIN = false;
    float* out;
    __device__ __forceinline__ void operator()(f32x4 (&acc)[2][2][4][2], const Unit& u, int wr, int wc, int fr, int fq) const {
        asm volatile("" : "+v"(fr), "+v"(fq));
        const int row0 = u.pm * BM + wr * 64 + fr, col0 = u.pn * BM + wc * 32 + 4 * fq;
#pragma unroll
        for (int ai = 0; ai < 2; ++ai)
#pragma unroll
            for (int m = 0; m < 4; ++m) { float* rowp = out + (size_t)(row0 + ai * HALF + m * 16) * DM + col0;
#pragma unroll
                for (int bj = 0; bj < 2; ++bj)
#pragma unroll
                    for (int n = 0; n < 2; ++n) { f32x4* p = (f32x4*)(rowp + bj * HALF + n * 16); *p = *p + acc[ai][bj][m][n]; } }
    }
};
template <class Epi, class Sched, bool ALIGN_EPI = false, bool SP2 = false>
__device__ __forceinline__ void gemm_phase(PG8_LAS unsigned char* lds, const Gemm g, const Sched& S, const Epi& E) {
    const int tid = threadIdx.x, wid = __builtin_amdgcn_readfirstlane(tid >> 6), lane = tid & 63, wr = wid >> 2, wc = wid & 3, fr = lane & 15, fq = lane >> 4;
    const int K = g.K, nt = K / BK;
    unsigned voffA[2], voffB[2];
#pragma unroll
    for (int i = 0; i < 2; ++i) { int R, C; stage_rc(tid * 16 + i * 8192, R, C); const int Rb = Epi::PERM ? ((R & ~31) + perm32(R & 31)) : R;
        voffA[i] = (unsigned)(R * K + C) * 2u; voffB[i] = (unsigned)(Rb * K + C) * 2u; }
    const size_t kstep = (size_t)(BK * 2);
    const size_t hstep = (size_t)HALF * K * 2;
    const size_t tstep = 2 * hstep;
    const unsigned ldsw = (unsigned)wid * 1024u;
    const int aoff = lds_byte(wr * 64 + fr, fq * 8), boff = lds_byte(wc * 32 + fr, fq * 8);
#define PG8_SA(b, h) (((b) * 2 + (h)) * HTB)
#define PG8_SB(b, h) ((4 + (b) * 2 + (h)) * HTB)
#define PG8_STAGE(bufoff, gbase, voff) do { _Pragma("unroll") for (int _i = 0; _i < 2; ++_i) \
        __builtin_amdgcn_global_load_lds((const unsigned*)((const char*)(gbase) + (voff)[_i]), (PG8_LAS unsigned*)(lds + (bufoff) + ldsw + _i * 8192), 16, 0, 0); } while (0)
#define PG8_LDA(dst, b, h) do { _Pragma("unroll") for (int m = 0; m < 4; ++m) _Pragma("unroll") for (int k = 0; k < 2; ++k) dst[m][k] = *(const PG8_LAS bf16x8*)(lds + PG8_SA(b, h) + aoff + m * 2048 + k * 1024); } while (0)
#define PG8_LDB(dst, b, h) do { _Pragma("unroll") for (int n = 0; n < 2; ++n) _Pragma("unroll") for (int k = 0; k < 2; ++k) dst[n][k] = *(const PG8_LAS bf16x8*)(lds + PG8_SB(b, h) + boff + n * 2048 + k * 1024); } while (0)
#define PG8_MMA(ai, bj, At, Bt) do { __builtin_amdgcn_s_setprio(1); _Pragma("unroll") for (int m = 0; m < 4; ++m) _Pragma("unroll") for (int n = 0; n < 2; ++n) _Pragma("unroll") for (int k = 0; k < 2; ++k) \
        acc[ai][bj][m][n] = __builtin_amdgcn_mfma_f32_16x16x32_bf16(Bt[n][k], At[m][k], acc[ai][bj][m][n], 0, 0, 0); __builtin_amdgcn_s_setprio(0); } while (0)
#define PG8_WAIT_V(n) asm volatile("s_waitcnt vmcnt(" #n ")" ::: "memory")
#define PG8_WAIT_L(n) asm volatile("s_waitcnt lgkmcnt(" #n ")" ::: "memory")
#define PG8_BAR __builtin_amdgcn_s_barrier()
#define PG8_SCHED __builtin_amdgcn_sched_barrier(0)
    Unit cur, nxt; int ui = 0;
    if (!S.next(0, cur)) return;
    f32x4 acc[2][2][4][2];
#pragma unroll
    for (int a = 0; a < 2; ++a)
#pragma unroll
        for (int b = 0; b < 2; ++b)
#pragma unroll
            for (int m = 0; m < 4; ++m)
#pragma unroll
                for (int n = 0; n < 2; ++n) acc[a][b][m][n] = (f32x4){0.f, 0.f, 0.f, 0.f};
    bf16x8 At[4][2], B0[2][2], B1[2][2];
    const char* cA = (const char*)g.A + (size_t)cur.pm * tstep; const char* cB = (const char*)g.Bt + (size_t)cur.pn * tstep;
    S.a_ready(cur);
    if constexpr (SP2) {
        PG8_STAGE(PG8_SB(0, 0), cB, voffB); PG8_STAGE(PG8_SB(0, 1), cB + hstep, voffB); PG8_STAGE(PG8_SA(0, 0), cA, voffA); PG8_STAGE(PG8_SA(0, 1), cA + hstep, voffA);
        if (wr == 1) PG8_BAR;
        PG8_WAIT_V(2); PG8_BAR;
        PG8_STAGE(PG8_SB(1, 0), cB + kstep, voffB); PG8_STAGE(PG8_SA(1, 0), cA + kstep, voffA); PG8_STAGE(PG8_SB(1, 1), cB + hstep + kstep, voffB);
        PG8_WAIT_V(6); PG8_BAR;
    } else {
        PG8_STAGE(PG8_SB(0, 0), cB, voffB); PG8_STAGE(PG8_SA(0, 0), cA, voffA); PG8_STAGE(PG8_SB(0, 1), cB + hstep, voffB); PG8_STAGE(PG8_SA(0, 1), cA + hstep, voffA);
        if (wr == 1) PG8_BAR;
        PG8_WAIT_V(4); PG8_BAR;
        PG8_STAGE(PG8_SB(1, 0), cB + kstep, voffB); PG8_STAGE(PG8_SA(1, 0), cA + kstep, voffA); PG8_STAGE(PG8_SB(1, 1), cB + hstep + kstep, voffB);
        PG8_WAIT_V(6); PG8_BAR;
    }
    for (;;) {
        const bool has_next = S.next(ui + 1, nxt);
        const char* nA = has_next ? (const char*)g.A + (size_t)nxt.pm * tstep : cA; const char* nB = has_next ? (const char*)g.Bt + (size_t)nxt.pn * tstep : cB;
        for (int t = 0; t < nt; t += 2) {
            const bool last = (t == nt - 2);
            const char* a1 = cA + (size_t)(t + 1) * kstep;
            const char* a2 = last ? nA : cA + (size_t)(t + 2) * kstep; const char* b2 = last ? nB : cB + (size_t)(t + 2) * kstep;
            const char* a3 = a2 + kstep; const char* b3 = b2 + kstep;
            if (last && has_next) S.a_ready(nxt);
            if constexpr (SP2) {
            PG8_LDB(B0, 0, 0); PG8_LDB(B1, 0, 1); PG8_SCHED; PG8_LDA(At, 0, 0); PG8_STAGE(PG8_SA(1, 1), a1 + hstep, voffA);
            PG8_WAIT_V(8); PG8_WAIT_L(0); PG8_BAR; PG8_MMA(0, 0, At, B0); PG8_MMA(0, 1, At, B1); PG8_BAR; PG8_SCHED;
            PG8_LDA(At, 0, 1); PG8_STAGE(PG8_SB(0, 0), b2, voffB); PG8_STAGE(PG8_SB(0, 1), b2 + hstep, voffB); PG8_STAGE(PG8_SA(0, 0), a2, voffA);
            PG8_WAIT_V(8); PG8_WAIT_L(0); PG8_BAR; PG8_MMA(1, 0, At, B0); PG8_MMA(1, 1, At, B1); PG8_BAR; PG8_SCHED;
            PG8_LDB(B0, 1, 0); PG8_LDB(B1, 1, 1); PG8_SCHED; PG8_LDA(At, 1, 0); PG8_STAGE(PG8_SA(0, 1), a2 + hstep, voffA);
            PG8_WAIT_V(8); PG8_WAIT_L(0); PG8_BAR; PG8_MMA(0, 0, At, B0); PG8_MMA(0, 1, At, B1); PG8_BAR; PG8_SCHED;
            PG8_LDA(At, 1, 1); PG8_STAGE(PG8_SB(1, 0), b3, voffB); PG8_STAGE(PG8_SB(1, 1), b3 + hstep, voffB); PG8_STAGE(PG8_SA(1, 0), a3, voffA);
            PG8_WAIT_V(8); PG8_WAIT_L(0); PG8_BAR; PG8_MMA(1, 0, At, B0); PG8_MMA(1, 1, At, B1); PG8_BAR; PG8_SCHED;
            } else {
            PG8_LDB(B0, 0, 0); PG8_SCHED; PG8_LDA(At, 0, 0); PG8_STAGE(PG8_SA(1, 1), a1 + hstep, voffA);
            PG8_WAIT_L(8); PG8_BAR; PG8_WAIT_L(0); PG8_MMA(0, 0, At, B0); PG8_BAR; PG8_SCHED;
            PG8_LDB(B1, 0, 1); PG8_STAGE(PG8_SB(0, 0), b2, voffB);
            PG8_BAR; PG8_WAIT_L(0); PG8_MMA(0, 1, At, B1); PG8_BAR;
            PG8_LDA(At, 0, 1); PG8_STAGE(PG8_SA(0, 0), a2, voffA);
            PG8_BAR; PG8_WAIT_L(0); PG8_MMA(1, 0, At, B0); PG8_BAR; PG8_SCHED;
            PG8_STAGE(PG8_SB(0, 1), b2 + hstep, voffB);
            PG8_WAIT_V(6); PG8_BAR; PG8_MMA(1, 1, At, B1); PG8_BAR;
            PG8_LDB(B0, 1, 0); PG8_SCHED; PG8_LDA(At, 1, 0); PG8_STAGE(PG8_SA(0, 1), a2 + hstep, voffA);
            PG8_WAIT_L(8); PG8_BAR; PG8_WAIT_L(0); PG8_MMA(0, 0, At, B0); PG8_BAR; PG8_SCHED;
            PG8_LDB(B1, 1, 1); PG8_STAGE(PG8_SB(1, 0), b3, voffB);
            PG8_BAR; PG8_WAIT_L(0); PG8_MMA(0, 1, At, B1); PG8_BAR;
            PG8_LDA(At, 1, 1); PG8_STAGE(PG8_SA(1, 0), a3, voffA);
            PG8_BAR; PG8_WAIT_L(0); PG8_MMA(1, 0, At, B0); PG8_BAR; PG8_SCHED;
            PG8_STAGE(PG8_SB(1, 1), b3 + hstep, voffB);
            PG8_WAIT_V(6); PG8_BAR; PG8_MMA(1, 1, At, B1); PG8_BAR;
            }
        }
        if constexpr (ALIGN_EPI) { if (wr == 0) PG8_BAR; }
        if constexpr (!Epi::AFTER_DRAIN) { E(acc, cur, wr, wc, fr, fq); S.done(cur); }
        if (!has_next) break;
#pragma unroll
        for (int a = 0; a < 2; ++a)
#pragma unroll
            for (int b = 0; b < 2; ++b)
#pragma unroll
                for (int m = 0; m < 4; ++m)
#pragma unroll
                    for (int n = 0; n < 2; ++n) acc[a][b][m][n] = (f32x4){0.f, 0.f, 0.f, 0.f};
        cur = nxt; cA = nA; cB = nB; ++ui;
        if constexpr (ALIGN_EPI) { if (wr == 1) PG8_BAR; }
    }
    PG8_WAIT_V(0);
    if constexpr (!ALIGN_EPI) { if (wr == 0) PG8_BAR; }
    PG8_BAR;
    if constexpr (Epi::AFTER_DRAIN) { E.fused(acc, cur, wr, wc, fr, fq, lds, wid, lane); S.done(cur); }
#undef PG8_SA
#undef PG8_SB
#undef PG8_STAGE
#undef PG8_LDA
#undef PG8_LDB
#undef PG8_MMA
#undef PG8_WAIT_V
#undef PG8_WAIT_L
#undef PG8_BAR
#undef PG8_SCHED
}
}
#define LAS __attribute__((address_space(3)))
typedef unsigned short bf16;
typedef unsigned v4u __attribute__((ext_vector_type(4)));
typedef unsigned v2u __attribute__((ext_vector_type(2)));
typedef float f32x4 __attribute__((ext_vector_type(4)));
typedef float f32x16 __attribute__((ext_vector_type(16)));
typedef short bf16x8 __attribute__((ext_vector_type(8)));
typedef short s16x4 __attribute__((ext_vector_type(4)));
using pg8::cvt_pk_bf16; using pg8::M_TOK; using pg8::DM; using pg8::M_PROMPT; using pg8::DFF; using pg8::LOG2E; using pg8::seq_bounds; using pg8::fast_silu; using pg8::fast_sigmoid;
constexpr int NWAVES = 8, NTHR = 512;
constexpr int LDS_BYTES = 147456;
constexpr size_t MiB = 1u << 20;
constexpr size_t WS_WIN = 0, WS_WO = 4 * MiB, WS_WGU = 6 * MiB, WS_WDA = 17 * MiB, WS_WDB = 20 * MiB, WS_SSQ = 23 * MiB, WS_GE = 25 * MiB, WS_UE = 37 * MiB;
constexpr size_t WS_H = 43 * MiB;
constexpr size_t WS_Q = 107 * MiB, WS_K = 139 * MiB, WS_VT = 147 * MiB, WS_U = 155 * MiB;
constexpr size_t WS_X1B = 192 * MiB, WS_END = 256 * MiB;
constexpr int NA = 1536, NB = 1280;

__device__ __forceinline__ float wave_sum(float v) {
#pragma unroll
    for (int o = 1; o < 64; o <<= 1) v += __shfl_xor(v, o);
    return v;
}
__device__ __forceinline__ float wave_max(float v) {
#pragma unroll
    for (int o = 1; o < 64; o <<= 1) v = fmaxf(v, __shfl_xor(v, o));
    return v;
}
__device__ __forceinline__ void transpose_item(const float* W, int N, int k0, int n0, bf16* dst, int dpitch, const float* kscale, LAS float* scr, int lane) {
#pragma unroll 8
    for (int i = 0; i < 32; ++i) { const int kk = 2 * i + (lane >> 5); float v = W[(size_t)(k0 + kk) * N + n0 + (lane & 31)]; if (kscale) v *= kscale[k0 + kk]; scr[kk * 33 + (lane & 31)] = v; }
    asm volatile("s_waitcnt lgkmcnt(0)" ::: "memory");
    const int c = lane & 7;
#pragma unroll
    for (int j = 0; j < 4; ++j) { const int n = (lane >> 3) + 8 * j; const LAS float* s = scr + (8 * c) * 33 + n;
        v4u o; o.x = cvt_pk_bf16(s[0 * 33], s[1 * 33]); o.y = cvt_pk_bf16(s[2 * 33], s[3 * 33]); o.z = cvt_pk_bf16(s[4 * 33], s[5 * 33]); o.w = cvt_pk_bf16(s[6 * 33], s[7 * 33]);
        *(v4u*)(dst + (size_t)n * dpitch + 8 * c) = o; }
    asm volatile("s_waitcnt lgkmcnt(0)" ::: "memory");
}

struct Args {
    const float *xp, *xs, *norm1_g, *w_in, *q_norm_g, *k_norm_g, *attn_sink, *conv_dw_w, *conv_dw_b, *conv_ln_g, *conv_ln_b, *w_out, *norm2_g, *w_gate, *w_up, *ffn_dw_w, *ffn_dw_b, *w_down;
    float* out; unsigned char* ws; int ph_lo, ph_hi;
};

__device__ __forceinline__ void phase0(const Args& A, LAS unsigned char* lds, int gw, int NGW, int wave, int lane) {
    unsigned char* ws = A.ws;
    LAS float* scr = (LAS float*)(lds + wave * 16384);
    constexpr int I_IN = 16 * 56, I_O = 16 * 32, I_G = 16 * 88, I_D = 44 * 32;
    constexpr int NITEMS = I_IN + I_O + 2 * I_G + I_D;
    for (int it = gw; it < NITEMS; it += NGW) {
        int r = it;
        if (r < I_IN) {
            const int kb = r / 56, nb = r % 56, n0 = 32 * nb; int drow;
            if (n0 < 768) { const int pn = n0 >> 8, wc = (n0 >> 6) & 3, bj = (n0 >> 5) & 1; drow = 256 * pn + 128 * bj + 32 * wc; }
            else if (n0 < 1280) { const int ch = n0 - 768; drow = 256 * (3 + (ch >> 7)) + (ch & 127); }
            else { const int ch = n0 - 1280; drow = 256 * (3 + (ch >> 7)) + 128 + (ch & 127); }
            transpose_item(A.w_in, 1792, 64 * kb, n0, (bf16*)(ws + WS_WIN) + (size_t)drow * 1024 + 64 * kb, 1024, nullptr, scr, lane); continue; }
        r -= I_IN;
        if (r < I_O) { const int kb = r / 32, nb = r % 32; transpose_item(A.w_out, 1024, 64 * kb, 32 * nb, (bf16*)(ws + WS_WO) + (size_t)(32 * nb) * 1024 + 64 * kb, 1024, nullptr, scr, lane); continue; }
        r -= I_O;
        if (r < 2 * I_G) { const int up = r >= I_G; if (up) r -= I_G; const int kb = r / 88, nb = r % 88, ch = 32 * nb; const int drow = 256 * (ch >> 7) + 128 * up + (ch & 127);
            transpose_item(up ? A.w_up : A.w_gate, DFF, 64 * kb, ch, (bf16*)(ws + WS_WGU) + (size_t)drow * 1024 + 64 * kb, 1024, A.norm2_g, scr, lane); continue; }
        r -= 2 * I_G;
        { const int kb = r / 32, nb = r % 32, k0 = 64 * kb;
          if (k0 < NA) transpose_item(A.w_down, 1024, k0, 32 * nb, (bf16*)(ws + WS_WDA) + (size_t)(32 * nb) * NA + k0, NA, nullptr, scr, lane);
          else transpose_item(A.w_down, 1024, k0, 32 * nb, (bf16*)(ws + WS_WDB) + (size_t)(32 * nb) * NB + (k0 - NA), NB, nullptr, scr, lane); }
    }
    f32x4 g[4];
#pragma unroll
    for (int j = 0; j < 4; ++j) g[j] = ((const f32x4*)A.norm1_g)[lane + 64 * j];
    bf16* H = (bf16*)(ws + WS_H);
    for (int m = gw; m < M_TOK; m += NGW) {
        const float* xrow = (m < M_PROMPT) ? A.xp + (size_t)m * DM : A.xs + (size_t)(m - M_PROMPT) * DM;
        f32x4 v[4]; float s = 0.f;
#pragma unroll
        for (int j = 0; j < 4; ++j) { v[j] = ((const f32x4*)xrow)[lane + 64 * j]; s += (v[j][0] * v[j][0] + v[j][1] * v[j][1]) + (v[j][2] * v[j][2] + v[j][3] * v[j][3]); }
        const float rs = __builtin_amdgcn_rsqf(wave_sum(s) * (1.0f / DM) + 1e-6f);
        uint2* o8 = (uint2*)(H + (size_t)m * DM) + lane;
#pragma unroll
        for (int j = 0; j < 4; ++j) { const f32x4 y = v[j] * rs * g[j]; uint2 w; w.x = cvt_pk_bf16(y[0], y[1]); w.y = cvt_pk_bf16(y[2], y[3]); o8[64 * j] = w; }
    }
}

constexpr int KP = 144, VP = 776;
constexpr int LDS_KOFF = 0, LDS_VOFF = 384 * KP;
__device__ __forceinline__ void attn_item(const Args& A, LAS unsigned char* lds, int item, int tid, int wave, int lane, float bound) {
    const bf16* Q = (const bf16*)(A.ws + WS_Q); const bf16* Kg = (const bf16*)(A.ws + WS_K); const bf16* VT = (const bf16*)(A.ws + WS_VT); bf16* MIX = (bf16*)(A.ws + WS_H);
    const int blk = item >> 1, kvh = item & 1, q0 = blk * 128, band0 = q0 - 128;
    int s0, s1; seq_bounds(q0, s0, s1);
    const int vlo = (q0 == s0) ? 128 : 0, vhi = (q0 + 128 == s1) ? 256 : 384;
    for (int c = tid; c < 384 * 8; c += NTHR) {
        const int i = c >> 3, part = c & 7;
        if (i >= vlo && i < vhi) { const v4u v = *(const v4u*)(Kg + (size_t)(band0 + i) * 128 + kvh * 64 + part * 8); *(LAS v4u*)(lds + LDS_KOFF + i * KP + part * 16) = v; }
    }
    for (int c = tid; c < 64 * 48; c += NTHR) {
        const int d = c / 48, part = c % 48, i = part * 8;
        if (i >= vlo && i < vhi) { const v4u v = *(const v4u*)(VT + (size_t)(kvh * 64 + d) * M_TOK + band0 + i);
            LAS v2u* p = (LAS v2u*)(lds + LDS_VOFF + d * VP + part * 16); p[0] = (v2u){v.x, v.y}; p[1] = (v2u){v.z, v.w}; }
    }
    __syncthreads();
    const int hl = wave >> 1, head = kvh * 4 + hl, r = lane & 31, h = lane >> 5;
    const float slope2 = LOG2E * __builtin_amdgcn_exp2f(-(float)(head + 1));
    const float sink = A.attn_sink[head];
    const float m2 = LOG2E * fmaxf(bound, sink), sinkterm = __builtin_amdgcn_exp2f(LOG2E * sink - m2);
#pragma unroll 1
    for (int qs = 0; qs < 2; ++qs) {
        const int qt = 128 + 64 * (wave & 1) + 32 * qs;
        const bf16* qrow = Q + (size_t)(band0 + qt + r) * 512 + head * 64 + 8 * h;
        bf16x8 qf[4];
#pragma unroll
        for (int kk = 0; kk < 4; ++kk) qf[kk] = *(const bf16x8*)(qrow + 16 * kk);
        f32x16 O0, O1;
#pragma unroll
        for (int i = 0; i < 16; ++i) { O0[i] = 0.f; O1[i] = 0.f; }
        float lsum = 0.f;
        const int kb_lo = max(qt - 128, vlo), kb_hi = min(qt + 160, vhi);
#pragma unroll 1
        for (int kb = kb_lo; kb < kb_hi; kb += 32) {
            f32x16 S;
#pragma unroll
            for (int i = 0; i < 16; ++i) S[i] = -m2;
            const LAS unsigned char* kp = lds + LDS_KOFF + (kb + r) * KP + h * 16;
#pragma unroll
            for (int kk = 0; kk < 4; ++kk) { const bf16x8 kf = *(const LAS bf16x8*)(kp + kk * 32); S = __builtin_amdgcn_mfma_f32_32x32x16_bf16(kf, qf[kk], S, 0, 0, 0); }
            const float dbase = (float)(qt + r - kb - 4 * h);
            float p[16];
#pragma unroll
            for (int i = 0; i < 16; ++i) {
                const float d = dbase - (float)((i & 3) + 8 * (i >> 2));
                const float t = S[i] - slope2 * fabsf(d);
                const float e = __builtin_amdgcn_exp2f(t);
                p[i] = (fabsf(d) <= 128.0f) ? e : 0.f; lsum += p[i];
            }
#pragma unroll
            for (int s = 0; s < 2; ++s) {
                v4u pk; pk.x = cvt_pk_bf16(p[8 * s], p[8 * s + 1]); pk.y = cvt_pk_bf16(p[8 * s + 2], p[8 * s + 3]); pk.z = cvt_pk_bf16(p[8 * s + 4], p[8 * s + 5]); pk.w = cvt_pk_bf16(p[8 * s + 6], p[8 * s + 7]);
                const bf16x8 ps = __builtin_bit_cast(bf16x8, pk);
                const LAS unsigned char* vp = lds + LDS_VOFF + r * VP + (kb + 16 * s + 4 * h) * 2;
                { const s16x4 lo = *(const LAS s16x4*)(vp), hi = *(const LAS s16x4*)(vp + 16);
                  const bf16x8 vf = __builtin_shufflevector(lo, hi, 0, 1, 2, 3, 4, 5, 6, 7); O0 = __builtin_amdgcn_mfma_f32_32x32x16_bf16(vf, ps, O0, 0, 0, 0); }
                { const s16x4 lo = *(const LAS s16x4*)(vp + 32 * VP), hi = *(const LAS s16x4*)(vp + 32 * VP + 16);
                  const bf16x8 vf = __builtin_shufflevector(lo, hi, 0, 1, 2, 3, 4, 5, 6, 7); O1 = __builtin_amdgcn_mfma_f32_32x32x16_bf16(vf, ps, O1, 0, 0, 0); }
            }
        }
        const float l = lsum + __shfl_xor(lsum, 32);
        const float inv = 1.0f / (l + sinkterm);
        bf16* orow = MIX + (size_t)(band0 + qt + r) * DM + head * 64 + 4 * h;
#pragma unroll
        for (int g = 0; g < 4; ++g) {
            uint2 w; w.x = cvt_pk_bf16(O0[4 * g] * inv, O0[4 * g + 1] * inv); w.y = cvt_pk_bf16(O0[4 * g + 2] * inv, O0[4 * g + 3] * inv); *(uint2*)(orow + 8 * g) = w;
            uint2 x; x.x = cvt_pk_bf16(O1[4 * g] * inv, O1[4 * g + 1] * inv); x.y = cvt_pk_bf16(O1[4 * g + 2] * inv, O1[4 * g + 3] * inv); *(uint2*)(orow + 32 + 8 * g) = x;
        }
    }
    __syncthreads();
}

constexpr int LDS_ST = 96 * 1024;
__device__ __forceinline__ void conv_item(const Args& A, LAS unsigned char* lds, int item, int tid, int wave, int lane, const float (&w)[31][2], float2 bias, float2 lg, float2 lb) {
    const bf16* U = (const bf16*)(A.ws + WS_U); bf16* MIX = (bf16*)(A.ws + WS_H);
    const int t0 = item * 64; int s0, s1; seq_bounds(t0, s0, s1);
    for (int c = tid; c < 94 * 64; c += NTHR) {
        const int i = c >> 6, part = c & 63, tok = t0 - 15 + i;
        v4u v = {0u, 0u, 0u, 0u};
        if (tok >= s0 && tok < s1) v = *(const v4u*)(U + (size_t)tok * 512 + part * 8);
        *(LAS v4u*)(lds + i * 1024 + part * 16) = v;
    }
    const int cp = tid & 255, tgb = tid >> 8;
    __syncthreads();
    LAS float* ST = (LAS float*)(lds + LDS_ST);
#pragma unroll 1
    for (int it = 0; it < 4; ++it) {
        const int tg = tgb + 2 * it;
        float res[8][2];
#pragma unroll
        for (int t = 0; t < 8; ++t) { res[t][0] = bias.x; res[t][1] = bias.y; }
        const LAS unsigned* xp = (const LAS unsigned*)(lds + (8 * tg) * 1024 + cp * 4);
#pragma unroll
        for (int c8 = 0; c8 < 5; ++c8) {
            unsigned xr[8];
#pragma unroll
            for (int q = 0; q < 8; ++q) { const int ii = 8 * c8 + q; if (ii < 38) xr[q] = xp[ii * 256]; }
            __builtin_amdgcn_sched_barrier(0);
#pragma unroll
            for (int q = 0; q < 8; ++q) { const int ii = 8 * c8 + q; if (ii < 38) {
                const float x0 = __uint_as_float(xr[q] << 16), x1 = __uint_as_float(xr[q] & 0xffff0000u);
#pragma unroll
                for (int t = 0; t < 8; ++t) { const int j = ii - t; if (j >= 0 && j <= 30) { res[t][0] += w[j][0] * x0; res[t][1] += w[j][1] * x1; } } } }
            __builtin_amdgcn_sched_barrier(0);
        }
#pragma unroll
        for (int t = 0; t < 8; ++t) {
            const float a0 = res[t][0], a1 = res[t][1];
            const float s1v = wave_sum(a0 + a1), s2v = wave_sum(a0 * a0 + a1 * a1);
            if (lane == 0) { ST[((8 * tg + t) * 4 + (wave & 3)) * 2] = s1v; ST[((8 * tg + t) * 4 + (wave & 3)) * 2 + 1] = s2v; }
        }
        __syncthreads();
#pragma unroll
        for (int t = 0; t < 8; ++t) {
            const LAS f32x4* sp = (const LAS f32x4*)(ST + (8 * tg + t) * 8); const f32x4 a = sp[0], b = sp[1];
            const float mean = ((a[0] + a[2]) + (b[0] + b[2])) * (1.0f / 512.0f), ex2 = ((a[1] + a[3]) + (b[1] + b[3])) * (1.0f / 512.0f);
            const float rstd = __builtin_amdgcn_rsqf(fmaxf(ex2 - mean * mean, 0.f) + 1e-5f);
            const float y0 = (res[t][0] - mean) * rstd * lg.x + lb.x, y1 = (res[t][1] - mean) * rstd * lg.y + lb.y;
            *(unsigned*)(MIX + (size_t)(t0 + 8 * tg + t) * DM + 512 + 2 * cp) = cvt_pk_bf16(fast_silu(y0), fast_silu(y1));
        }
    }
    __syncthreads();
}

__device__ __forceinline__ void fix_edges(const Args& A, int ncols, int chbase, int gtid, int gthreads) {
    const float* ge = (const float*)(A.ws + WS_GE); const float* ue = (const float*)(A.ws + WS_UE); bf16* act = (bf16*)(A.ws + WS_H);
    const int ng = ncols >> 2, total = 512 * 2 * ng;
    for (int idx = gtid; idx < total; idx += gthreads) {
        const int cg4 = idx % ng, rw = idx / ng, which = rw & 1, chunk = rw >> 1, col = 4 * cg4;
        const int row = 64 * chunk + (which ? 63 : 0); int s0, s1; seq_bounds(row, s0, s1);
        const f32x4 zero = {0.f, 0.f, 0.f, 0.f};
        f32x4 pv, cur, nx, up;
        if (which == 0) { pv = (row == s0) ? zero : *(const f32x4*)(ge + ((size_t)(chunk - 1) * 4 + 3) * ncols + col); cur = *(const f32x4*)(ge + ((size_t)chunk * 4 + 0) * ncols + col); nx = *(const f32x4*)(ge + ((size_t)chunk * 4 + 1) * ncols + col); up = *(const f32x4*)(ue + ((size_t)chunk * 2) * ncols + col); }
        else { pv = *(const f32x4*)(ge + ((size_t)chunk * 4 + 2) * ncols + col); cur = *(const f32x4*)(ge + ((size_t)chunk * 4 + 3) * ncols + col); nx = (row + 1 == s1) ? zero : *(const f32x4*)(ge + ((size_t)(chunk + 1) * 4 + 0) * ncols + col); up = *(const f32x4*)(ue + ((size_t)chunk * 2 + 1) * ncols + col); }
        const int gc = chbase + col;
        const f32x4 w0 = *(const f32x4*)(A.ffn_dw_w + gc), w1 = *(const f32x4*)(A.ffn_dw_w + DFF + gc), w2 = *(const f32x4*)(A.ffn_dw_w + 2 * DFF + gc), bb = *(const f32x4*)(A.ffn_dw_b + gc);
        float o[4];
#pragma unroll
        for (int j = 0; j < 4; ++j) { const float cv = bb[j] + w0[j] * pv[j] + w1[j] * cur[j] + w2[j] * nx[j]; o[j] = fast_silu(cv) * up[j]; }
        uint2 w; w.x = cvt_pk_bf16(o[0], o[1]); w.y = cvt_pk_bf16(o[2], o[3]);
        *(uint2*)(act + (size_t)row * ncols + col) = w;
    }
}

__global__ void __launch_bounds__(NTHR, 2) hymba_fwd(Args A) {
    extern __shared__ __attribute__((aligned(16))) unsigned char lds_raw[];
    LAS unsigned char* lds = (LAS unsigned char*)lds_raw;
    cg::grid_group grid = cg::this_grid();
    const int tid = threadIdx.x, lane = tid & 63, wave = __builtin_amdgcn_readfirstlane(tid >> 6);
    const int G = gridDim.x, bx = blockIdx.x;
    const int gw = bx * NWAVES + wave, NGW = G * NWAVES;
    unsigned char* ws = A.ws;
    const int lo = A.ph_lo, hi = A.ph_hi;
#ifndef PMASK
#define PMASK 0x3ff
#endif
#define IN(k) (((PMASK >> (k)) & 1) && lo <= (k) && (k) < hi)
#define SEAM(k) do { if (IN(k) && IN((k) + 1)) grid.sync(); } while (0)
    if (IN(0)) phase0(A, lds, gw, NGW, wave, lane);
    SEAM(0);
    if (IN(1)) {
        pg8::Gemm g{(const pg8::bf16_t*)(ws + WS_H), (const pg8::bf16_t*)(ws + WS_WIN), M_TOK, 1792, 1024}; pg8::StaticOrder S; S.init(M_TOK, 1792, G, bx);
        pg8::EpiInProj E{(pg8::bf16_t*)(ws + WS_Q), (pg8::bf16_t*)(ws + WS_K), (pg8::bf16_t*)(ws + WS_VT), (pg8::bf16_t*)(ws + WS_U), A.q_norm_g, A.k_norm_g};
        pg8::gemm_phase<pg8::EpiInProj, pg8::StaticOrder, true, true>(lds, g, S, E);
    }
    SEAM(1);
    if (IN(2)) {
        const float gqm = wave_max(fabsf(A.q_norm_g[lane])), gkm = wave_max(fabsf(A.k_norm_g[lane]));
        const float bound = 8.0f * gqm * gkm;
#ifndef NO_ATTN
        for (int it = bx; it < 512; it += G) attn_item(A, lds, it, tid, wave, lane, bound);
#endif
#ifndef NO_CONV
        {
            const int cp = tid & 255;
            float w[31][2];
#pragma unroll
            for (int j = 0; j < 31; ++j) { const float2 t = *(const float2*)(A.conv_dw_w + j * 512 + 2 * cp); w[j][0] = t.x; w[j][1] = t.y; }
            const float2 bias = *(const float2*)(A.conv_dw_b + 2 * cp), lg = *(const float2*)(A.conv_ln_g + 2 * cp), lb = *(const float2*)(A.conv_ln_b + 2 * cp);
#pragma unroll 1
            for (int it = bx; it < 512; it += G) conv_item(A, lds, it, tid, wave, lane, w, bias, lg, lb);
        }
#endif
    }
    SEAM(2);
    if (IN(3)) {
        pg8::Gemm g{(const pg8::bf16_t*)(ws + WS_H), (const pg8::bf16_t*)(ws + WS_WO), M_TOK, 1024, 1024}; pg8::StaticOrder S; S.init(M_TOK, 1024, G, bx);
        pg8::EpiOutProj E{A.xp, A.xs, A.out, (pg8::bf16_t*)(ws + WS_X1B), (float*)(ws + WS_SSQ), (LAS float*)(lds + 131072)};
        pg8::gemm_phase<pg8::EpiOutProj, pg8::StaticOrder, true, true>(lds, g, S, E);
    }
    SEAM(3);
#pragma unroll
    for (int part = 0; part < 2; ++part) {
        const int ncols = part ? NB : NA, chbase = part ? NA : 0, pb = 4 + 3 * part;
        if (IN(pb)) {
            pg8::Gemm g{(const pg8::bf16_t*)(ws + WS_X1B), (const pg8::bf16_t*)(ws + WS_WGU) + (size_t)(2 * chbase) * 1024, M_TOK, 2 * ncols, 1024}; pg8::StaticOrder S; S.init(M_TOK, 2 * ncols, G, bx);
            pg8::EpiGateUp E{(pg8::bf16_t*)(ws + WS_H), (float*)(ws + WS_GE), (float*)(ws + WS_UE), (const float*)(ws + WS_SSQ), A.ffn_dw_w, A.ffn_dw_b, ncols, chbase};
            pg8::gemm_phase<pg8::EpiGateUp, pg8::StaticOrder, true, true>(lds, g, S, E);
        }
        SEAM(pb);
        if (IN(pb + 1)) fix_edges(A, ncols, chbase, bx * NTHR + tid, G * NTHR);
        SEAM(pb + 1);
        if (IN(pb + 2)) {
            pg8::Gemm g{(const pg8::bf16_t*)(ws + WS_H), (const pg8::bf16_t*)(ws + (part ? WS_WDB : WS_WDA)), M_TOK, 1024, ncols}; pg8::StaticOrder S; S.init(M_TOK, 1024, G, bx);
            pg8::EpiDown E{A.out};
            pg8::gemm_phase<pg8::EpiDown, pg8::StaticOrder, true, true>(lds, g, S, E);
        }
        SEAM(pb + 2);
    }
#undef IN
#undef SEAM
}

#ifndef N_LAUNCH_PER_PHASE
#define N_LAUNCH_PER_PHASE 0
#endif
extern "C" void kernel_launch(void* const* d_in, const int* in_sizes, int n_in, void* d_out, int out_size, void* d_ws, size_t ws_size, hipStream_t stream) {
    static int grid = 0;
    if (grid == 0) {
        if (n_in != 18 || out_size != M_TOK * DM || ws_size < WS_END) { fprintf(stderr, "kernel_launch: unexpected shapes (n_in %d out %d ws %zu)\n", n_in, out_size, ws_size); grid = -1; return; }
        int dev = 0, cus = 0, per_cu = 0;
        hipGetDevice(&dev); hipDeviceGetAttribute(&cus, hipDeviceAttributeMultiprocessorCount, dev);
        if (hipFuncSetAttribute((const void*)hymba_fwd, hipFuncAttributeMaxDynamicSharedMemorySize, LDS_BYTES) != hipSuccess) { fprintf(stderr, "kernel_launch: hipFuncSetAttribute failed\n"); grid = -1; return; }
        if (hipOccupancyMaxActiveBlocksPerMultiprocessor(&per_cu, (const void*)hymba_fwd, NTHR, LDS_BYTES) != hipSuccess || per_cu < 1) { fprintf(stderr, "kernel_launch: occupancy query says %d\n", per_cu); per_cu = 1; }
        (void)hipGetLastError();
        grid = cus * 1;
    }
    if (grid < 0) return;
    Args a{};
    const float** slots = (const float**)&a;
    for (int i = 0; i < 18; ++i) slots[i] = (const float*)d_in[i];
    a.out = (float*)d_out; a.ws = (unsigned char*)d_ws;
#if N_LAUNCH_PER_PHASE
    for (int p = 0; p < 10; ++p) { a.ph_lo = p; a.ph_hi = p + 1; hipLaunchKernelGGL(hymba_fwd, dim3(grid), dim3(NTHR), LDS_BYTES, stream, a); }
#else
    a.ph_lo = 0; a.ph_hi = 10;
    void* args[] = {&a};
    hipError_t e = hipLaunchCooperativeKernel((const void*)hymba_fwd, dim3(grid), dim3(NTHR), args, LDS_BYTES, stream);
    if (e != hipSuccess) fprintf(stderr, "cooperative launch failed: %s (grid %d)\n", hipGetErrorString(e), grid);
#endif
}
```

```cpp
#include <hip/hip_runtime.h>
#include <hip/hip_cooperative_groups.h>
#include <cstdio>
#include <cstdint>
namespace cg = cooperative_groups;
namespace pg8 {
#define PG8_LAS __attribute__((address_space(3)))
typedef unsigned short bf16_t;
typedef short bf16x8 __attribute__((ext_vector_type(8)));
typedef float f32x4 __attribute__((ext_vector_type(4)));
typedef unsigned u32x4 __attribute__((ext_vector_type(4)));
constexpr int BM = 256, BK = 64, HALF = 128, HTB = HALF * BK * 2  , STAGE_BYTES = 8 * HTB, NXCD = 8, WGM = 8;

__host__ __device__ __forceinline__ int lds_byte(int r, int c) { const int st = (r >> 4) * 2 + (c >> 5), rr = r & 15, cc = c & 31, ob = rr * 64 + cc * 2; return st * 1024 + (ob ^ (((ob >> 9) & 1) << 5)); }
__host__ __device__ __forceinline__ void stage_rc(int b, int& R, int& C) { const int st = b / 1024, sb = b % 1024, swz = sb ^ (((sb >> 9) & 1) << 5); R = (st >> 1) * 16 + swz / 64; C = (st & 1) * 32 + (swz % 64) / 2; }
__host__ __device__ __forceinline__ int perm32(int rho) { const int n = rho >> 4, i = rho & 15; return 8 * (i >> 2) + 4 * n + (i & 3); }

struct Unit { int pm, pn; };
struct Gemm { const bf16_t* A; const bf16_t* Bt; int M, N, K; };

struct StaticOrder {
    int nM, nN, nwg, G, c;
    __host__ __device__ void init(int M, int N, int G_, int c_) { nM = M / BM; nN = N / BM; nwg = nM * nN; G = G_; c = c_; }
    __host__ __device__ bool next(int i, Unit& u) const {
        const long L = (long)i * G + c; if (L >= nwg) return false;
        int wgid = (int)L; { const int q = nwg / NXCD, r = nwg % NXCD, xcd = wgid % NXCD, off = wgid / NXCD; wgid = (xcd < r ? xcd * (q + 1) : r * (q + 1) + (xcd - r) * q) + off; }
        const int nig = WGM * nN, gid = wgid / nig, fm = gid * WGM, gsz = (nM - fm) < WGM ? (nM - fm) : WGM;
        u.pm = fm + ((wgid % nig) % gsz); u.pn = (wgid % nig) / gsz; return true;
    }
    __device__ __forceinline__ void a_ready(const Unit&) const {}
    __device__ __forceinline__ void done(const Unit&) const {}
};

__device__ __forceinline__ unsigned cvt_pk_bf16(float lo, float hi) { unsigned r; asm volatile("v_cvt_pk_bf16_f32 %0, %1, %2" : "=v"(r) : "v"(lo), "v"(hi)); return r; }
typedef float f32x2 __attribute__((ext_vector_type(2)));
constexpr int M_TOK = 32768, DM = 1024, M_PROMPT = 16384, T_PROMPT = 2048, T_SAMPLE = 8192, DFF = 2816;
constexpr float LOG2E = 1.4426950408889634f;
constexpr float QSCALE = 0.125f * LOG2E;
__device__ __forceinline__ void seq_bounds(int row, int& s0, int& s1) {
    if (row < M_PROMPT) { s0 = row & ~(T_PROMPT - 1); s1 = s0 + T_PROMPT; }
    else { s0 = M_PROMPT + ((row - M_PROMPT) & ~(T_SAMPLE - 1)); s1 = s0 + T_SAMPLE; }
}
__device__ __forceinline__ float fast_sigmoid(float v) { return __builtin_amdgcn_rcpf(1.0f + __builtin_amdgcn_exp2f(-LOG2E * v)); }
__device__ __forceinline__ float fast_silu(float v) { return v * fast_sigmoid(v); }

struct EpiInProj {
    static constexpr bool PERM = true, AFTER_DRAIN = false;
    bf16_t* Q; bf16_t* Kb; bf16_t* VT; bf16_t* U; const float* gq; const float* gk;
    __device__ __forceinline__ void operator()(f32x4 (&acc)[2][2][4][2], const Unit& u, int wr, int wc, int fr, int fq) const {
        asm volatile("" : "+v"(fr), "+v"(fq));
        const int row0 = u.pm * BM + wr * 64 + fr;
        if (u.pn < 3) {
            const bool isq = u.pn < 2, isk = (u.pn == 2) && (wc < 2);
            if (isq || isk) {
                const float* g = isq ? gq : gk; const float sc = isq ? QSCALE : 1.0f;
                f32x4 gv[2][2];
#pragma unroll
                for (int bj = 0; bj < 2; ++bj)
#pragma unroll
                    for (int n = 0; n < 2; ++n) gv[bj][n] = *(const f32x4*)(g + 32 * bj + 8 * fq + 4 * n) * sc;
                bf16_t* dst = isq ? (Q + (size_t)(u.pn * 4 + wc) * 64) : (Kb + (size_t)wc * 64);
                const int pitch = isq ? 512 : 128;
#pragma unroll
                for (int ai = 0; ai < 2; ++ai)
#pragma unroll
                    for (int m = 0; m < 4; ++m) {
                        float s = 0.f;
#pragma unroll
                        for (int bj = 0; bj < 2; ++bj)
#pragma unroll
                            for (int n = 0; n < 2; ++n) { const f32x4 x = acc[ai][bj][m][n]; s += (x[0] * x[0] + x[1] * x[1]) + (x[2] * x[2] + x[3] * x[3]); }
                        s += __shfl_xor(s, 16); s += __shfl_xor(s, 32);
                        const float rs = __builtin_amdgcn_rsqf(s * (1.0f / 64.0f) + 1e-6f);
                        bf16_t* rowp = dst + (size_t)(row0 + ai * HALF + m * 16) * pitch + 8 * fq;
#pragma unroll
                        for (int bj = 0; bj < 2; ++bj) {
                            const f32x4 v0 = acc[ai][bj][m][0] * rs * gv[bj][0], v1 = acc[ai][bj][m][1] * rs * gv[bj][1];
                            u32x4 w; w.x = cvt_pk_bf16(v0[0], v0[1]); w.y = cvt_pk_bf16(v0[2], v0[3]); w.z = cvt_pk_bf16(v1[0], v1[1]); w.w = cvt_pk_bf16(v1[2], v1[3]);
                            *(u32x4*)(rowp + 32 * bj) = w;
                        }
                    }
            } else {
                bf16_t* vt = VT + (size_t)(wc - 2) * 64 * M_TOK;
#pragma unroll
                for (int ai = 0; ai < 2; ++ai)
#pragma unroll
                    for (int m = 0; m < 4; ++m) {
                        const int row = row0 + ai * HALF + m * 16;
#pragma unroll
                        for (int bj = 0; bj < 2; ++bj)
#pragma unroll
                            for (int n = 0; n < 2; ++n) {
                                const f32x4 x = acc[ai][bj][m][n]; const int d0 = 32 * bj + 8 * fq + 4 * n;
                                const unsigned p01 = cvt_pk_bf16(x[0], x[1]), p23 = cvt_pk_bf16(x[2], x[3]);
                                vt[(size_t)(d0 + 0) * M_TOK + row] = (bf16_t)(p01 & 0xffffu); vt[(size_t)(d0 + 1) * M_TOK + row] = (bf16_t)(p01 >> 16);
                                vt[(size_t)(d0 + 2) * M_TOK + row] = (bf16_t)(p23 & 0xffffu); vt[(size_t)(d0 + 3) * M_TOK + row] = (bf16_t)(p23 >> 16);
                            }
                    }
            }
        } else {
            bf16_t* dst = U + (size_t)(u.pn - 3) * 128 + 32 * wc + 8 * fq;
#pragma unroll
            for (int ai = 0; ai < 2; ++ai)
#pragma unroll
                for (int m = 0; m < 4; ++m) {
                    f32x4 o[2];
#pragma unroll
                    for (int n = 0; n < 2; ++n) { const f32x4 a = acc[ai][0][m][n], g = acc[ai][1][m][n];
#pragma unroll
                        for (int j = 0; j < 4; ++j) o[n][j] = a[j] * fast_sigmoid(g[j]); }
                    u32x4 w; w.x = cvt_pk_bf16(o[0][0], o[0][1]); w.y = cvt_pk_bf16(o[0][2], o[0][3]); w.z = cvt_pk_bf16(o[1][0], o[1][1]); w.w = cvt_pk_bf16(o[1][2], o[1][3]);
                    *(u32x4*)(dst + (size_t)(row0 + ai * HALF + m * 16) * 512) = w;
                }
        }
    }
};

struct EpiOutProj {
    static constexpr bool PERM = false, AFTER_DRAIN = false;
    const float* xp; const float* xs; float* out; bf16_t* x1b; float* ssq; PG8_LAS float* red;
    __device__ __forceinline__ void operator()(f32x4 (&acc)[2][2][4][2], const Unit& u, int wr, int wc, int fr, int fq) const {
        asm volatile("" : "+v"(fr), "+v"(fq));
        const int row0 = u.pm * BM + wr * 64 + fr, col0 = u.pn * BM + wc * 32 + 4 * fq;
        const float* xb = (u.pm * BM < M_PROMPT) ? xp : (xs - (size_t)M_PROMPT * DM);
#pragma unroll
        for (int ai = 0; ai < 2; ++ai)
#pragma unroll
            for (int m = 0; m < 4; ++m) {
                const int row = row0 + ai * HALF + m * 16; const size_t ro = (size_t)row * DM + col0; float s = 0.f;
#pragma unroll
                for (int bj = 0; bj < 2; ++bj)
#pragma unroll
                    for (int n = 0; n < 2; ++n) {
                        const f32x4 v = acc[ai][bj][m][n] + *(const f32x4*)(xb + ro + bj * HALF + n * 16);
                        *(f32x4*)(out + ro + bj * HALF + n * 16) = v;
                        s += (v[0] * v[0] + v[1] * v[1]) + (v[2] * v[2] + v[3] * v[3]);
                        uint2 w; w.x = cvt_pk_bf16(v[0], v[1]); w.y = cvt_pk_bf16(v[2], v[3]);
                        *(uint2*)(x1b + ro + bj * HALF + n * 16) = w;
                    }
                s += __shfl_xor(s, 16); s += __shfl_xor(s, 32);
                if (fq == 0) red[(ai * HALF + wr * 64 + m * 16 + fr) * 4 + wc] = s;
            }
        __syncthreads();
        const int t = threadIdx.x;
        if (t < 256) { const f32x4 v = *(const PG8_LAS f32x4*)(red + t * 4); ssq[(size_t)(u.pm * BM + t) * 4 + u.pn] = (v[0] + v[1]) + (v[2] + v[3]); }
    }
};

struct EpiGateUp {
    static constexpr bool PERM = true, AFTER_DRAIN = false;
    bf16_t* act; float* ge; float* ue; const float* ssq; const float* cw; const float* cb; int ncols, chbase;
    __device__ __forceinline__ void operator()(f32x4 (&acc)[2][2][4][2], const Unit& u, int wr, int wc, int fr, int fq) const {
        asm volatile("" : "+v"(fr), "+v"(fq));
        const int lane = fr + 16 * fq;
        const int ch0 = u.pn * 128 + 32 * wc + 8 * fq;
        const int lprev = (lane & 48) | ((fr + 15) & 15), lnext = (lane & 48) | ((fr + 1) & 15);
#pragma unroll
        for (int ai = 0; ai < 2; ++ai) {
            const int crow0 = u.pm * BM + ai * HALF + wr * 64;
            const int chunk = crow0 >> 6;
#pragma unroll
            for (int m = 0; m < 4; ++m) {
                const f32x4 a = *(const f32x4*)(ssq + (size_t)(crow0 + m * 16 + fr) * 4);
                const float t = (a[0] + a[1]) + (a[2] + a[3]);
                const float rstd = __builtin_amdgcn_rsqf(t * (1.0f / 1024.0f) + 1e-6f);
#pragma unroll
                for (int n = 0; n < 2; ++n) { acc[ai][0][m][n] *= rstd; acc[ai][1][m][n] *= rstd; }
            }
            if (fr < 2) {
                float* g = ge + ((size_t)chunk * 4 + fr) * ncols + ch0;
                *(f32x4*)g = acc[ai][0][0][0]; *(f32x4*)(g + 4) = acc[ai][0][0][1];
                if (fr == 0) { float* q = ue + ((size_t)chunk * 2) * ncols + ch0; *(f32x4*)q = acc[ai][1][0][0]; *(f32x4*)(q + 4) = acc[ai][1][0][1]; }
            }
            if (fr >= 14) {
                float* g = ge + ((size_t)chunk * 4 + (fr - 12)) * ncols + ch0;
                *(f32x4*)g = acc[ai][0][3][0]; *(f32x4*)(g + 4) = acc[ai][0][3][1];
                if (fr == 15) { float* q = ue + ((size_t)chunk * 2 + 1) * ncols + ch0; *(f32x4*)q = acc[ai][1][3][0]; *(f32x4*)(q + 4) = acc[ai][1][3][1]; }
            }
        }
#pragma unroll
        for (int n = 0; n < 2; ++n) {
            const int gc = chbase + ch0 + 4 * n;
            const f32x4 w0 = *(const f32x4*)(cw + gc), w1 = *(const f32x4*)(cw + DFF + gc), w2 = *(const f32x4*)(cw + 2 * DFF + gc), bb = *(const f32x4*)(cb + gc);
#pragma unroll
            for (int ai = 0; ai < 2; ++ai) {
                const int crow0 = u.pm * BM + ai * HALF + wr * 64;
                float o[4][4];
#pragma unroll
                for (int j = 0; j < 4; ++j) {
                    float R[4], L[4];
#pragma unroll
                    for (int m = 0; m < 4; ++m) { R[m] = __shfl(acc[ai][0][m][n][j], lprev); L[m] = __shfl(acc[ai][0][m][n][j], lnext); }
#pragma unroll
                    for (int m = 0; m < 4; ++m) {
                        const float pv = (m > 0 && fr == 0) ? R[m > 0 ? m - 1 : 0] : R[m];
                        const float nx = (m < 3 && fr == 15) ? L[m < 3 ? m + 1 : 3] : L[m];
                        const float cv = bb[j] + w0[j] * pv + w1[j] * acc[ai][0][m][n][j] + w2[j] * nx;
                        o[m][j] = fast_silu(cv) * acc[ai][1][m][n][j];
                    }
                }
#pragma unroll
                for (int m = 0; m < 4; ++m) {
                    const bool edge = (m == 0 && fr == 0) || (m == 3 && fr == 15);
                    if (!edge) { uint2 w; w.x = cvt_pk_bf16(o[m][0], o[m][1]); w.y = cvt_pk_bf16(o[m][2], o[m][3]);
                        *(uint2*)(act + (size_t)(crow0 + m * 16 + fr) * ncols + ch0 + 4 * n) = w; }
                }
                __builtin_amdgcn_sched_barrier(0);
            }
        }
    }
};

struct EpiDown {
    static constexpr bool PERM = false, AFTER_DRAIN = false;
    float* out;
    __device__ __forceinline__ void operator()(f32x4 (&acc)[2][2][4][2], const Unit& u, int wr, int wc, int fr, int fq) const {
        asm volatile("" : "+v"(fr), "+v"(fq));
        const int row0 = u.pm * BM + wr * 64 + fr, col0 = u.pn * BM + wc * 32 + 4 * fq;
#pragma unroll
        for (int ai = 0; ai < 2; ++ai)
#pragma unroll
            for (int m = 0; m < 4; ++m) { float* rowp = out + (size_t)(row0 + ai * HALF + m * 16) * DM + col0;
#pragma unroll
                for (int bj = 0; bj < 2; ++bj)
#pragma unroll
                    for (int n = 0; n < 2; ++n) { f32x4* p = (f32x4*)(rowp + bj * HALF + n * 16); *p = *p + acc[ai][bj][m][n]; } }
    }
};
template <class Epi, class Sched, bool ALIGN_EPI = false, bool SP2 = false>
__device__ __forceinline__ void gemm_phase(PG8_LAS unsigned char* lds, const Gemm g, const Sched& S, const Epi& E) {
    const int tid = threadIdx.x, wid = __builtin_amdgcn_readfirstlane(tid >> 6), lane = tid & 63, wr = wid >> 2, wc = wid & 3, fr = lane & 15, fq = lane >> 4;
    const int K = g.K, nt = K / BK;
    unsigned voffA[2], voffB[2];
#pragma unroll
    for (int i = 0; i < 2; ++i) { int R, C; stage_rc(tid * 16 + i * 8192, R, C); const int Rb = Epi::PERM ? ((R & ~31) + perm32(R & 31)) : R;
        voffA[i] = (unsigned)(R * K + C) * 2u; voffB[i] = (unsigned)(Rb * K + C) * 2u; }
    const size_t kstep = (size_t)(BK * 2);
    const size_t hstep = (size_t)HALF * K * 2;
    const size_t tstep = 2 * hstep;
    const unsigned ldsw = (unsigned)wid * 1024u;
    const int aoff = lds_byte(wr * 64 + fr, fq * 8), boff = lds_byte(wc * 32 + fr, fq * 8);
#define PG8_SA(b, h) (((b) * 2 + (h)) * HTB)
#define PG8_SB(b, h) ((4 + (b) * 2 + (h)) * HTB)
#define PG8_STAGE(bufoff, gbase, voff) do { _Pragma("unroll") for (int _i = 0; _i < 2; ++_i) \
        __builtin_amdgcn_global_load_lds((const unsigned*)((const char*)(gbase) + (voff)[_i]), (PG8_LAS unsigned*)(lds + (bufoff) + ldsw + _i * 8192), 16, 0, 0); } while (0)
#define PG8_LDA(dst, b, h) do { _Pragma("unroll") for (int m = 0; m < 4; ++m) _Pragma("unroll") for (int k = 0; k < 2; ++k) dst[m][k] = *(const PG8_LAS bf16x8*)(lds + PG8_SA(b, h) + aoff + m * 2048 + k * 1024); } while (0)
#define PG8_LDB(dst, b, h) do { _Pragma("unroll") for (int n = 0; n < 2; ++n) _Pragma("unroll") for (int k = 0; k < 2; ++k) dst[n][k] = *(const PG8_LAS bf16x8*)(lds + PG8_SB(b, h) + boff + n * 2048 + k * 1024); } while (0)
#define PG8_MMA(ai, bj, At, Bt) do { __builtin_amdgcn_s_setprio(1); _Pragma("unroll") for (int m = 0; m < 4; ++m) _Pragma("unroll") for (int n = 0; n < 2; ++n) _Pragma("unroll") for (int k = 0; k < 2; ++k) \
        acc[ai][bj][m][n] = __builtin_amdgcn_mfma_f32_16x16x32_bf16(Bt[n][k], At[m][k], acc[ai][bj][m][n], 0, 0, 0); __builtin_amdgcn_s_setprio(0); } while (0)
#define PG8_WAIT_V(n) asm volatile("s_waitcnt vmcnt(" #n ")" ::: "memory")
#define PG8_WAIT_L(n) asm volatile("s_waitcnt lgkmcnt(" #n ")" ::: "memory")
#define PG8_BAR __builtin_amdgcn_s_barrier()
#define PG8_SCHED __builtin_amdgcn_sched_barrier(0)
    Unit cur, nxt; int ui = 0;
    if (!S.next(0, cur)) return;
    f32x4 acc[2][2][4][2];
#pragma unroll
    for (int a = 0; a < 2; ++a)
#pragma unroll
        for (int b = 0; b < 2; ++b)
#pragma unroll
            for (int m = 0; m < 4; ++m)
#pragma unroll
                for (int n = 0; n < 2; ++n) acc[a][b][m][n] = (f32x4){0.f, 0.f, 0.f, 0.f};
    bf16x8 At[4][2], B0[2][2], B1[2][2];
    const char* cA = (const char*)g.A + (size_t)cur.pm * tstep; const char* cB = (const char*)g.Bt + (size_t)cur.pn * tstep;
    S.a_ready(cur);
    if constexpr (SP2) {
        PG8_STAGE(PG8_SB(0, 0), cB, voffB); PG8_STAGE(PG8_SB(0, 1), cB + hstep, voffB); PG8_STAGE(PG8_SA(0, 0), cA, voffA); PG8_STAGE(PG8_SA(0, 1), cA + hstep, voffA);
        if (wr == 1) PG8_BAR;
        PG8_WAIT_V(2); PG8_BAR;
        PG8_STAGE(PG8_SB(1, 0), cB + kstep, voffB); PG8_STAGE(PG8_SA(1, 0), cA + kstep, voffA); PG8_STAGE(PG8_SB(1, 1), cB + hstep + kstep, voffB);
        PG8_WAIT_V(6); PG8_BAR;
    } else {
        PG8_STAGE(PG8_SB(0, 0), cB, voffB); PG8_STAGE(PG8_SA(0, 0), cA, voffA); PG8_STAGE(PG8_SB(0, 1), cB + hstep, voffB); PG8_STAGE(PG8_SA(0, 1), cA + hstep, voffA);
        if (wr == 1) PG8_BAR;
        PG8_WAIT_V(4); PG8_BAR;
        PG8_STAGE(PG8_SB(1, 0), cB + kstep, voffB); PG8_STAGE(PG8_SA(1, 0), cA + kstep, voffA); PG8_STAGE(PG8_SB(1, 1), cB + hstep + kstep, voffB);
        PG8_WAIT_V(6); PG8_BAR;
    }
    for (;;) {
        const bool has_next = S.next(ui + 1, nxt);
        const char* nA = has_next ? (const char*)g.A + (size_t)nxt.pm * tstep : cA; const char* nB = has_next ? (const char*)g.Bt + (size_t)nxt.pn * tstep : cB;
        for (int t = 0; t < nt; t += 2) {
            const bool last = (t == nt - 2);
            const char* a1 = cA + (size_t)(t + 1) * kstep;
            const char* a2 = last ? nA : cA + (size_t)(t + 2) * kstep; const char* b2 = last ? nB : cB + (size_t)(t + 2) * kstep;
            const char* a3 = a2 + kstep; const char* b3 = b2 + kstep;
            if (last && has_next) S.a_ready(nxt);
            if constexpr (SP2) {
            PG8_LDB(B0, 0, 0); PG8_LDB(B1, 0, 1); PG8_SCHED; PG8_LDA(At, 0, 0); PG8_STAGE(PG8_SA(1, 1), a1 + hstep, voffA);
            PG8_WAIT_V(8); PG8_WAIT_L(0); PG8_BAR; PG8_MMA(0, 0, At, B0); PG8_MMA(0, 1, At, B1); PG8_BAR; PG8_SCHED;
            PG8_LDA(At, 0, 1); PG8_STAGE(PG8_SB(0, 0), b2, voffB); PG8_STAGE(PG8_SB(0, 1), b2 + hstep, voffB); PG8_STAGE(PG8_SA(0, 0), a2, voffA);
            PG8_WAIT_V(8); PG8_WAIT_L(0); PG8_BAR; PG8_MMA(1, 0, At, B0); PG8_MMA(1, 1, At, B1); PG8_BAR; PG8_SCHED;
            PG8_LDB(B0, 1, 0); PG8_LDB(B1, 1, 1); PG8_SCHED; PG8_LDA(At, 1, 0); PG8_STAGE(PG8_SA(0, 1), a2 + hstep, voffA);
            PG8_WAIT_V(8); PG8_WAIT_L(0); PG8_BAR; PG8_MMA(0, 0, At, B0); PG8_MMA(0, 1, At, B1); PG8_BAR; PG8_SCHED;
            PG8_LDA(At, 1, 1); PG8_STAGE(PG8_SB(1, 0), b3, voffB); PG8_STAGE(PG8_SB(1, 1), b3 + hstep, voffB); PG8_STAGE(PG8_SA(1, 0), a3, voffA);
            PG8_WAIT_V(8); PG8_WAIT_L(0); PG8_BAR; PG8_MMA(1, 0, At, B0); PG8_MMA(1, 1, At, B1); PG8_BAR; PG8_SCHED;
            } else {
            PG8_LDB(B0, 0, 0); PG8_SCHED; PG8_LDA(At, 0, 0); PG8_STAGE(PG8_SA(1, 1), a1 + hstep, voffA);
            PG8_WAIT_L(8); PG8_BAR; PG8_WAIT_L(0); PG8_MMA(0, 0, At, B0); PG8_BAR; PG8_SCHED;
            PG8_LDB(B1, 0, 1); PG8_STAGE(PG8_SB(0, 0), b2, voffB);
            PG8_BAR; PG8_WAIT_L(0); PG8_MMA(0, 1, At, B1); PG8_BAR;
            PG8_LDA(At, 0, 1); PG8_STAGE(PG8_SA(0, 0), a2, voffA);
            PG8_BAR; PG8_WAIT_L(0); PG8_MMA(1, 0, At, B0); PG8_BAR; PG8_SCHED;
            PG8_STAGE(PG8_SB(0, 1), b2 + hstep, voffB);
            PG8_WAIT_V(6); PG8_BAR; PG8_MMA(1, 1, At, B1); PG8_BAR;
            PG8_LDB(B0, 1, 0); PG8_SCHED; PG8_LDA(At, 1, 0); PG8_STAGE(PG8_SA(0, 1), a2 + hstep, voffA);
            PG8_WAIT_L(8); PG8_BAR; PG8_WAIT_L(0); PG8_MMA(0, 0, At, B0); PG8_BAR; PG8_SCHED;
            PG8_LDB(B1, 1, 1); PG8_STAGE(PG8_SB(1, 0), b3, voffB);
            PG8_BAR; PG8_WAIT_L(0); PG8_MMA(0, 1, At, B1); PG8_BAR;
            PG8_LDA(At, 1, 1); PG8_STAGE(PG8_SA(1, 0), a3, voffA);
            PG8_BAR; PG8_WAIT_L(0); PG8_MMA(1, 0, At, B0); PG8_BAR; PG8_SCHED;
            PG8_STAGE(PG8_SB(1, 1), b3 + hstep, voffB);
            PG8_WAIT_V(6); PG8_BAR; PG8_MMA(1, 1, At, B1); PG8_BAR;
            }
        }
        if constexpr (ALIGN_EPI) { if (wr == 0) PG8_BAR; }
        if constexpr (!Epi::AFTER_DRAIN) { E(acc, cur, wr, wc, fr, fq); S.done(cur); }
        if (!has_next) break;
#pragma unroll
        for (int a = 0; a < 2; ++a)
#pragma unroll
            for (int b = 0; b < 2; ++b)
#pragma unroll
                for (int m = 0; m < 4; ++m)
#pragma unroll
                    for (int n = 0; n < 2; ++n) acc[a][b][m][n] = (f32x4){0.f, 0.f, 0.f, 0.f};
        cur = nxt; cA = nA; cB = nB; ++ui;
        if constexpr (ALIGN_EPI) { if (wr == 1) PG8_BAR; }
    }
    PG8_WAIT_V(0);
    if constexpr (!ALIGN_EPI) { if (wr == 0) PG8_BAR; }
    PG8_BAR;
    if constexpr (Epi::AFTER_DRAIN) { E.fused(acc, cur, wr, wc, fr, fq, lds, wid, lane); S.done(cur); }
#undef PG8_SA
#undef PG8_SB
#undef PG8_STAGE
#undef PG8_LDA
#undef PG8_LDB
#undef PG8_MMA
#undef PG8_WAIT_V
#undef PG8_WAIT_L
#undef PG8_BAR
#undef PG8_SCHED
}
}
#define LAS __attribute__((address_space(3)))
typedef unsigned short bf16;
typedef unsigned v4u __attribute__((ext_vector_type(4)));
typedef unsigned v2u __attribute__((ext_vector_type(2)));
typedef float f32x4 __attribute__((ext_vector_type(4)));
typedef float f32x16 __attribute__((ext_vector_type(16)));
typedef short bf16x8 __attribute__((ext_vector_type(8)));
typedef short s16x4 __attribute__((ext_vector_type(4)));
using pg8::cvt_pk_bf16; using pg8::M_TOK; using pg8::DM; using pg8::M_PROMPT; using pg8::DFF; using pg8::LOG2E; using pg8::seq_bounds; using pg8::fast_silu; using pg8::fast_sigmoid;
constexpr int NWAVES = 8, NTHR = 512;
constexpr int LDS_BYTES = 147456;
constexpr size_t MiB = 1u << 20;
constexpr size_t WS_WIN = 0, WS_WO = 4 * MiB, WS_WGU = 6 * MiB, WS_WDA = 17 * MiB, WS_WDB = 20 * MiB, WS_SSQ = 23 * MiB, WS_GE = 25 * MiB, WS_UE = 37 * MiB;
constexpr size_t WS_BAR = 22 * MiB + 768 * 1024, BAR_BYTES = 16384;
constexpr size_t WS_H = 43 * MiB;
constexpr size_t WS_Q = 107 * MiB, WS_K = 139 * MiB, WS_VT = 147 * MiB, WS_U = 155 * MiB;
constexpr size_t WS_X1B = 192 * MiB, WS_END = 256 * MiB;
constexpr int NA = 1536, NB = 1280;

__device__ __forceinline__ float wave_sum(float v) {
#pragma unroll
    for (int o = 1; o < 64; o <<= 1) v += __shfl_xor(v, o);
    return v;
}
__device__ __forceinline__ float wave_max(float v) {
#pragma unroll
    for (int o = 1; o < 64; o <<= 1) v = fmaxf(v, __shfl_xor(v, o));
    return v;
}
__device__ __forceinline__ void transpose_item(const float* W, int N, int k0, int n0, bf16* dst, int dpitch, const float* kscale, LAS float* scr, int lane) {
#pragma unroll 8
    for (int i = 0; i < 32; ++i) { const int kk = 2 * i + (lane >> 5); float v = W[(size_t)(k0 + kk) * N + n0 + (lane & 31)]; if (kscale) v *= kscale[k0 + kk]; scr[kk * 33 + (lane & 31)] = v; }
    asm volatile("s_waitcnt lgkmcnt(0)" ::: "memory");
    const int c = lane & 7;
#pragma unroll
    for (int j = 0; j < 4; ++j) { const int n = (lane >> 3) + 8 * j; const LAS float* s = scr + (8 * c) * 33 + n;
        v4u o; o.x = cvt_pk_bf16(s[0 * 33], s[1 * 33]); o.y = cvt_pk_bf16(s[2 * 33], s[3 * 33]); o.z = cvt_pk_bf16(s[4 * 33], s[5 * 33]); o.w = cvt_pk_bf16(s[6 * 33], s[7 * 33]);
        *(v4u*)(dst + (size_t)n * dpitch + 8 * c) = o; }
    asm volatile("s_waitcnt lgkmcnt(0)" ::: "memory");
}

struct Args {
    const float *xp, *xs, *norm1_g, *w_in, *q_norm_g, *k_norm_g, *attn_sink, *conv_dw_w, *conv_dw_b, *conv_ln_g, *conv_ln_b, *w_out, *norm2_g, *w_gate, *w_up, *ffn_dw_w, *ffn_dw_b, *w_down;
    float* out; unsigned char* ws; int ph_lo, ph_hi;
};

__device__ __forceinline__ void phase0(const Args& A, LAS unsigned char* lds, int gw, int NGW, int wave, int lane) {
    unsigned char* ws = A.ws;
    LAS float* scr = (LAS float*)(lds + wave * 16384);
    constexpr int I_IN = 16 * 56, I_O = 16 * 32, I_G = 16 * 88, I_D = 44 * 32;
    constexpr int NITEMS = I_IN + I_O + 2 * I_G + I_D;
    for (int it = gw; it < NITEMS; it += NGW) {
        int r = it;
        if (r < I_IN) {
            const int kb = r / 56, nb = r % 56, n0 = 32 * nb; int drow;
            if (n0 < 768) { const int pn = n0 >> 8, wc = (n0 >> 6) & 3, bj = (n0 >> 5) & 1; drow = 256 * pn + 128 * bj + 32 * wc; }
            else if (n0 < 1280) { const int ch = n0 - 768; drow = 256 * (3 + (ch >> 7)) + (ch & 127); }
            else { const int ch = n0 - 1280; drow = 256 * (3 + (ch >> 7)) + 128 + (ch & 127); }
            transpose_item(A.w_in, 1792, 64 * kb, n0, (bf16*)(ws + WS_WIN) + (size_t)drow * 1024 + 64 * kb, 1024, nullptr, scr, lane); continue; }
        r -= I_IN;
        if (r < I_O) { const int kb = r / 32, nb = r % 32; transpose_item(A.w_out, 1024, 64 * kb, 32 * nb, (bf16*)(ws + WS_WO) + (size_t)(32 * nb) * 1024 + 64 * kb, 1024, nullptr, scr, lane); continue; }
        r -= I_O;
        if (r < 2 * I_G) { const int up = r >= I_G; if (up) r -= I_G; const int kb = r / 88, nb = r % 88, ch = 32 * nb; const int drow = 256 * (ch >> 7) + 128 * up + (ch & 127);
            transpose_item(up ? A.w_up : A.w_gate, DFF, 64 * kb, ch, (bf16*)(ws + WS_WGU) + (size_t)drow * 1024 + 64 * kb, 1024, A.norm2_g, scr, lane); continue; }
        r -= 2 * I_G;
        { const int kb = r / 32, nb = r % 32, k0 = 64 * kb;
          if (k0 < NA) transpose_item(A.w_down, 1024, k0, 32 * nb, (bf16*)(ws + WS_WDA) + (size_t)(32 * nb) * NA + k0, NA, nullptr, scr, lane);
          else transpose_item(A.w_down, 1024, k0, 32 * nb, (bf16*)(ws + WS_WDB) + (size_t)(32 * nb) * NB + (k0 - NA), NB, nullptr, scr, lane); }
    }
    f32x4 g[4];
#pragma unroll
    for (int j = 0; j < 4; ++j) g[j] = ((const f32x4*)A.norm1_g)[lane + 64 * j];
    bf16* H = (bf16*)(ws + WS_H);
    for (int m = gw; m < M_TOK; m += NGW) {
        const float* xrow = (m < M_PROMPT) ? A.xp + (size_t)m * DM : A.xs + (size_t)(m - M_PROMPT) * DM;
        f32x4 v[4]; float s = 0.f;
#pragma unroll
        for (int j = 0; j < 4; ++j) { v[j] = ((const f32x4*)xrow)[lane + 64 * j]; s += (v[j][0] * v[j][0] + v[j][1] * v[j][1]) + (v[j][2] * v[j][2] + v[j][3] * v[j][3]); }
        const float rs = __builtin_amdgcn_rsqf(wave_sum(s) * (1.0f / DM) + 1e-6f);
        uint2* o8 = (uint2*)(H + (size_t)m * DM) + lane;
#pragma unroll
        for (int j = 0; j < 4; ++j) { const f32x4 y = v[j] * rs * g[j]; uint2 w; w.x = cvt_pk_bf16(y[0], y[1]); w.y = cvt_pk_bf16(y[2], y[3]); o8[64 * j] = w; }
    }
}

constexpr int KP = 144, VP = 776;
constexpr int LDS_KOFF = 0, LDS_VOFF = 384 * KP;
__device__ __forceinline__ void attn_item(const Args& A, LAS unsigned char* lds, int item, int tid, int wave, int lane, float bound) {
    const bf16* Q = (const bf16*)(A.ws + WS_Q); const bf16* Kg = (const bf16*)(A.ws + WS_K); const bf16* VT = (const bf16*)(A.ws + WS_VT); bf16* MIX = (bf16*)(A.ws + WS_H);
    const int blk = item >> 1, kvh = item & 1, q0 = blk * 128, band0 = q0 - 128;
    int s0, s1; seq_bounds(q0, s0, s1);
    const int vlo = (q0 == s0) ? 128 : 0, vhi = (q0 + 128 == s1) ? 256 : 384;
    for (int c = tid; c < 384 * 8; c += NTHR) {
        const int i = c >> 3, part = c & 7;
        if (i >= vlo && i < vhi) { const v4u v = *(const v4u*)(Kg + (size_t)(band0 + i) * 128 + kvh * 64 + part * 8); *(LAS v4u*)(lds + LDS_KOFF + i * KP + part * 16) = v; }
    }
    for (int c = tid; c < 64 * 48; c += NTHR) {
        const int d = c / 48, part = c % 48, i = part * 8;
        if (i >= vlo && i < vhi) { const v4u v = *(const v4u*)(VT + (size_t)(kvh * 64 + d) * M_TOK + band0 + i);
            LAS v2u* p = (LAS v2u*)(lds + LDS_VOFF + d * VP + part * 16); p[0] = (v2u){v.x, v.y}; p[1] = (v2u){v.z, v.w}; }
    }
    __syncthreads();
    const int hl = wave >> 1, head = kvh * 4 + hl, r = lane & 31, h = lane >> 5;
    const float slope2 = LOG2E * __builtin_amdgcn_exp2f(-(float)(head + 1));
    const float sink = A.attn_sink[head];
    const float m2 = LOG2E * fmaxf(bound, sink), sinkterm = __builtin_amdgcn_exp2f(LOG2E * sink - m2);
#pragma unroll 1
    for (int qs = 0; qs < 2; ++qs) {
        const int qt = 128 + 64 * (wave & 1) + 32 * qs;
        const bf16* qrow = Q + (size_t)(band0 + qt + r) * 512 + head * 64 + 8 * h;
        bf16x8 qf[4];
#pragma unroll
        for (int kk = 0; kk < 4; ++kk) qf[kk] = *(const bf16x8*)(qrow + 16 * kk);
        f32x16 O0, O1;
#pragma unroll
        for (int i = 0; i < 16; ++i) { O0[i] = 0.f; O1[i] = 0.f; }
        float lsum = 0.f;
        const int kb_lo = max(qt - 128, vlo), kb_hi = min(qt + 160, vhi);
#pragma unroll 1
        for (int kb = kb_lo; kb < kb_hi; kb += 32) {
            f32x16 S;
#pragma unroll
            for (int i = 0; i < 16; ++i) S[i] = -m2;
            const LAS unsigned char* kp = lds + LDS_KOFF + (kb + r) * KP + h * 16;
#pragma unroll
            for (int kk = 0; kk < 4; ++kk) { const bf16x8 kf = *(const LAS bf16x8*)(kp + kk * 32); S = __builtin_amdgcn_mfma_f32_32x32x16_bf16(kf, qf[kk], S, 0, 0, 0); }
            const float dbase = (float)(qt + r - kb - 4 * h);
            float p[16];
#pragma unroll
            for (int i = 0; i < 16; ++i) {
                const float d = dbase - (float)((i & 3) + 8 * (i >> 2));
                const float t = S[i] - slope2 * fabsf(d);
                const float e = __builtin_amdgcn_exp2f(t);
                p[i] = (fabsf(d) <= 128.0f) ? e : 0.f; lsum += p[i];
            }
#pragma unroll
            for (int s = 0; s < 2; ++s) {
                v4u pk; pk.x = cvt_pk_bf16(p[8 * s], p[8 * s + 1]); pk.y = cvt_pk_bf16(p[8 * s + 2], p[8 * s + 3]); pk.z = cvt_pk_bf16(p[8 * s + 4], p[8 * s + 5]); pk.w = cvt_pk_bf16(p[8 * s + 6], p[8 * s + 7]);
                const bf16x8 ps = __builtin_bit_cast(bf16x8, pk);
                const LAS unsigned char* vp = lds + LDS_VOFF + r * VP + (kb + 16 * s + 4 * h) * 2;
                { const s16x4 lo = *(const LAS s16x4*)(vp), hi = *(const LAS s16x4*)(vp + 16);
                  const bf16x8 vf = __builtin_shufflevector(lo, hi, 0, 1, 2, 3, 4, 5, 6, 7); O0 = __builtin_amdgcn_mfma_f32_32x32x16_bf16(vf, ps, O0, 0, 0, 0); }
                { const s16x4 lo = *(const LAS s16x4*)(vp + 32 * VP), hi = *(const LAS s16x4*)(vp + 32 * VP + 16);
                  const bf16x8 vf = __builtin_shufflevector(lo, hi, 0, 1, 2, 3, 4, 5, 6, 7); O1 = __builtin_amdgcn_mfma_f32_32x32x16_bf16(vf, ps, O1, 0, 0, 0); }
            }
        }
        const float l = lsum + __shfl_xor(lsum, 32);
        const float inv = 1.0f / (l + sinkterm);
        bf16* orow = MIX + (size_t)(band0 + qt + r) * DM + head * 64 + 4 * h;
#pragma unroll
        for (int g = 0; g < 4; ++g) {
            uint2 w; w.x = cvt_pk_bf16(O0[4 * g] * inv, O0[4 * g + 1] * inv); w.y = cvt_pk_bf16(O0[4 * g + 2] * inv, O0[4 * g + 3] * inv); *(uint2*)(orow + 8 * g) = w;
            uint2 x; x.x = cvt_pk_bf16(O1[4 * g] * inv, O1[4 * g + 1] * inv); x.y = cvt_pk_bf16(O1[4 * g + 2] * inv, O1[4 * g + 3] * inv); *(uint2*)(orow + 32 + 8 * g) = x;
        }
    }
    __syncthreads();
}

constexpr int LDS_ST = 96 * 1024;
__device__ __forceinline__ void conv_item(const Args& A, LAS unsigned char* lds, int item, int tid, int wave, int lane, const float (&w)[31][2], float2 bias, float2 lg, float2 lb) {
    const bf16* U = (const bf16*)(A.ws + WS_U); bf16* MIX = (bf16*)(A.ws + WS_H);
    const int t0 = item * 64; int s0, s1; seq_bounds(t0, s0, s1);
    for (int c = tid; c < 94 * 64; c += NTHR) {
        const int i = c >> 6, part = c & 63, tok = t0 - 15 + i;
        v4u v = {0u, 0u, 0u, 0u};
        if (tok >= s0 && tok < s1) v = *(const v4u*)(U + (size_t)tok * 512 + part * 8);
        *(LAS v4u*)(lds + i * 1024 + part * 16) = v;
    }
    const int cp = tid & 255, tgb = tid >> 8;
    __syncthreads();
    LAS float* ST = (LAS float*)(lds + LDS_ST);
#pragma unroll 1
    for (int it = 0; it < 4; ++it) {
        const int tg = tgb + 2 * it;
        float res[8][2];
#pragma unroll
        for (int t = 0; t < 8; ++t) { res[t][0] = bias.x; res[t][1] = bias.y; }
        const LAS unsigned* xp = (const LAS unsigned*)(lds + (8 * tg) * 1024 + cp * 4);
#pragma unroll
        for (int c8 = 0; c8 < 5; ++c8) {
            unsigned xr[8];
#pragma unroll
            for (int q = 0; q < 8; ++q) { const int ii = 8 * c8 + q; if (ii < 38) xr[q] = xp[ii * 256]; }
            __builtin_amdgcn_sched_barrier(0);
#pragma unroll
            for (int q = 0; q < 8; ++q) { const int ii = 8 * c8 + q; if (ii < 38) {
                const float x0 = __uint_as_float(xr[q] << 16), x1 = __uint_as_float(xr[q] & 0xffff0000u);
#pragma unroll
                for (int t = 0; t < 8; ++t) { const int j = ii - t; if (j >= 0 && j <= 30) { res[t][0] += w[j][0] * x0; res[t][1] += w[j][1] * x1; } } } }
            __builtin_amdgcn_sched_barrier(0);
        }
#pragma unroll
        for (int t = 0; t < 8; ++t) {
            const float a0 = res[t][0], a1 = res[t][1];
            const float s1v = wave_sum(a0 + a1), s2v = wave_sum(a0 * a0 + a1 * a1);
            if (lane == 0) { ST[((8 * tg + t) * 4 + (wave & 3)) * 2] = s1v; ST[((8 * tg + t) * 4 + (wave & 3)) * 2 + 1] = s2v; }
        }
        __syncthreads();
#pragma unroll
        for (int t = 0; t < 8; ++t) {
            const LAS f32x4* sp = (const LAS f32x4*)(ST + (8 * tg + t) * 8); const f32x4 a = sp[0], b = sp[1];
            const float mean = ((a[0] + a[2]) + (b[0] + b[2])) * (1.0f / 512.0f), ex2 = ((a[1] + a[3]) + (b[1] + b[3])) * (1.0f / 512.0f);
            const float rstd = __builtin_amdgcn_rsqf(fmaxf(ex2 - mean * mean, 0.f) + 1e-5f);
            const float y0 = (res[t][0] - mean) * rstd * lg.x + lb.x, y1 = (res[t][1] - mean) * rstd * lg.y + lb.y;
            *(unsigned*)(MIX + (size_t)(t0 + 8 * tg + t) * DM + 512 + 2 * cp) = cvt_pk_bf16(fast_silu(y0), fast_silu(y1));
        }
    }
    __syncthreads();
}

__device__ __forceinline__ void fix_edges(const Args& A, int ncols, int chbase, int gtid, int gthreads) {
    const float* ge = (const float*)(A.ws + WS_GE); const float* ue = (const float*)(A.ws + WS_UE); bf16* act = (bf16*)(A.ws + WS_H);
    const int ng = ncols >> 2, total = 512 * 2 * ng;
    for (int idx = gtid; idx < total; idx += gthreads) {
        const int cg4 = idx % ng, rw = idx / ng, which = rw & 1, chunk = rw >> 1, col = 4 * cg4;
        const int row = 64 * chunk + (which ? 63 : 0); int s0, s1; seq_bounds(row, s0, s1);
        const f32x4 zero = {0.f, 0.f, 0.f, 0.f};
        f32x4 pv, cur, nx, up;
        if (which == 0) { pv = (row == s0) ? zero : *(const f32x4*)(ge + ((size_t)(chunk - 1) * 4 + 3) * ncols + col); cur = *(const f32x4*)(ge + ((size_t)chunk * 4 + 0) * ncols + col); nx = *(const f32x4*)(ge + ((size_t)chunk * 4 + 1) * ncols + col); up = *(const f32x4*)(ue + ((size_t)chunk * 2) * ncols + col); }
        else { pv = *(const f32x4*)(ge + ((size_t)chunk * 4 + 2) * ncols + col); cur = *(const f32x4*)(ge + ((size_t)chunk * 4 + 3) * ncols + col); nx = (row + 1 == s1) ? zero : *(const f32x4*)(ge + ((size_t)(chunk + 1) * 4 + 0) * ncols + col); up = *(const f32x4*)(ue + ((size_t)chunk * 2 + 1) * ncols + col); }
        const int gc = chbase + col;
        const f32x4 w0 = *(const f32x4*)(A.ffn_dw_w + gc), w1 = *(const f32x4*)(A.ffn_dw_w + DFF + gc), w2 = *(const f32x4*)(A.ffn_dw_w + 2 * DFF + gc), bb = *(const f32x4*)(A.ffn_dw_b + gc);
        float o[4];
#pragma unroll
        for (int j = 0; j < 4; ++j) { const float cv = bb[j] + w0[j] * pv[j] + w1[j] * cur[j] + w2[j] * nx[j]; o[j] = fast_silu(cv) * up[j]; }
        uint2 w; w.x = cvt_pk_bf16(o[0], o[1]); w.y = cvt_pk_bf16(o[2], o[3]);
        *(uint2*)(act + (size_t)row * ncols + col) = w;
    }
}

#define XB_TMO      128
#define XB_XCNT(j)  (256  + 64 * (j))
#define XB_XSUB(j)  (1280 + 64 * (j))
#define XB_XGEN(j)  (2304 + 64 * (j))
#define XB_TOP      3328
#define XB_TOPGEN   3392
#define XCD_BAR_WORDS 3456
#define XB_SPIN_CAP (1u << 18)

__device__ __forceinline__ unsigned xb_ld(unsigned* p)              { return __hip_atomic_load(p, __ATOMIC_RELAXED, __HIP_MEMORY_SCOPE_AGENT); }
__device__ __forceinline__ unsigned xb_add(unsigned* p, unsigned v) { return __hip_atomic_fetch_add(p, v, __ATOMIC_RELAXED, __HIP_MEMORY_SCOPE_AGENT); }
__device__ __forceinline__ unsigned xb_xcc_id() { return (unsigned)__builtin_amdgcn_s_getreg((3 << 11) | 20) & 0xFu; }
#define XB_SPIN(cond, bar) do { unsigned _sp = 0; while (cond) { __builtin_amdgcn_s_sleep(1); \
    if ((++_sp & 255u) == 0u) { if (xb_ld(&(bar)[XB_TMO])) break; if (_sp > XB_SPIN_CAP) { atomicAdd(&(bar)[XB_TMO], 1u); break; } } } } while (0)

struct XcdBarrier {
    unsigned* bar; unsigned x;
    volatile LAS unsigned* st;
};

__device__ __forceinline__ XcdBarrier xcd_barrier_post(unsigned* bar, volatile LAS unsigned* st) {
    XcdBarrier b; b.bar = bar; b.x = xb_xcc_id(); b.st = st;
    if (threadIdx.x == 0) (void)xb_add(&bar[XB_XCNT(b.x)], 1u);
    return b;
}
__device__ __forceinline__ void xcd_barrier_complete(unsigned* bar, unsigned x, unsigned& nloc, unsigned& nx) {
    const unsigned G = gridDim.x * gridDim.y * gridDim.z;
    unsigned sum, cnt, mine, sp = 0u;
    for (;;) {
        sum = 0u; cnt = 0u; mine = 0u;
#pragma unroll
        for (unsigned j = 0; j < 16; ++j) { const unsigned c = xb_ld(&bar[XB_XCNT(j)]); sum += c; cnt += (c > 0u) ? 1u : 0u; mine = (j == x) ? c : mine; }
        if (sum == G) break;
        __builtin_amdgcn_s_sleep(1);
        if ((++sp & 255u) == 0u) { if (xb_ld(&bar[XB_TMO])) break; if (sp > XB_SPIN_CAP) { atomicAdd(&bar[XB_TMO], 1u); break; } }
    }
    nloc = mine > 0u ? mine : 1u; nx = cnt > 0u ? cnt : 1u;
}

__device__ __forceinline__ void xcd_barrier(const XcdBarrier& b) {
    asm volatile("s_waitcnt vmcnt(0)" ::: "memory");
    __syncthreads();
    if (threadIdx.x == 0) {
        unsigned* bar = b.bar;
        __builtin_amdgcn_s_waitcnt(0);
        unsigned nloc = b.st[0], nx = b.st[1];
        if (nloc == 0u) { xcd_barrier_complete(bar, b.x, nloc, nx); b.st[0] = nloc; b.st[1] = nx; }
        const unsigned old = xb_add(&bar[XB_XSUB(b.x)], 1u);
        const unsigned gen = old / nloc;
        if (old + 1u == (gen + 1u) * nloc) {
            __builtin_amdgcn_fence(__ATOMIC_RELEASE, "agent");
            asm volatile("s_waitcnt vmcnt(0)" ::: "memory");
            const unsigned og = xb_add(&bar[XB_TOP], 1u);
            const unsigned tg = og / nx;
            if (og + 1u == (tg + 1u) * nx) xb_add(&bar[XB_TOPGEN], 1u);
            else XB_SPIN(xb_ld(&bar[XB_TOPGEN]) == tg, bar);
            __builtin_amdgcn_fence(__ATOMIC_ACQUIRE, "agent");
            xb_add(&bar[XB_XGEN(b.x)], 1u);
            asm volatile("s_waitcnt vmcnt(0)" ::: "memory");
        } else {
            XB_SPIN(xb_ld(&bar[XB_XGEN(b.x)]) == gen, bar);
            __builtin_amdgcn_fence(__ATOMIC_ACQUIRE, "agent");
            asm volatile("s_waitcnt vmcnt(0)" ::: "memory");
        }
    }
    __syncthreads();
}
__global__ void __launch_bounds__(NTHR, 2) hymba_fwd(Args A) {
    extern __shared__ __attribute__((aligned(16))) unsigned char lds_raw[];
    LAS unsigned char* lds = (LAS unsigned char*)lds_raw;
    cg::grid_group grid = cg::this_grid();
    const int tid = threadIdx.x, lane = tid & 63, wave = __builtin_amdgcn_readfirstlane(tid >> 6);
    const int G = gridDim.x, bx = blockIdx.x;
    const int gw = bx * NWAVES + wave, NGW = G * NWAVES;
    unsigned char* ws = A.ws;
    const int lo = A.ph_lo, hi = A.ph_hi;
    volatile LAS unsigned* xb_st = (volatile LAS unsigned*)(lds + 131072 + 8192);
    if (tid < 4) xb_st[tid] = 0u;
    __syncthreads();
    const XcdBarrier xbar = xcd_barrier_post((unsigned*)(ws + WS_BAR), xb_st);
    if (lo > 1000) grid.sync();
#ifndef PMASK
#define PMASK 0x3ff
#endif
#define IN(k) (((PMASK >> (k)) & 1) && lo <= (k) && (k) < hi)
#ifndef REPMASK
#define REPMASK 0
#endif
#ifndef XSYNC
#define XSYNC 0
#endif
#define REPS(k) (((REPMASK >> (k)) & 1) ? 2 : 1)
#define SEAM(k) do { if (IN(k) && IN((k) + 1)) { xcd_barrier(xbar); if ((k) == 0) for (int xs_ = 0; xs_ < XSYNC; ++xs_) xcd_barrier(xbar); } } while (0)
    if (IN(0)) for (int rep = 0; rep < REPS(0); ++rep) phase0(A, lds, gw, NGW, wave, lane);
    SEAM(0);
    if (IN(1)) for (int rep = 0; rep < REPS(1); ++rep) {
        pg8::Gemm g{(const pg8::bf16_t*)(ws + WS_H), (const pg8::bf16_t*)(ws + WS_WIN), M_TOK, 1792, 1024}; pg8::StaticOrder S; S.init(M_TOK, 1792, G, bx);
        pg8::EpiInProj E{(pg8::bf16_t*)(ws + WS_Q), (pg8::bf16_t*)(ws + WS_K), (pg8::bf16_t*)(ws + WS_VT), (pg8::bf16_t*)(ws + WS_U), A.q_norm_g, A.k_norm_g};
        pg8::gemm_phase<pg8::EpiInProj, pg8::StaticOrder, true, true>(lds, g, S, E);
    }
    SEAM(1);
    if (IN(2)) for (int rep = 0; rep < REPS(2); ++rep) {
        const float gqm = wave_max(fabsf(A.q_norm_g[lane])), gkm = wave_max(fabsf(A.k_norm_g[lane]));
        const float bound = 8.0f * gqm * gkm;
#ifndef NO_ATTN
        for (int it = bx; it < 512; it += G) attn_item(A, lds, it, tid, wave, lane, bound);
#endif
#ifndef NO_CONV
        {
            const int cp = tid & 255;
            float w[31][2];
#pragma unroll
            for (int j = 0; j < 31; ++j) { const float2 t = *(const float2*)(A.conv_dw_w + j * 512 + 2 * cp); w[j][0] = t.x; w[j][1] = t.y; }
            const float2 bias = *(const float2*)(A.conv_dw_b + 2 * cp), lg = *(const float2*)(A.conv_ln_g + 2 * cp), lb = *(const float2*)(A.conv_ln_b + 2 * cp);
#pragma unroll 1
            for (int it = bx; it < 512; it += G) conv_item(A, lds, it, tid, wave, lane, w, bias, lg, lb);
        }
#endif
    }
    SEAM(2);
    if (IN(3)) for (int rep = 0; rep < REPS(3); ++rep) {
        pg8::Gemm g{(const pg8::bf16_t*)(ws + WS_H), (const pg8::bf16_t*)(ws + WS_WO), M_TOK, 1024, 1024}; pg8::StaticOrder S; S.init(M_TOK, 1024, G, bx);
        pg8::EpiOutProj E{A.xp, A.xs, A.out, (pg8::bf16_t*)(ws + WS_X1B), (float*)(ws + WS_SSQ), (LAS float*)(lds + 131072)};
        pg8::gemm_phase<pg8::EpiOutProj, pg8::StaticOrder, true, true>(lds, g, S, E);
    }
    SEAM(3);
#pragma unroll
    for (int part = 0; part < 2; ++part) {
        const int ncols = part ? NB : NA, chbase = part ? NA : 0, pb = 4 + 3 * part;
        if (IN(pb)) for (int rep = 0; rep < REPS(4); ++rep) {
            pg8::Gemm g{(const pg8::bf16_t*)(ws + WS_X1B), (const pg8::bf16_t*)(ws + WS_WGU) + (size_t)(2 * chbase) * 1024, M_TOK, 2 * ncols, 1024}; pg8::StaticOrder S; S.init(M_TOK, 2 * ncols, G, bx);
            pg8::EpiGateUp E{(pg8::bf16_t*)(ws + WS_H), (float*)(ws + WS_GE), (float*)(ws + WS_UE), (const float*)(ws + WS_SSQ), A.ffn_dw_w, A.ffn_dw_b, ncols, chbase};
            pg8::gemm_phase<pg8::EpiGateUp, pg8::StaticOrder, true, true>(lds, g, S, E);
        }
        SEAM(pb);
        if (IN(pb + 1)) for (int rep = 0; rep < REPS(5); ++rep) fix_edges(A, ncols, chbase, bx * NTHR + tid, G * NTHR);
        SEAM(pb + 1);
        if (IN(pb + 2)) {
            pg8::Gemm g{(const pg8::bf16_t*)(ws + WS_H), (const pg8::bf16_t*)(ws + (part ? WS_WDB : WS_WDA)), M_TOK, 1024, ncols}; pg8::StaticOrder S; S.init(M_TOK, 1024, G, bx);
            pg8::EpiDown E{A.out};
            pg8::gemm_phase<pg8::EpiDown, pg8::StaticOrder, true, true>(lds, g, S, E);
        }
        SEAM(pb + 2);
    }
#undef IN
#undef SEAM
}

#ifndef N_LAUNCH_PER_PHASE
#define N_LAUNCH_PER_PHASE 0
#endif
extern "C" void kernel_launch(void* const* d_in, const int* in_sizes, int n_in, void* d_out, int out_size, void* d_ws, size_t ws_size, hipStream_t stream) {
    static int grid = 0;
    if (grid == 0) {
        if (n_in != 18 || out_size != M_TOK * DM || ws_size < WS_END) { fprintf(stderr, "kernel_launch: unexpected shapes (n_in %d out %d ws %zu)\n", n_in, out_size, ws_size); grid = -1; return; }
        int dev = 0, cus = 0, per_cu = 0;
        hipGetDevice(&dev); hipDeviceGetAttribute(&cus, hipDeviceAttributeMultiprocessorCount, dev);
        if (hipFuncSetAttribute((const void*)hymba_fwd, hipFuncAttributeMaxDynamicSharedMemorySize, LDS_BYTES) != hipSuccess) { fprintf(stderr, "kernel_launch: hipFuncSetAttribute failed\n"); grid = -1; return; }
        if (hipOccupancyMaxActiveBlocksPerMultiprocessor(&per_cu, (const void*)hymba_fwd, NTHR, LDS_BYTES) != hipSuccess || per_cu < 1) { fprintf(stderr, "kernel_launch: occupancy query says %d\n", per_cu); per_cu = 1; }
        (void)hipGetLastError();
        grid = cus * 1;
    }
    if (grid < 0) return;
    if (hipMemsetAsync((char*)d_ws + WS_BAR, 0, BAR_BYTES, stream) != hipSuccess) { fprintf(stderr, "kernel_launch: memset failed\n"); return; }
    Args a{};
    const float** slots = (const float**)&a;
    for (int i = 0; i < 18; ++i) slots[i] = (const float*)d_in[i];
    a.out = (float*)d_out; a.ws = (unsigned char*)d_ws;
#if N_LAUNCH_PER_PHASE
    for (int p = 0; p < 10; ++p) { a.ph_lo = p; a.ph_hi = p + 1; hipLaunchKernelGGL(hymba_fwd, dim3(grid), dim3(NTHR), LDS_BYTES, stream, a); }
#else
    a.ph_lo = 0; a.ph_hi = 10;
    void* args[] = {&a};
    hipError_t e = hipLaunchCooperativeKernel((const void*)hymba_fwd, dim3(grid), dim3(NTHR), args, LDS_BYTES, stream);
    if (e != hipSuccess) fprintf(stderr, "cooperative launch failed: %s (grid %d)\n", hipGetErrorString(e), grid);
#endif
}
```

```cpp
#include <hip/hip_runtime.h>
#include <hip/hip_cooperative_groups.h>
#include <cstdio>
#include <cstdint>
namespace cg = cooperative_groups;
namespace pg8 {
#define PG8_LAS __attribute__((address_space(3)))
typedef unsigned short bf16_t;
typedef short bf16x8 __attribute__((ext_vector_type(8)));
typedef float f32x4 __attribute__((ext_vector_type(4)));
typedef unsigned u32x4 __attribute__((ext_vector_type(4)));
constexpr int BM = 256, BK = 64, HALF = 128, HTB = HALF * BK * 2  , STAGE_BYTES = 8 * HTB, NXCD = 8, WGM = 8;

__host__ __device__ __forceinline__ int lds_byte(int r, int c) { const int st = (r >> 4) * 2 + (c >> 5), rr = r & 15, cc = c & 31, ob = rr * 64 + cc * 2; return st * 1024 + (ob ^ (((ob >> 9) & 1) << 5)); }
__host__ __device__ __forceinline__ void stage_rc(int b, int& R, int& C) { const int st = b / 1024, sb = b % 1024, swz = sb ^ (((sb >> 9) & 1) << 5); R = (st >> 1) * 16 + swz / 64; C = (st & 1) * 32 + (swz % 64) / 2; }
__host__ __device__ __forceinline__ int perm32(int rho) { const int n = rho >> 4, i = rho & 15; return 8 * (i >> 2) + 4 * n + (i & 3); }

struct Unit { int pm, pn; };
struct Gemm { const bf16_t* A; const bf16_t* Bt; int M, N, K; };

struct StaticOrder {
    int nM, nN, nwg, G, c, rep = 1;
    __host__ __device__ void init(int M, int N, int G_, int c_) { nM = M / BM; nN = N / BM; nwg = nM * nN; G = G_; c = c_; }
    __host__ __device__ bool next(int i, Unit& u) const {
        const int rounds = (nwg - c + G - 1) / G; if (i >= rep * rounds) return false; const long L = (long)(i % rounds) * G + c;
        int wgid = (int)L; { const int q = nwg / NXCD, r = nwg % NXCD, xcd = wgid % NXCD, off = wgid / NXCD; wgid = (xcd < r ? xcd * (q + 1) : r * (q + 1) + (xcd - r) * q) + off; }
        const int nig = WGM * nN, gid = wgid / nig, fm = gid * WGM, gsz = (nM - fm) < WGM ? (nM - fm) : WGM;
        u.pm = fm + ((wgid % nig) % gsz); u.pn = (wgid % nig) / gsz; return true;
    }
    __device__ __forceinline__ void a_ready(const Unit&) const {}
    __device__ __forceinline__ void done(const Unit&) const {}
};

__device__ __forceinline__ unsigned cvt_pk_bf16(float lo, float hi) { unsigned r; asm volatile("v_cvt_pk_bf16_f32 %0, %1, %2" : "=v"(r) : "v"(lo), "v"(hi)); return r; }
typedef float f32x2 __attribute__((ext_vector_type(2)));
constexpr int M_TOK = 32768, DM = 1024, M_PROMPT = 16384, T_PROMPT = 2048, T_SAMPLE = 8192, DFF = 2816;
constexpr float LOG2E = 1.4426950408889634f;
constexpr float QSCALE = 0.125f * LOG2E;
__device__ __forceinline__ void seq_bounds(int row, int& s0, int& s1) {
    if (row < M_PROMPT) { s0 = row & ~(T_PROMPT - 1); s1 = s0 + T_PROMPT; }
    else { s0 = M_PROMPT + ((row - M_PROMPT) & ~(T_SAMPLE - 1)); s1 = s0 + T_SAMPLE; }
}
__device__ __forceinline__ float fast_sigmoid(float v) { return __builtin_amdgcn_rcpf(1.0f + __builtin_amdgcn_exp2f(-LOG2E * v)); }
__device__ __forceinline__ float fast_silu(float v) { return v * fast_sigmoid(v); }

struct EpiInProj {
    static constexpr bool PERM = true, AFTER_DRAIN = false;
    bf16_t* Q; bf16_t* Kb; bf16_t* VT; bf16_t* U; const float* gq; const float* gk;
    __device__ __forceinline__ void operator()(f32x4 (&acc)[2][2][4][2], const Unit& u, int wr, int wc, int fr, int fq) const {
        asm volatile("" : "+v"(fr), "+v"(fq));
        const int row0 = u.pm * BM + wr * 64 + fr;
        if (u.pn < 3) {
            const bool isq = u.pn < 2, isk = (u.pn == 2) && (wc < 2);
            if (isq || isk) {
                const float* g = isq ? gq : gk; const float sc = isq ? QSCALE : 1.0f;
                f32x4 gv[2][2];
#pragma unroll
                for (int bj = 0; bj < 2; ++bj)
#pragma unroll
                    for (int n = 0; n < 2; ++n) gv[bj][n] = *(const f32x4*)(g + 32 * bj + 8 * fq + 4 * n) * sc;
                bf16_t* dst = isq ? (Q + (size_t)(u.pn * 4 + wc) * 64) : (Kb + (size_t)wc * 64);
                const int pitch = isq ? 512 : 128;
#pragma unroll
                for (int ai = 0; ai < 2; ++ai)
#pragma unroll
                    for (int m = 0; m < 4; ++m) {
                        float s = 0.f;
#pragma unroll
                        for (int bj = 0; bj < 2; ++bj)
#pragma unroll
                            for (int n = 0; n < 2; ++n) { const f32x4 x = acc[ai][bj][m][n]; s += (x[0] * x[0] + x[1] * x[1]) + (x[2] * x[2] + x[3] * x[3]); }
                        s += __shfl_xor(s, 16); s += __shfl_xor(s, 32);
                        const float rs = __builtin_amdgcn_rsqf(s * (1.0f / 64.0f) + 1e-6f);
                        bf16_t* rowp = dst + (size_t)(row0 + ai * HALF + m * 16) * pitch + 8 * fq;
#pragma unroll
                        for (int bj = 0; bj < 2; ++bj) {
                            const f32x4 v0 = acc[ai][bj][m][0] * rs * gv[bj][0], v1 = acc[ai][bj][m][1] * rs * gv[bj][1];
                            u32x4 w; w.x = cvt_pk_bf16(v0[0], v0[1]); w.y = cvt_pk_bf16(v0[2], v0[3]); w.z = cvt_pk_bf16(v1[0], v1[1]); w.w = cvt_pk_bf16(v1[2], v1[3]);
                            *(u32x4*)(rowp + 32 * bj) = w;
                        }
                    }
            } else {
                bf16_t* vt = VT + (size_t)(wc - 2) * 64 * M_TOK;
#pragma unroll
                for (int ai = 0; ai < 2; ++ai)
#pragma unroll
                    for (int m = 0; m < 4; ++m) {
                        const int row = row0 + ai * HALF + m * 16;
#pragma unroll
                        for (int bj = 0; bj < 2; ++bj)
#pragma unroll
                            for (int n = 0; n < 2; ++n) {
                                const f32x4 x = acc[ai][bj][m][n]; const int d0 = 32 * bj + 8 * fq + 4 * n;
                                const unsigned p01 = cvt_pk_bf16(x[0], x[1]), p23 = cvt_pk_bf16(x[2], x[3]);
                                vt[(size_t)(d0 + 0) * M_TOK + row] = (bf16_t)(p01 & 0xffffu); vt[(size_t)(d0 + 1) * M_TOK + row] = (bf16_t)(p01 >> 16);
                                vt[(size_t)(d0 + 2) * M_TOK + row] = (bf16_t)(p23 & 0xffffu); vt[(size_t)(d0 + 3) * M_TOK + row] = (bf16_t)(p23 >> 16);
                            }
                    }
            }
        } else {
            bf16_t* dst = U + (size_t)(u.pn - 3) * 128 + 32 * wc + 8 * fq;
#pragma unroll
            for (int ai = 0; ai < 2; ++ai)
#pragma unroll
                for (int m = 0; m < 4; ++m) {
                    f32x4 o[2];
#pragma unroll
                    for (int n = 0; n < 2; ++n) { const f32x4 a = acc[ai][0][m][n], g = acc[ai][1][m][n];
#pragma unroll
                        for (int j = 0; j < 4; ++j) o[n][j] = a[j] * fast_sigmoid(g[j]); }
                    u32x4 w; w.x = cvt_pk_bf16(o[0][0], o[0][1]); w.y = cvt_pk_bf16(o[0][2], o[0][3]); w.z = cvt_pk_bf16(o[1][0], o[1][1]); w.w = cvt_pk_bf16(o[1][2], o[1][3]);
                    *(u32x4*)(dst + (size_t)(row0 + ai * HALF + m * 16) * 512) = w;
                }
        }
    }
};

struct EpiOutProj {
    static constexpr bool PERM = true, AFTER_DRAIN = false;
    const float* xp; const float* xs; bf16_t* delta; bf16_t* x1b; float* ssq; PG8_LAS float* red;
    __device__ __forceinline__ void operator()(f32x4 (&acc)[2][2][4][2], const Unit& u, int wr, int wc, int fr, int fq) const {
        asm volatile("" : "+v"(fr), "+v"(fq));
        const int row0 = u.pm * BM + wr * 64 + fr, col0 = u.pn * BM + wc * 32 + 8 * fq;
        const float* xb = (u.pm * BM < M_PROMPT) ? xp : (xs - (size_t)M_PROMPT * DM);
#pragma unroll
        for (int ai = 0; ai < 2; ++ai)
#pragma unroll
            for (int m = 0; m < 4; ++m) {
                const int row = row0 + ai * HALF + m * 16; const size_t ro = (size_t)row * DM + col0; float s = 0.f;
#pragma unroll
                for (int bj = 0; bj < 2; ++bj) {
                    const f32x4 a0 = acc[ai][bj][m][0], a1 = acc[ai][bj][m][1];
                    const f32x4 v0 = a0 + *(const f32x4*)(xb + ro + bj * HALF), v1 = a1 + *(const f32x4*)(xb + ro + bj * HALF + 4);
                    s += ((v0[0] * v0[0] + v0[1] * v0[1]) + (v0[2] * v0[2] + v0[3] * v0[3])) + ((v1[0] * v1[0] + v1[1] * v1[1]) + (v1[2] * v1[2] + v1[3] * v1[3]));
                    u32x4 w; w.x = cvt_pk_bf16(a0[0], a0[1]); w.y = cvt_pk_bf16(a0[2], a0[3]); w.z = cvt_pk_bf16(a1[0], a1[1]); w.w = cvt_pk_bf16(a1[2], a1[3]);
                    *(u32x4*)(delta + ro + bj * HALF) = w;
                    u32x4 y; y.x = cvt_pk_bf16(v0[0], v0[1]); y.y = cvt_pk_bf16(v0[2], v0[3]); y.z = cvt_pk_bf16(v1[0], v1[1]); y.w = cvt_pk_bf16(v1[2], v1[3]);
                    *(u32x4*)(x1b + ro + bj * HALF) = y;
                }
                s += __shfl_xor(s, 16); s += __shfl_xor(s, 32);
                if (fq == 0) red[(ai * HALF + wr * 64 + m * 16 + fr) * 4 + wc] = s;
            }
        __syncthreads();
        const int t = threadIdx.x;
        if (t < 256) { const f32x4 v = *(const PG8_LAS f32x4*)(red + t * 4); ssq[(size_t)(u.pm * BM + t) * 4 + u.pn] = (v[0] + v[1]) + (v[2] + v[3]); }
    }
};

struct EpiGateUp {
    static constexpr bool PERM = true, AFTER_DRAIN = false;
    bf16_t* act; float* ge; float* ue; const float* ssq; const float* cw; const float* cb;
    static constexpr int ncols = DFF, chbase = 0;
    __device__ __forceinline__ void operator()(f32x4 (&acc)[2][2][4][2], const Unit& u, int wr, int wc, int fr, int fq) const {
        asm volatile("" : "+v"(fr), "+v"(fq));
        const int lane = fr + 16 * fq;
        const int ch0 = u.pn * 128 + 32 * wc + 8 * fq;
        const int lprev = (lane & 48) | ((fr + 15) & 15), lnext = (lane & 48) | ((fr + 1) & 15);
#pragma unroll
        for (int ai = 0; ai < 2; ++ai) {
            const int crow0 = u.pm * BM + ai * HALF + wr * 64;
            const int chunk = crow0 >> 6;
#pragma unroll
            for (int m = 0; m < 4; ++m) {
                const f32x4 a = *(const f32x4*)(ssq + (size_t)(crow0 + m * 16 + fr) * 4);
                const float t = (a[0] + a[1]) + (a[2] + a[3]);
                const float rstd = __builtin_amdgcn_rsqf(t * (1.0f / 1024.0f) + 1e-6f);
#pragma unroll
                for (int n = 0; n < 2; ++n) { acc[ai][0][m][n] *= rstd; acc[ai][1][m][n] *= rstd; }
            }
            if (fr < 2) {
                float* g = ge + ((size_t)chunk * 4 + fr) * ncols + ch0;
                *(f32x4*)g = acc[ai][0][0][0]; *(f32x4*)(g + 4) = acc[ai][0][0][1];
                if (fr == 0) { float* q = ue + ((size_t)chunk * 2) * ncols + ch0; *(f32x4*)q = acc[ai][1][0][0]; *(f32x4*)(q + 4) = acc[ai][1][0][1]; }
            }
            if (fr >= 14) {
                float* g = ge + ((size_t)chunk * 4 + (fr - 12)) * ncols + ch0;
                *(f32x4*)g = acc[ai][0][3][0]; *(f32x4*)(g + 4) = acc[ai][0][3][1];
                if (fr == 15) { float* q = ue + ((size_t)chunk * 2 + 1) * ncols + ch0; *(f32x4*)q = acc[ai][1][3][0]; *(f32x4*)(q + 4) = acc[ai][1][3][1]; }
            }
        }
#pragma unroll
        for (int n = 0; n < 2; ++n) {
            const int gc = chbase + ch0 + 4 * n;
            const f32x4 w0 = *(const f32x4*)(cw + gc), w1 = *(const f32x4*)(cw + DFF + gc), w2 = *(const f32x4*)(cw + 2 * DFF + gc), bb = *(const f32x4*)(cb + gc);
#pragma unroll
            for (int ai = 0; ai < 2; ++ai) {
                const int crow0 = u.pm * BM + ai * HALF + wr * 64;
                float o[4][4];
#pragma unroll
                for (int j = 0; j < 4; ++j) {
                    float R[4], L[4];
#pragma unroll
                    for (int m = 0; m < 4; ++m) { R[m] = __shfl(acc[ai][0][m][n][j], lprev); L[m] = __shfl(acc[ai][0][m][n][j], lnext); }
#pragma unroll
                    for (int m = 0; m < 4; ++m) {
                        const float pv = (m > 0 && fr == 0) ? R[m > 0 ? m - 1 : 0] : R[m];
                        const float nx = (m < 3 && fr == 15) ? L[m < 3 ? m + 1 : 3] : L[m];
                        const float cv = bb[j] + w0[j] * pv + w1[j] * acc[ai][0][m][n][j] + w2[j] * nx;
                        o[m][j] = fast_silu(cv) * acc[ai][1][m][n][j];
                    }
                }
#pragma unroll
                for (int m = 0; m < 4; ++m) {
                    const bool edge = (m == 0 && fr == 0) || (m == 3 && fr == 15);
                    if (!edge) { uint2 w; w.x = cvt_pk_bf16(o[m][0], o[m][1]); w.y = cvt_pk_bf16(o[m][2], o[m][3]);
                        *(uint2*)(act + (size_t)(crow0 + m * 16 + fr) * ncols + ch0 + 4 * n) = w; }
                }
                __builtin_amdgcn_sched_barrier(0);
            }
        }
    }
};

struct EpiDown {
    static constexpr bool PERM = true, AFTER_DRAIN = false;
    const float* xp; const float* xs; const bf16_t* delta; float* out;
    __device__ __forceinline__ void operator()(f32x4 (&acc)[2][2][4][2], const Unit& u, int wr, int wc, int fr, int fq) const {
        asm volatile("" : "+v"(fr), "+v"(fq));
        const int row0 = u.pm * BM + wr * 64 + fr, col0 = u.pn * BM + wc * 32 + 8 * fq;
        const float* xb = (u.pm * BM < M_PROMPT) ? xp : (xs - (size_t)M_PROMPT * DM);
#pragma unroll
        for (int ai = 0; ai < 2; ++ai)
#pragma unroll
            for (int m = 0; m < 4; ++m) { const size_t ro = (size_t)(row0 + ai * HALF + m * 16) * DM + col0;
#pragma unroll
                for (int bj = 0; bj < 2; ++bj) {
                    const u32x4 d = *(const u32x4*)(delta + ro + bj * HALF);
                    const f32x4 x0 = *(const f32x4*)(xb + ro + bj * HALF), x1 = *(const f32x4*)(xb + ro + bj * HALF + 4);
                    f32x4 d0, d1;
                    d0[0] = __uint_as_float(d.x << 16); d0[1] = __uint_as_float(d.x & 0xffff0000u); d0[2] = __uint_as_float(d.y << 16); d0[3] = __uint_as_float(d.y & 0xffff0000u);
                    d1[0] = __uint_as_float(d.z << 16); d1[1] = __uint_as_float(d.z & 0xffff0000u); d1[2] = __uint_as_float(d.w << 16); d1[3] = __uint_as_float(d.w & 0xffff0000u);
                    *(f32x4*)(out + ro + bj * HALF) = (x0 + d0) + acc[ai][bj][m][0];
                    *(f32x4*)(out + ro + bj * HALF + 4) = (x1 + d1) + acc[ai][bj][m][1];
                } }
    }
};
template <class Epi, class Sched, bool ALIGN_EPI = false, bool SP2 = false>
__device__ __forceinline__ void gemm_phase(PG8_LAS unsigned char* lds, const Gemm g, const Sched& S, const Epi& E) {
    const int tid = threadIdx.x, wid = __builtin_amdgcn_readfirstlane(tid >> 6), lane = tid & 63, wr = wid >> 2, wc = wid & 3, fr = lane & 15, fq = lane >> 4;
    const int K = g.K, nt = K / BK;
    unsigned voffA[2], voffB[2];
#pragma unroll
    for (int i = 0; i < 2; ++i) { int R, C; stage_rc(tid * 16 + i * 8192, R, C); const int Rb = Epi::PERM ? ((R & ~31) + perm32(R & 31)) : R;
        voffA[i] = (unsigned)(R * K + C) * 2u; voffB[i] = (unsigned)(Rb * K + C) * 2u; }
    const size_t kstep = (size_t)(BK * 2);
    const size_t hstep = (size_t)HALF * K * 2;
    const size_t tstep = 2 * hstep;
    const unsigned ldsw = (unsigned)wid * 1024u;
    const int aoff = lds_byte(wr * 64 + fr, fq * 8), boff = lds_byte(wc * 32 + fr, fq * 8);
#define PG8_SA(b, h) (((b) * 2 + (h)) * HTB)
#define PG8_SB(b, h) ((4 + (b) * 2 + (h)) * HTB)
#define PG8_STAGE(bufoff, gbase, voff) do { _Pragma("unroll") for (int _i = 0; _i < 2; ++_i) \
        __builtin_amdgcn_global_load_lds((const unsigned*)((const char*)(gbase) + (voff)[_i]), (PG8_LAS unsigned*)(lds + (bufoff) + ldsw + _i * 8192), 16, 0, 0); } while (0)
#define PG8_LDA(dst, b, h) do { _Pragma("unroll") for (int m = 0; m < 4; ++m) _Pragma("unroll") for (int k = 0; k < 2; ++k) dst[m][k] = *(const PG8_LAS bf16x8*)(lds + PG8_SA(b, h) + aoff + m * 2048 + k * 1024); } while (0)
#define PG8_LDB(dst, b, h) do { _Pragma("unroll") for (int n = 0; n < 2; ++n) _Pragma("unroll") for (int k = 0; k < 2; ++k) dst[n][k] = *(const PG8_LAS bf16x8*)(lds + PG8_SB(b, h) + boff + n * 2048 + k * 1024); } while (0)
#define PG8_MMA(ai, bj, At, Bt) do { __builtin_amdgcn_s_setprio(1); _Pragma("unroll") for (int m = 0; m < 4; ++m) _Pragma("unroll") for (int n = 0; n < 2; ++n) _Pragma("unroll") for (int k = 0; k < 2; ++k) \
        acc[ai][bj][m][n] = __builtin_amdgcn_mfma_f32_16x16x32_bf16(Bt[n][k], At[m][k], acc[ai][bj][m][n], 0, 0, 0); __builtin_amdgcn_s_setprio(0); } while (0)
#define PG8_WAIT_V(n) asm volatile("s_waitcnt vmcnt(" #n ")" ::: "memory")
#define PG8_WAIT_L(n) asm volatile("s_waitcnt lgkmcnt(" #n ")" ::: "memory")
#define PG8_BAR __builtin_amdgcn_s_barrier()
#define PG8_SCHED __builtin_amdgcn_sched_barrier(0)
    Unit cur, nxt; int ui = 0;
    if (!S.next(0, cur)) return;
    f32x4 acc[2][2][4][2];
#pragma unroll
    for (int a = 0; a < 2; ++a)
#pragma unroll
        for (int b = 0; b < 2; ++b)
#pragma unroll
            for (int m = 0; m < 4; ++m)
#pragma unroll
                for (int n = 0; n < 2; ++n) acc[a][b][m][n] = (f32x4){0.f, 0.f, 0.f, 0.f};
    bf16x8 At[4][2], B0[2][2], B1[2][2];
    const char* cA = (const char*)g.A + (size_t)cur.pm * tstep; const char* cB = (const char*)g.Bt + (size_t)cur.pn * tstep;
    S.a_ready(cur);
    if constexpr (SP2) {
        PG8_STAGE(PG8_SB(0, 0), cB, voffB); PG8_STAGE(PG8_SB(0, 1), cB + hstep, voffB); PG8_STAGE(PG8_SA(0, 0), cA, voffA); PG8_STAGE(PG8_SA(0, 1), cA + hstep, voffA);
        if (wr == 1) PG8_BAR;
        PG8_WAIT_V(2); PG8_BAR;
        PG8_STAGE(PG8_SB(1, 0), cB + kstep, voffB); PG8_STAGE(PG8_SA(1, 0), cA + kstep, voffA); PG8_STAGE(PG8_SB(1, 1), cB + hstep + kstep, voffB);
        PG8_WAIT_V(6); PG8_BAR;
    } else {
        PG8_STAGE(PG8_SB(0, 0), cB, voffB); PG8_STAGE(PG8_SA(0, 0), cA, voffA); PG8_STAGE(PG8_SB(0, 1), cB + hstep, voffB); PG8_STAGE(PG8_SA(0, 1), cA + hstep, voffA);
        if (wr == 1) PG8_BAR;
        PG8_WAIT_V(4); PG8_BAR;
        PG8_STAGE(PG8_SB(1, 0), cB + kstep, voffB); PG8_STAGE(PG8_SA(1, 0), cA + kstep, voffA); PG8_STAGE(PG8_SB(1, 1), cB + hstep + kstep, voffB);
        PG8_WAIT_V(6); PG8_BAR;
    }
    for (;;) {
        const bool has_next = S.next(ui + 1, nxt);
        const char* nA = has_next ? (const char*)g.A + (size_t)nxt.pm * tstep : cA; const char* nB = has_next ? (const char*)g.Bt + (size_t)nxt.pn * tstep : cB;
        for (int t = 0; t < nt; t += 2) {
            const bool last = (t == nt - 2);
            const char* a1 = cA + (size_t)(t + 1) * kstep;
            const char* a2 = last ? nA : cA + (size_t)(t + 2) * kstep; const char* b2 = last ? nB : cB + (size_t)(t + 2) * kstep;
            const char* a3 = a2 + kstep; const char* b3 = b2 + kstep;
            if (last && has_next) S.a_ready(nxt);
            if constexpr (SP2) {
            PG8_LDB(B0, 0, 0); PG8_LDB(B1, 0, 1); PG8_SCHED; PG8_LDA(At, 0, 0); PG8_STAGE(PG8_SA(1, 1), a1 + hstep, voffA);
            PG8_WAIT_V(8); PG8_WAIT_L(0); PG8_BAR; PG8_MMA(0, 0, At, B0); PG8_MMA(0, 1, At, B1); PG8_BAR; PG8_SCHED;
            PG8_LDA(At, 0, 1); PG8_STAGE(PG8_SB(0, 0), b2, voffB); PG8_STAGE(PG8_SB(0, 1), b2 + hstep, voffB); PG8_STAGE(PG8_SA(0, 0), a2, voffA);
            PG8_WAIT_V(8); PG8_WAIT_L(0); PG8_BAR; PG8_MMA(1, 0, At, B0); PG8_MMA(1, 1, At, B1); PG8_BAR; PG8_SCHED;
            PG8_LDB(B0, 1, 0); PG8_LDB(B1, 1, 1); PG8_SCHED; PG8_LDA(At, 1, 0); PG8_STAGE(PG8_SA(0, 1), a2 + hstep, voffA);
            PG8_WAIT_V(8); PG8_WAIT_L(0); PG8_BAR; PG8_MMA(0, 0, At, B0); PG8_MMA(0, 1, At, B1); PG8_BAR; PG8_SCHED;
            PG8_LDA(At, 1, 1); PG8_STAGE(PG8_SB(1, 0), b3, voffB); PG8_STAGE(PG8_SB(1, 1), b3 + hstep, voffB); PG8_STAGE(PG8_SA(1, 0), a3, voffA);
            PG8_WAIT_V(8); PG8_WAIT_L(0); PG8_BAR; PG8_MMA(1, 0, At, B0); PG8_MMA(1, 1, At, B1); PG8_BAR; PG8_SCHED;
            } else {
            PG8_LDB(B0, 0, 0); PG8_SCHED; PG8_LDA(At, 0, 0); PG8_STAGE(PG8_SA(1, 1), a1 + hstep, voffA);
            PG8_WAIT_L(8); PG8_BAR; PG8_WAIT_L(0); PG8_MMA(0, 0, At, B0); PG8_BAR; PG8_SCHED;
            PG8_LDB(B1, 0, 1); PG8_STAGE(PG8_SB(0, 0), b2, voffB);
            PG8_BAR; PG8_WAIT_L(0); PG8_MMA(0, 1, At, B1); PG8_BAR;
            PG8_LDA(At, 0, 1); PG8_STAGE(PG8_SA(0, 0), a2, voffA);
            PG8_BAR; PG8_WAIT_L(0); PG8_MMA(1, 0, At, B0); PG8_BAR; PG8_SCHED;
            PG8_STAGE(PG8_SB(0, 1), b2 + hstep, voffB);
            PG8_WAIT_V(6); PG8_BAR; PG8_MMA(1, 1, At, B1); PG8_BAR;
            PG8_LDB(B0, 1, 0); PG8_SCHED; PG8_LDA(At, 1, 0); PG8_STAGE(PG8_SA(0, 1), a2 + hstep, voffA);
            PG8_WAIT_L(8); PG8_BAR; PG8_WAIT_L(0); PG8_MMA(0, 0, At, B0); PG8_BAR; PG8_SCHED;
            PG8_LDB(B1, 1, 1); PG8_STAGE(PG8_SB(1, 0), b3, voffB);
            PG8_BAR; PG8_WAIT_L(0); PG8_MMA(0, 1, At, B1); PG8_BAR;
            PG8_LDA(At, 1, 1); PG8_STAGE(PG8_SA(1, 0), a3, voffA);
            PG8_BAR; PG8_WAIT_L(0); PG8_MMA(1, 0, At, B0); PG8_BAR; PG8_SCHED;
            PG8_STAGE(PG8_SB(1, 1), b3 + hstep, voffB);
            PG8_WAIT_V(6); PG8_BAR; PG8_MMA(1, 1, At, B1); PG8_BAR;
            }
        }
        if constexpr (ALIGN_EPI) { if (wr == 0) PG8_BAR; }
        if constexpr (!Epi::AFTER_DRAIN) { E(acc, cur, wr, wc, fr, fq); S.done(cur); }
        if (!has_next) break;
#pragma unroll
        for (int a = 0; a < 2; ++a)
#pragma unroll
            for (int b = 0; b < 2; ++b)
#pragma unroll
                for (int m = 0; m < 4; ++m)
#pragma unroll
                    for (int n = 0; n < 2; ++n) acc[a][b][m][n] = (f32x4){0.f, 0.f, 0.f, 0.f};
        cur = nxt; cA = nA; cB = nB; ++ui;
        if constexpr (ALIGN_EPI) { if (wr == 1) PG8_BAR; }
    }
    PG8_WAIT_V(0);
    if constexpr (!ALIGN_EPI) { if (wr == 0) PG8_BAR; }
    PG8_BAR;
    if constexpr (Epi::AFTER_DRAIN) { E.fused(acc, cur, wr, wc, fr, fq, lds, wid, lane); S.done(cur); }
#undef PG8_SA
#undef PG8_SB
#undef PG8_STAGE
#undef PG8_LDA
#undef PG8_LDB
#undef PG8_MMA
#undef PG8_WAIT_V
#undef PG8_WAIT_L
#undef PG8_BAR
#undef PG8_SCHED
}
}
#define LAS __attribute__((address_space(3)))
typedef unsigned short bf16;
typedef unsigned v4u __attribute__((ext_vector_type(4)));
typedef unsigned v2u __attribute__((ext_vector_type(2)));
typedef float f32x4 __attribute__((ext_vector_type(4)));
typedef float f32x16 __attribute__((ext_vector_type(16)));
typedef short bf16x8 __attribute__((ext_vector_type(8)));
typedef short s16x4 __attribute__((ext_vector_type(4)));
using pg8::cvt_pk_bf16; using pg8::M_TOK; using pg8::DM; using pg8::M_PROMPT; using pg8::DFF; using pg8::LOG2E; using pg8::seq_bounds; using pg8::fast_silu; using pg8::fast_sigmoid;
constexpr int NWAVES = 8, NTHR = 512;
constexpr int LDS_BYTES = 147456;
constexpr size_t MiB = 1u << 20;
constexpr size_t WS_WIN = 0, WS_WO = 4 * MiB, WS_WD = 6 * MiB, WS_SSQ = 12 * MiB, WS_BAR = 12 * MiB + 512 * 1024, BAR_BYTES = 16384;
constexpr size_t WS_H = 16 * MiB;
constexpr size_t WS_Q = 80 * MiB, WS_K = 112 * MiB, WS_VT = 120 * MiB, WS_U = 128 * MiB;
constexpr size_t WS_ACT = 16 * MiB;
constexpr size_t WS_DELTA = 192 * MiB, WS_END = 256 * MiB;
constexpr size_t DO_X1B = 0, DO_WGU = 64 * MiB, DO_GE = 76 * MiB, DO_UE = 99 * MiB;

__device__ __forceinline__ float wave_sum(float v) {
#pragma unroll
    for (int o = 1; o < 64; o <<= 1) v += __shfl_xor(v, o);
    return v;
}
__device__ __forceinline__ float wave_max(float v) {
#pragma unroll
    for (int o = 1; o < 64; o <<= 1) v = fmaxf(v, __shfl_xor(v, o));
    return v;
}
__device__ __forceinline__ void transpose_item(const float* W, int N, int k0, int n0, bf16* dst, int dpitch, const float* kscale, LAS float* scr, int lane) {
#pragma unroll 8
    for (int i = 0; i < 32; ++i) { const int kk = 2 * i + (lane >> 5); float v = W[(size_t)(k0 + kk) * N + n0 + (lane & 31)]; if (kscale) v *= kscale[k0 + kk]; scr[kk * 33 + (lane & 31)] = v; }
    asm volatile("s_waitcnt lgkmcnt(0)" ::: "memory");
    const int c = lane & 7;
#pragma unroll
    for (int j = 0; j < 4; ++j) { const int n = (lane >> 3) + 8 * j; const LAS float* s = scr + (8 * c) * 33 + n;
        v4u o; o.x = cvt_pk_bf16(s[0 * 33], s[1 * 33]); o.y = cvt_pk_bf16(s[2 * 33], s[3 * 33]); o.z = cvt_pk_bf16(s[4 * 33], s[5 * 33]); o.w = cvt_pk_bf16(s[6 * 33], s[7 * 33]);
        *(v4u*)(dst + (size_t)n * dpitch + 8 * c) = o; }
    asm volatile("s_waitcnt lgkmcnt(0)" ::: "memory");
}

struct Args {
    const float *xp, *xs, *norm1_g, *w_in, *q_norm_g, *k_norm_g, *attn_sink, *conv_dw_w, *conv_dw_b, *conv_ln_g, *conv_ln_b, *w_out, *norm2_g, *w_gate, *w_up, *ffn_dw_w, *ffn_dw_b, *w_down;
    float* out; unsigned char* ws; int ph_lo, ph_hi;
};

__device__ __forceinline__ void phase0(const Args& A, LAS unsigned char* lds, int gw, int NGW, int wave, int lane) {
    unsigned char* ws = A.ws;
    LAS float* scr = (LAS float*)(lds + wave * 16384);
    constexpr int I_IN = 16 * 56, I_O = 16 * 32, I_G = 16 * 88, I_D = 44 * 32;
    constexpr int NITEMS = I_IN + I_O + 2 * I_G + I_D;
    for (int it = gw; it < NITEMS; it += NGW) {
        int r = it;
        if (r < I_IN) {
            const int kb = r / 56, nb = r % 56, n0 = 32 * nb; int drow;
            if (n0 < 768) { const int pn = n0 >> 8, wc = (n0 >> 6) & 3, bj = (n0 >> 5) & 1; drow = 256 * pn + 128 * bj + 32 * wc; }
            else if (n0 < 1280) { const int ch = n0 - 768; drow = 256 * (3 + (ch >> 7)) + (ch & 127); }
            else { const int ch = n0 - 1280; drow = 256 * (3 + (ch >> 7)) + 128 + (ch & 127); }
            transpose_item(A.w_in, 1792, 64 * kb, n0, (bf16*)(ws + WS_WIN) + (size_t)drow * 1024 + 64 * kb, 1024, nullptr, scr, lane); continue; }
        r -= I_IN;
        if (r < I_O) { const int kb = r / 32, nb = r % 32; transpose_item(A.w_out, 1024, 64 * kb, 32 * nb, (bf16*)(ws + WS_WO) + (size_t)(32 * nb) * 1024 + 64 * kb, 1024, nullptr, scr, lane); continue; }
        r -= I_O;
        if (r < 2 * I_G) { const int up = r >= I_G; if (up) r -= I_G; const int kb = r / 88, nb = r % 88, ch = 32 * nb; const int drow = 256 * (ch >> 7) + 128 * up + (ch & 127);
            transpose_item(up ? A.w_up : A.w_gate, DFF, 64 * kb, ch, (bf16*)((unsigned char*)A.out + DO_WGU) + (size_t)drow * 1024 + 64 * kb, 1024, A.norm2_g, scr, lane); continue; }
        r -= 2 * I_G;
        { const int kb = r / 32, nb = r % 32, k0 = 64 * kb;
          transpose_item(A.w_down, 1024, k0, 32 * nb, (bf16*)(ws + WS_WD) + (size_t)(32 * nb) * DFF + k0, DFF, nullptr, scr, lane); }
    }
    f32x4 g[4];
#pragma unroll
    for (int j = 0; j < 4; ++j) g[j] = ((const f32x4*)A.norm1_g)[lane + 64 * j];
    bf16* H = (bf16*)(ws + WS_H);
    for (int m = gw; m < M_TOK; m += NGW) {
        const float* xrow = (m < M_PROMPT) ? A.xp + (size_t)m * DM : A.xs + (size_t)(m - M_PROMPT) * DM;
        f32x4 v[4]; float s = 0.f;
#pragma unroll
        for (int j = 0; j < 4; ++j) { v[j] = ((const f32x4*)xrow)[lane + 64 * j]; s += (v[j][0] * v[j][0] + v[j][1] * v[j][1]) + (v[j][2] * v[j][2] + v[j][3] * v[j][3]); }
        const float rs = __builtin_amdgcn_rsqf(wave_sum(s) * (1.0f / DM) + 1e-6f);
        uint2* o8 = (uint2*)(H + (size_t)m * DM) + lane;
#pragma unroll
        for (int j = 0; j < 4; ++j) { const f32x4 y = v[j] * rs * g[j]; uint2 w; w.x = cvt_pk_bf16(y[0], y[1]); w.y = cvt_pk_bf16(y[2], y[3]); o8[64 * j] = w; }
    }
}

constexpr int KP = 144, VP = 776;
constexpr int LDS_KOFF = 0, LDS_VOFF = 384 * KP;
__device__ __forceinline__ void attn_item(const Args& A, LAS unsigned char* lds, int item, int tid, int wave, int lane, float bound) {
    const bf16* Q = (const bf16*)(A.ws + WS_Q); const bf16* Kg = (const bf16*)(A.ws + WS_K); const bf16* VT = (const bf16*)(A.ws + WS_VT); bf16* MIX = (bf16*)(A.ws + WS_H);
    const int blk = item >> 1, kvh = item & 1, q0 = blk * 128, band0 = q0 - 128;
    int s0, s1; seq_bounds(q0, s0, s1);
    const int vlo = (q0 == s0) ? 128 : 0, vhi = (q0 + 128 == s1) ? 256 : 384;
    for (int c = tid; c < 384 * 8; c += NTHR) {
        const int i = c >> 3, part = c & 7;
        if (i >= vlo && i < vhi) { const v4u v = *(const v4u*)(Kg + (size_t)(band0 + i) * 128 + kvh * 64 + part * 8); *(LAS v4u*)(lds + LDS_KOFF + i * KP + part * 16) = v; }
    }
    for (int c = tid; c < 64 * 48; c += NTHR) {
        const int d = c / 48, part = c % 48, i = part * 8;
        if (i >= vlo && i < vhi) { const v4u v = *(const v4u*)(VT + (size_t)(kvh * 64 + d) * M_TOK + band0 + i);
            LAS v2u* p = (LAS v2u*)(lds + LDS_VOFF + d * VP + part * 16); p[0] = (v2u){v.x, v.y}; p[1] = (v2u){v.z, v.w}; }
    }
    __syncthreads();
    const int hl = wave >> 1, head = kvh * 4 + hl, r = lane & 31, h = lane >> 5;
    const float slope2 = LOG2E * __builtin_amdgcn_exp2f(-(float)(head + 1));
    const float sink = A.attn_sink[head];
    const float m2 = LOG2E * fmaxf(bound, sink), sinkterm = __builtin_amdgcn_exp2f(LOG2E * sink - m2);
#pragma unroll 1
    for (int qs = 0; qs < 2; ++qs) {
        const int qt = 128 + 64 * (wave & 1) + 32 * qs;
        const bf16* qrow = Q + (size_t)(band0 + qt + r) * 512 + head * 64 + 8 * h;
        bf16x8 qf[4];
#pragma unroll
        for (int kk = 0; kk < 4; ++kk) qf[kk] = *(const bf16x8*)(qrow + 16 * kk);
        f32x16 O0, O1;
#pragma unroll
        for (int i = 0; i < 16; ++i) { O0[i] = 0.f; O1[i] = 0.f; }
        float lsum = 0.f;
        const int kb_lo = max(qt - 128, vlo), kb_hi = min(qt + 160, vhi);
#pragma unroll 1
        for (int kb = kb_lo; kb < kb_hi; kb += 32) {
            f32x16 S;
#pragma unroll
            for (int i = 0; i < 16; ++i) S[i] = -m2;
            const LAS unsigned char* kp = lds + LDS_KOFF + (kb + r) * KP + h * 16;
#pragma unroll
            for (int kk = 0; kk < 4; ++kk) { const bf16x8 kf = *(const LAS bf16x8*)(kp + kk * 32); S = __builtin_amdgcn_mfma_f32_32x32x16_bf16(kf, qf[kk], S, 0, 0, 0); }
            const float dbase = (float)(qt + r - kb - 4 * h);
            float p[16];
#pragma unroll
            for (int i = 0; i < 16; ++i) {
                const float d = dbase - (float)((i & 3) + 8 * (i >> 2));
                const float t = S[i] - slope2 * fabsf(d);
                const float e = __builtin_amdgcn_exp2f(t);
                p[i] = (fabsf(d) <= 128.0f) ? e : 0.f; lsum += p[i];
            }
#pragma unroll
            for (int s = 0; s < 2; ++s) {
                v4u pk; pk.x = cvt_pk_bf16(p[8 * s], p[8 * s + 1]); pk.y = cvt_pk_bf16(p[8 * s + 2], p[8 * s + 3]); pk.z = cvt_pk_bf16(p[8 * s + 4], p[8 * s + 5]); pk.w = cvt_pk_bf16(p[8 * s + 6], p[8 * s + 7]);
                const bf16x8 ps = __builtin_bit_cast(bf16x8, pk);
                const LAS unsigned char* vp = lds + LDS_VOFF + r * VP + (kb + 16 * s + 4 * h) * 2;
                { const s16x4 lo = *(const LAS s16x4*)(vp), hi = *(const LAS s16x4*)(vp + 16);
                  const bf16x8 vf = __builtin_shufflevector(lo, hi, 0, 1, 2, 3, 4, 5, 6, 7); O0 = __builtin_amdgcn_mfma_f32_32x32x16_bf16(vf, ps, O0, 0, 0, 0); }
                { const s16x4 lo = *(const LAS s16x4*)(vp + 32 * VP), hi = *(const LAS s16x4*)(vp + 32 * VP + 16);
                  const bf16x8 vf = __builtin_shufflevector(lo, hi, 0, 1, 2, 3, 4, 5, 6, 7); O1 = __builtin_amdgcn_mfma_f32_32x32x16_bf16(vf, ps, O1, 0, 0, 0); }
            }
        }
        const float l = lsum + __shfl_xor(lsum, 32);
        const float inv = 1.0f / (l + sinkterm);
        bf16* orow = MIX + (size_t)(band0 + qt + r) * DM + head * 64 + 4 * h;
#pragma unroll
        for (int g = 0; g < 4; ++g) {
            uint2 w; w.x = cvt_pk_bf16(O0[4 * g] * inv, O0[4 * g + 1] * inv); w.y = cvt_pk_bf16(O0[4 * g + 2] * inv, O0[4 * g + 3] * inv); *(uint2*)(orow + 8 * g) = w;
            uint2 x; x.x = cvt_pk_bf16(O1[4 * g] * inv, O1[4 * g + 1] * inv); x.y = cvt_pk_bf16(O1[4 * g + 2] * inv, O1[4 * g + 3] * inv); *(uint2*)(orow + 32 + 8 * g) = x;
        }
    }
    __syncthreads();
}

constexpr int LDS_ST = 96 * 1024;
__device__ __forceinline__ void conv_item(const Args& A, LAS unsigned char* lds, int item, int tid, int wave, int lane, const float (&w)[31][2], float2 bias, float2 lg, float2 lb) {
    const bf16* U = (const bf16*)(A.ws + WS_U); bf16* MIX = (bf16*)(A.ws + WS_H);
    const int t0 = item * 64; int s0, s1; seq_bounds(t0, s0, s1);
    for (int c = tid; c < 94 * 64; c += NTHR) {
        const int i = c >> 6, part = c & 63, tok = t0 - 15 + i;
        v4u v = {0u, 0u, 0u, 0u};
        if (tok >= s0 && tok < s1) v = *(const v4u*)(U + (size_t)tok * 512 + part * 8);
        *(LAS v4u*)(lds + i * 1024 + part * 16) = v;
    }
    const int cp = tid & 255, tgb = tid >> 8;
    __syncthreads();
    LAS float* ST = (LAS float*)(lds + LDS_ST);
#pragma unroll 1
    for (int it = 0; it < 4; ++it) {
        const int tg = tgb + 2 * it;
        float res[8][2];
#pragma unroll
        for (int t = 0; t < 8; ++t) { res[t][0] = bias.x; res[t][1] = bias.y; }
        const LAS unsigned* xp = (const LAS unsigned*)(lds + (8 * tg) * 1024 + cp * 4);
#pragma unroll
        for (int c8 = 0; c8 < 5; ++c8) {
            unsigned xr[8];
#pragma unroll
            for (int q = 0; q < 8; ++q) { const int ii = 8 * c8 + q; if (ii < 38) xr[q] = xp[ii * 256]; }
            __builtin_amdgcn_sched_barrier(0);
#pragma unroll
            for (int q = 0; q < 8; ++q) { const int ii = 8 * c8 + q; if (ii < 38) {
                const float x0 = __uint_as_float(xr[q] << 16), x1 = __uint_as_float(xr[q] & 0xffff0000u);
#pragma unroll
                for (int t = 0; t < 8; ++t) { const int j = ii - t; if (j >= 0 && j <= 30) { res[t][0] += w[j][0] * x0; res[t][1] += w[j][1] * x1; } } } }
            __builtin_amdgcn_sched_barrier(0);
        }
#pragma unroll
        for (int t = 0; t < 8; ++t) {
            const float a0 = res[t][0], a1 = res[t][1];
            const float s1v = wave_sum(a0 + a1), s2v = wave_sum(a0 * a0 + a1 * a1);
            if (lane == 0) { ST[((8 * tg + t) * 4 + (wave & 3)) * 2] = s1v; ST[((8 * tg + t) * 4 + (wave & 3)) * 2 + 1] = s2v; }
        }
        __syncthreads();
#pragma unroll
        for (int t = 0; t < 8; ++t) {
            const LAS f32x4* sp = (const LAS f32x4*)(ST + (8 * tg + t) * 8); const f32x4 a = sp[0], b = sp[1];
            const float mean = ((a[0] + a[2]) + (b[0] + b[2])) * (1.0f / 512.0f), ex2 = ((a[1] + a[3]) + (b[1] + b[3])) * (1.0f / 512.0f);
            const float rstd = __builtin_amdgcn_rsqf(fmaxf(ex2 - mean * mean, 0.f) + 1e-5f);
            const float y0 = (res[t][0] - mean) * rstd * lg.x + lb.x, y1 = (res[t][1] - mean) * rstd * lg.y + lb.y;
            *(unsigned*)(MIX + (size_t)(t0 + 8 * tg + t) * DM + 512 + 2 * cp) = cvt_pk_bf16(fast_silu(y0), fast_silu(y1));
        }
    }
    __syncthreads();
}

__device__ __forceinline__ void fix_edges(const Args& A, int gtid, int gthreads) {
    constexpr int ncols = DFF, chbase = 0;
    const float* ge = (const float*)((unsigned char*)A.out + DO_GE); const float* ue = (const float*)((unsigned char*)A.out + DO_UE); bf16* act = (bf16*)(A.ws + WS_ACT);
    const int ng = ncols >> 2, total = 512 * 2 * ng;
    for (int idx = gtid; idx < total; idx += gthreads) {
        const int cg4 = idx % ng, rw = idx / ng, which = rw & 1, chunk = rw >> 1, col = 4 * cg4;
        const int row = 64 * chunk + (which ? 63 : 0); int s0, s1; seq_bounds(row, s0, s1);
        const f32x4 zero = {0.f, 0.f, 0.f, 0.f};
        f32x4 pv, cur, nx, up;
        if (which == 0) { pv = (row == s0) ? zero : *(const f32x4*)(ge + ((size_t)(chunk - 1) * 4 + 3) * ncols + col); cur = *(const f32x4*)(ge + ((size_t)chunk * 4 + 0) * ncols + col); nx = *(const f32x4*)(ge + ((size_t)chunk * 4 + 1) * ncols + col); up = *(const f32x4*)(ue + ((size_t)chunk * 2) * ncols + col); }
        else { pv = *(const f32x4*)(ge + ((size_t)chunk * 4 + 2) * ncols + col); cur = *(const f32x4*)(ge + ((size_t)chunk * 4 + 3) * ncols + col); nx = (row + 1 == s1) ? zero : *(const f32x4*)(ge + ((size_t)(chunk + 1) * 4 + 0) * ncols + col); up = *(const f32x4*)(ue + ((size_t)chunk * 2 + 1) * ncols + col); }
        const int gc = chbase + col;
        const f32x4 w0 = *(const f32x4*)(A.ffn_dw_w + gc), w1 = *(const f32x4*)(A.ffn_dw_w + DFF + gc), w2 = *(const f32x4*)(A.ffn_dw_w + 2 * DFF + gc), bb = *(const f32x4*)(A.ffn_dw_b + gc);
        float o[4];
#pragma unroll
        for (int j = 0; j < 4; ++j) { const float cv = bb[j] + w0[j] * pv[j] + w1[j] * cur[j] + w2[j] * nx[j]; o[j] = fast_silu(cv) * up[j]; }
        uint2 w; w.x = cvt_pk_bf16(o[0], o[1]); w.y = cvt_pk_bf16(o[2], o[3]);
        *(uint2*)(act + (size_t)row * ncols + col) = w;
    }
}

#define XB_TMO      128
#define XB_XCNT(j)  (256  + 64 * (j))
#define XB_XSUB(j)  (1280 + 64 * (j))
#define XB_XGEN(j)  (2304 + 64 * (j))
#define XB_TOP      3328
#define XB_TOPGEN   3392
#define XCD_BAR_WORDS 3456
#define XB_SPIN_CAP (1u << 18)

__device__ __forceinline__ unsigned xb_ld(unsigned* p)              { return __hip_atomic_load(p, __ATOMIC_RELAXED, __HIP_MEMORY_SCOPE_AGENT); }
__device__ __forceinline__ unsigned xb_add(unsigned* p, unsigned v) { return __hip_atomic_fetch_add(p, v, __ATOMIC_RELAXED, __HIP_MEMORY_SCOPE_AGENT); }
__device__ __forceinline__ unsigned xb_xcc_id() { return (unsigned)__builtin_amdgcn_s_getreg((3 << 11) | 20) & 0xFu; }
#define XB_SPIN(cond, bar) do { unsigned _sp = 0; while (cond) { __builtin_amdgcn_s_sleep(1); \
    if ((++_sp & 255u) == 0u) { if (xb_ld(&(bar)[XB_TMO])) break; if (_sp > XB_SPIN_CAP) { atomicAdd(&(bar)[XB_TMO], 1u); break; } } } } while (0)

struct XcdBarrier {
    unsigned* bar; unsigned x;
    volatile LAS unsigned* st;
};

__device__ __forceinline__ XcdBarrier xcd_barrier_post(unsigned* bar, volatile LAS unsigned* st) {
    XcdBarrier b; b.bar = bar; b.x = xb_xcc_id(); b.st = st;
    if (threadIdx.x == 0) (void)xb_add(&bar[XB_XCNT(b.x)], 1u);
    return b;
}
__device__ __forceinline__ void xcd_barrier_complete(unsigned* bar, unsigned x, unsigned& nloc, unsigned& nx) {
    const unsigned G = gridDim.x * gridDim.y * gridDim.z;
    unsigned sum, cnt, mine, sp = 0u;
    for (;;) {
        sum = 0u; cnt = 0u; mine = 0u;
#pragma unroll
        for (unsigned j = 0; j < 16; ++j) { const unsigned c = xb_ld(&bar[XB_XCNT(j)]); sum += c; cnt += (c > 0u) ? 1u : 0u; mine = (j == x) ? c : mine; }
        if (sum == G) break;
        __builtin_amdgcn_s_sleep(1);
        if ((++sp & 255u) == 0u) { if (xb_ld(&bar[XB_TMO])) break; if (sp > XB_SPIN_CAP) { atomicAdd(&bar[XB_TMO], 1u); break; } }
    }
    nloc = mine > 0u ? mine : 1u; nx = cnt > 0u ? cnt : 1u;
}

__device__ __forceinline__ void xcd_barrier(const XcdBarrier& b) {
    asm volatile("s_waitcnt vmcnt(0)" ::: "memory");
    __syncthreads();
    if (threadIdx.x == 0) {
        unsigned* bar = b.bar;
        __builtin_amdgcn_s_waitcnt(0);
        unsigned nloc = b.st[0], nx = b.st[1];
        if (nloc == 0u) { xcd_barrier_complete(bar, b.x, nloc, nx); b.st[0] = nloc; b.st[1] = nx; }
        const unsigned old = xb_add(&bar[XB_XSUB(b.x)], 1u);
        const unsigned gen = old / nloc;
        if (old + 1u == (gen + 1u) * nloc) {
            __builtin_amdgcn_fence(__ATOMIC_RELEASE, "agent");
            asm volatile("s_waitcnt vmcnt(0)" ::: "memory");
            const unsigned og = xb_add(&bar[XB_TOP], 1u);
            const unsigned tg = og / nx;
            if (og + 1u == (tg + 1u) * nx) xb_add(&bar[XB_TOPGEN], 1u);
            else XB_SPIN(xb_ld(&bar[XB_TOPGEN]) == tg, bar);
            __builtin_amdgcn_fence(__ATOMIC_ACQUIRE, "agent");
            xb_add(&bar[XB_XGEN(b.x)], 1u);
            asm volatile("s_waitcnt vmcnt(0)" ::: "memory");
        } else {
            XB_SPIN(xb_ld(&bar[XB_XGEN(b.x)]) == gen, bar);
            __builtin_amdgcn_fence(__ATOMIC_ACQUIRE, "agent");
            asm volatile("s_waitcnt vmcnt(0)" ::: "memory");
        }
    }
    __syncthreads();
}
__global__ void __launch_bounds__(NTHR, 2) hymba_fwd(Args A) {
    extern __shared__ __attribute__((aligned(16))) unsigned char lds_raw[];
    LAS unsigned char* lds = (LAS unsigned char*)lds_raw;
    cg::grid_group grid = cg::this_grid();
    const int tid = threadIdx.x, lane = tid & 63, wave = __builtin_amdgcn_readfirstlane(tid >> 6);
    const int G = gridDim.x, bx = blockIdx.x;
    const int gw = bx * NWAVES + wave, NGW = G * NWAVES;
    unsigned char* ws = A.ws; unsigned char* dob = (unsigned char*)A.out;
    const int lo = A.ph_lo, hi = A.ph_hi;
    volatile LAS unsigned* xb_st = (volatile LAS unsigned*)(lds + 131072 + 8192);
    if (tid < 4) xb_st[tid] = 0u;
    __syncthreads();
    const XcdBarrier xbar = xcd_barrier_post((unsigned*)(ws + WS_BAR), xb_st);
    if (lo > 1000) grid.sync();
#ifndef PMASK
#define PMASK 0x7f
#endif
#define IN(k) (((PMASK >> (k)) & 1) && lo <= (k) && (k) < hi)
#ifndef REPMASK
#define REPMASK 0
#endif
#ifndef XSYNC
#define XSYNC 0
#endif
#define REPS(k) (((REPMASK >> (k)) & 1) ? 2 : 1)
#define SEAM(k) do { if (IN(k) && IN((k) + 1)) { xcd_barrier(xbar); if ((k) == 0) for (int xs_ = 0; xs_ < XSYNC; ++xs_) xcd_barrier(xbar); } } while (0)
    if (IN(0)) for (int rep = 0; rep < REPS(0); ++rep) phase0(A, lds, gw, NGW, wave, lane);
    SEAM(0);
    if (IN(1)) {
        pg8::Gemm g{(const pg8::bf16_t*)(ws + WS_H), (const pg8::bf16_t*)(ws + WS_WIN), M_TOK, 1792, 1024}; pg8::StaticOrder S; S.init(M_TOK, 1792, G, bx); S.rep = REPS(1);
        pg8::EpiInProj E{(pg8::bf16_t*)(ws + WS_Q), (pg8::bf16_t*)(ws + WS_K), (pg8::bf16_t*)(ws + WS_VT), (pg8::bf16_t*)(ws + WS_U), A.q_norm_g, A.k_norm_g};
        pg8::gemm_phase<pg8::EpiInProj, pg8::StaticOrder, true, true>(lds, g, S, E);
    }
    SEAM(1);
    if (IN(2)) {
        const float gqm = wave_max(fabsf(A.q_norm_g[lane])), gkm = wave_max(fabsf(A.k_norm_g[lane]));
        const float bound = 8.0f * gqm * gkm;
#ifndef NO_ATTN
        for (int it = bx; it < 512 * REPS(2); it += G) attn_item(A, lds, it & 511, tid, wave, lane, bound);
#endif
#ifndef NO_CONV
        {
            const int cp = tid & 255;
            float w[31][2];
#pragma unroll
            for (int j = 0; j < 31; ++j) { const float2 t = *(const float2*)(A.conv_dw_w + j * 512 + 2 * cp); w[j][0] = t.x; w[j][1] = t.y; }
            const float2 bias = *(const float2*)(A.conv_dw_b + 2 * cp), lg = *(const float2*)(A.conv_ln_g + 2 * cp), lb = *(const float2*)(A.conv_ln_b + 2 * cp);
#pragma unroll 1
            for (int it = bx; it < 512 * REPS(2); it += G) conv_item(A, lds, it & 511, tid, wave, lane, w, bias, lg, lb);
        }
#endif
    }
    SEAM(2);
    if (IN(3)) {
        pg8::Gemm g{(const pg8::bf16_t*)(ws + WS_H), (const pg8::bf16_t*)(ws + WS_WO), M_TOK, 1024, 1024}; pg8::StaticOrder S; S.init(M_TOK, 1024, G, bx); S.rep = REPS(3);
        pg8::EpiOutProj E{A.xp, A.xs, (pg8::bf16_t*)(ws + WS_DELTA), (pg8::bf16_t*)(dob + DO_X1B), (float*)(ws + WS_SSQ), (LAS float*)(lds + 131072)};
        pg8::gemm_phase<pg8::EpiOutProj, pg8::StaticOrder, true, true>(lds, g, S, E);
    }
    SEAM(3);
    if (IN(4)) {
        pg8::Gemm g{(const pg8::bf16_t*)(dob + DO_X1B), (const pg8::bf16_t*)(dob + DO_WGU), M_TOK, 2 * DFF, 1024}; pg8::StaticOrder S; S.init(M_TOK, 2 * DFF, G, bx); S.rep = REPS(4);
        pg8::EpiGateUp E{(pg8::bf16_t*)(ws + WS_ACT), (float*)(dob + DO_GE), (float*)(dob + DO_UE), (const float*)(ws + WS_SSQ), A.ffn_dw_w, A.ffn_dw_b};
        pg8::gemm_phase<pg8::EpiGateUp, pg8::StaticOrder, true, true>(lds, g, S, E);
    }
    SEAM(4);
    if (IN(5)) for (int rep = 0; rep < REPS(5); ++rep) fix_edges(A, bx * NTHR + tid, G * NTHR);
    SEAM(5);
    if (IN(6)) {
        pg8::Gemm g{(const pg8::bf16_t*)(ws + WS_ACT), (const pg8::bf16_t*)(ws + WS_WD), M_TOK, 1024, DFF}; pg8::StaticOrder S; S.init(M_TOK, 1024, G, bx);
        pg8::EpiDown E{A.xp, A.xs, (const pg8::bf16_t*)(ws + WS_DELTA), A.out};
        pg8::gemm_phase<pg8::EpiDown, pg8::StaticOrder, true, true>(lds, g, S, E);
    }
#undef IN
#undef SEAM
}

#ifndef N_LAUNCH_PER_PHASE
#define N_LAUNCH_PER_PHASE 0
#endif
extern "C" void kernel_launch(void* const* d_in, const int* in_sizes, int n_in, void* d_out, int out_size, void* d_ws, size_t ws_size, hipStream_t stream) {
    static int grid = 0;
    if (grid == 0) {
        if (n_in != 18 || out_size != M_TOK * DM || ws_size < WS_END) { fprintf(stderr, "kernel_launch: unexpected shapes (n_in %d out %d ws %zu)\n", n_in, out_size, ws_size); grid = -1; return; }
        int dev = 0, cus = 0, per_cu = 0;
        hipGetDevice(&dev); hipDeviceGetAttribute(&cus, hipDeviceAttributeMultiprocessorCount, dev);
        if (hipFuncSetAttribute((const void*)hymba_fwd, hipFuncAttributeMaxDynamicSharedMemorySize, LDS_BYTES) != hipSuccess) { fprintf(stderr, "kernel_launch: hipFuncSetAttribute failed\n"); grid = -1; return; }
        if (hipOccupancyMaxActiveBlocksPerMultiprocessor(&per_cu, (const void*)hymba_fwd, NTHR, LDS_BYTES) != hipSuccess || per_cu < 1) { fprintf(stderr, "kernel_launch: occupancy query says %d\n", per_cu); per_cu = 1; }
        (void)hipGetLastError();
        grid = cus * 1;
    }
    if (grid < 0) return;
    if (hipMemsetAsync((char*)d_ws + WS_BAR, 0, BAR_BYTES, stream) != hipSuccess) { fprintf(stderr, "kernel_launch: memset failed\n"); return; }
    Args a{};
    const float** slots = (const float**)&a;
    for (int i = 0; i < 18; ++i) slots[i] = (const float*)d_in[i];
    a.out = (float*)d_out; a.ws = (unsigned char*)d_ws;
#if N_LAUNCH_PER_PHASE
    for (int p = 0; p < 7; ++p) { a.ph_lo = p; a.ph_hi = p + 1; hipLaunchKernelGGL(hymba_fwd, dim3(grid), dim3(NTHR), LDS_BYTES, stream, a); }
#else
    a.ph_lo = 0; a.ph_hi = 7;
    void* args[] = {&a};
    hipError_t e = hipLaunchCooperativeKernel((const void*)hymba_fwd, dim3(grid), dim3(NTHR), args, LDS_BYTES, stream);
    if (e != hipSuccess) fprintf(stderr, "cooperative launch failed: %s (grid %d)\n", hipGetErrorString(e), grid);
#endif
}
```

```cpp
#include <hip/hip_runtime.h>
#include <hip/hip_cooperative_groups.h>
#include <cstdio>
#include <cstdint>
namespace cg = cooperative_groups;
namespace pg8 {
#define PG8_LAS __attribute__((address_space(3)))
typedef unsigned short bf16_t;
typedef short bf16x8 __attribute__((ext_vector_type(8)));
typedef float f32x4 __attribute__((ext_vector_type(4)));
typedef unsigned u32x4 __attribute__((ext_vector_type(4)));
constexpr int BM = 256, BK = 64, HALF = 128, HTB = HALF * BK * 2  , STAGE_BYTES = 8 * HTB, NXCD = 8, WGM = 8;

__host__ __device__ __forceinline__ int lds_byte(int r, int c) { const int st = (r >> 4) * 2 + (c >> 5), rr = r & 15, cc = c & 31, ob = rr * 64 + cc * 2; return st * 1024 + (ob ^ (((ob >> 9) & 1) << 5)); }
__host__ __device__ __forceinline__ void stage_rc(int b, int& R, int& C) { const int st = b / 1024, sb = b % 1024, swz = sb ^ (((sb >> 9) & 1) << 5); R = (st >> 1) * 16 + swz / 64; C = (st & 1) * 32 + (swz % 64) / 2; }
__host__ __device__ __forceinline__ int perm32(int rho) { const int n = rho >> 4, i = rho & 15; return 8 * (i >> 2) + 4 * n + (i & 3); }

struct Unit { int pm, pn; };
struct Gemm { const bf16_t* A; const bf16_t* Bt; int M, N, K; };

struct StaticOrder {
    int nM, nN, nwg, G, c, rep = 1;
    __host__ __device__ void init(int M, int N, int G_, int c_) { nM = M / BM; nN = N / BM; nwg = nM * nN; G = G_; c = c_; }
    __host__ __device__ bool next(int i, Unit& u) const {
        const int rounds = (nwg - c + G - 1) / G; if (i >= rep * rounds) return false; const long L = (long)(i % rounds) * G + c;
        int wgid = (int)L; { const int q = nwg / NXCD, r = nwg % NXCD, xcd = wgid % NXCD, off = wgid / NXCD; wgid = (xcd < r ? xcd * (q + 1) : r * (q + 1) + (xcd - r) * q) + off; }
        const int nig = WGM * nN, gid = wgid / nig, fm = gid * WGM, gsz = (nM - fm) < WGM ? (nM - fm) : WGM;
        u.pm = fm + ((wgid % nig) % gsz); u.pn = (wgid % nig) / gsz; return true;
    }
    __device__ __forceinline__ void a_ready(const Unit&) const {}
    __device__ __forceinline__ void done(const Unit&) const {}
};

__device__ __forceinline__ unsigned cvt_pk_bf16(float lo, float hi) { unsigned r; asm volatile("v_cvt_pk_bf16_f32 %0, %1, %2" : "=v"(r) : "v"(lo), "v"(hi)); return r; }
typedef float f32x2 __attribute__((ext_vector_type(2)));
constexpr int M_TOK = 32768, DM = 1024, M_PROMPT = 16384, T_PROMPT = 2048, T_SAMPLE = 8192, DFF = 2816;
constexpr float LOG2E = 1.4426950408889634f;
constexpr float QSCALE = 0.125f * LOG2E;
__device__ __forceinline__ void seq_bounds(int row, int& s0, int& s1) {
    if (row < M_PROMPT) { s0 = row & ~(T_PROMPT - 1); s1 = s0 + T_PROMPT; }
    else { s0 = M_PROMPT + ((row - M_PROMPT) & ~(T_SAMPLE - 1)); s1 = s0 + T_SAMPLE; }
}
__device__ __forceinline__ float fast_sigmoid(float v) { return __builtin_amdgcn_rcpf(1.0f + __builtin_amdgcn_exp2f(-LOG2E * v)); }
__device__ __forceinline__ float fast_silu(float v) { return v * fast_sigmoid(v); }

struct EpiInProj {
    static constexpr bool PERM = true, AFTER_DRAIN = false, PREFETCH = false;
    bf16_t* Q; bf16_t* Kb; bf16_t* VT; bf16_t* U; const float* gq; const float* gk;
    __device__ __forceinline__ void operator()(f32x4 (&acc)[2][2][4][2], const Unit& u, int wr, int wc, int fr, int fq) const {
        asm volatile("" : "+v"(fr), "+v"(fq));
        const int row0 = u.pm * BM + wr * 64 + fr;
        if (u.pn < 3) {
            const bool isq = u.pn < 2, isk = (u.pn == 2) && (wc < 2);
            if (isq || isk) {
                const float* g = isq ? gq : gk; const float sc = isq ? QSCALE : 1.0f;
                f32x4 gv[2][2];
#pragma unroll
                for (int bj = 0; bj < 2; ++bj)
#pragma unroll
                    for (int n = 0; n < 2; ++n) gv[bj][n] = *(const f32x4*)(g + 32 * bj + 8 * fq + 4 * n) * sc;
                bf16_t* dst = isq ? (Q + (size_t)(u.pn * 4 + wc) * 64) : (Kb + (size_t)wc * 64);
                const int pitch = isq ? 512 : 128;
#pragma unroll
                for (int ai = 0; ai < 2; ++ai)
#pragma unroll
                    for (int m = 0; m < 4; ++m) {
                        float s = 0.f;
#pragma unroll
                        for (int bj = 0; bj < 2; ++bj)
#pragma unroll
                            for (int n = 0; n < 2; ++n) { const f32x4 x = acc[ai][bj][m][n]; s += (x[0] * x[0] + x[1] * x[1]) + (x[2] * x[2] + x[3] * x[3]); }
                        s += __shfl_xor(s, 16); s += __shfl_xor(s, 32);
                        const float rs = __builtin_amdgcn_rsqf(s * (1.0f / 64.0f) + 1e-6f);
                        bf16_t* rowp = dst + (size_t)(row0 + ai * HALF + m * 16) * pitch + 8 * fq;
#pragma unroll
                        for (int bj = 0; bj < 2; ++bj) {
                            const f32x4 v0 = acc[ai][bj][m][0] * rs * gv[bj][0], v1 = acc[ai][bj][m][1] * rs * gv[bj][1];
                            u32x4 w; w.x = cvt_pk_bf16(v0[0], v0[1]); w.y = cvt_pk_bf16(v0[2], v0[3]); w.z = cvt_pk_bf16(v1[0], v1[1]); w.w = cvt_pk_bf16(v1[2], v1[3]);
                            *(u32x4*)(rowp + 32 * bj) = w;
                        }
                    }
            } else {
                bf16_t* vt = VT + (size_t)(wc - 2) * 64 * M_TOK;
#pragma unroll
                for (int ai = 0; ai < 2; ++ai)
#pragma unroll
                    for (int m = 0; m < 4; ++m) {
                        const int row = row0 + ai * HALF + m * 16;
#pragma unroll
                        for (int bj = 0; bj < 2; ++bj)
#pragma unroll
                            for (int n = 0; n < 2; ++n) {
                                const f32x4 x = acc[ai][bj][m][n]; const int d0 = 32 * bj + 8 * fq + 4 * n;
                                const unsigned p01 = cvt_pk_bf16(x[0], x[1]), p23 = cvt_pk_bf16(x[2], x[3]);
                                vt[(size_t)(d0 + 0) * M_TOK + row] = (bf16_t)(p01 & 0xffffu); vt[(size_t)(d0 + 1) * M_TOK + row] = (bf16_t)(p01 >> 16);
                                vt[(size_t)(d0 + 2) * M_TOK + row] = (bf16_t)(p23 & 0xffffu); vt[(size_t)(d0 + 3) * M_TOK + row] = (bf16_t)(p23 >> 16);
                            }
                    }
            }
        } else {
            bf16_t* dst = U + (size_t)(u.pn - 3) * 128 + 32 * wc + 8 * fq;
#pragma unroll
            for (int ai = 0; ai < 2; ++ai)
#pragma unroll
                for (int m = 0; m < 4; ++m) {
                    f32x4 o[2];
#pragma unroll
                    for (int n = 0; n < 2; ++n) { const f32x4 a = acc[ai][0][m][n], g = acc[ai][1][m][n];
#pragma unroll
                        for (int j = 0; j < 4; ++j) o[n][j] = a[j] * fast_sigmoid(g[j]); }
                    u32x4 w; w.x = cvt_pk_bf16(o[0][0], o[0][1]); w.y = cvt_pk_bf16(o[0][2], o[0][3]); w.z = cvt_pk_bf16(o[1][0], o[1][1]); w.w = cvt_pk_bf16(o[1][2], o[1][3]);
                    *(u32x4*)(dst + (size_t)(row0 + ai * HALF + m * 16) * 512) = w;
                }
        }
    }
};

struct EpiOutProj {
    static constexpr bool PERM = true, AFTER_DRAIN = false, PREFETCH = false;
    __device__ __forceinline__ void prefetch(const Unit& u, PG8_LAS unsigned char* lds) const {
        const int t = threadIdx.x; const float* xb = (u.pm * BM < M_PROMPT) ? xp : (xs - (size_t)M_PROMPT * DM);
        PG8_LAS unsigned* dummy = (PG8_LAS unsigned*)(lds + 131072 + 4096 + (t >> 6) * 256);
#pragma unroll
        for (int i = 0; i < 4; ++i) { const int L = t + 512 * i; __builtin_amdgcn_global_load_lds((const unsigned*)(xb + (size_t)(u.pm * BM + (L >> 3)) * DM + u.pn * BM + (L & 7) * 32), dummy, 4, 0, 0); }
    }
    const float* xp; const float* xs; bf16_t* delta; bf16_t* x1b; float* ssq; PG8_LAS float* red;
    __device__ __forceinline__ void operator()(f32x4 (&acc)[2][2][4][2], const Unit& u, int wr, int wc, int fr, int fq) const {
        asm volatile("" : "+v"(fr), "+v"(fq));
        const int row0 = u.pm * BM + wr * 64 + fr, col0 = u.pn * BM + wc * 32 + 8 * fq;
        const float* xb = (u.pm * BM < M_PROMPT) ? xp : (xs - (size_t)M_PROMPT * DM);
#pragma unroll
        for (int ai = 0; ai < 2; ++ai)
#pragma unroll
            for (int m = 0; m < 4; ++m) {
                const int row = row0 + ai * HALF + m * 16; const size_t ro = (size_t)row * DM + col0; float s = 0.f;
#pragma unroll
                for (int bj = 0; bj < 2; ++bj) {
                    const f32x4 a0 = acc[ai][bj][m][0], a1 = acc[ai][bj][m][1];
                    const f32x4 v0 = a0 + *(const f32x4*)(xb + ro + bj * HALF), v1 = a1 + *(const f32x4*)(xb + ro + bj * HALF + 4);
                    s += ((v0[0] * v0[0] + v0[1] * v0[1]) + (v0[2] * v0[2] + v0[3] * v0[3])) + ((v1[0] * v1[0] + v1[1] * v1[1]) + (v1[2] * v1[2] + v1[3] * v1[3]));
                    u32x4 w; w.x = cvt_pk_bf16(a0[0], a0[1]); w.y = cvt_pk_bf16(a0[2], a0[3]); w.z = cvt_pk_bf16(a1[0], a1[1]); w.w = cvt_pk_bf16(a1[2], a1[3]);
                    *(u32x4*)(delta + ro + bj * HALF) = w;
                    u32x4 y; y.x = cvt_pk_bf16(v0[0], v0[1]); y.y = cvt_pk_bf16(v0[2], v0[3]); y.z = cvt_pk_bf16(v1[0], v1[1]); y.w = cvt_pk_bf16(v1[2], v1[3]);
                    *(u32x4*)(x1b + ro + bj * HALF) = y;
                }
                s += __shfl_xor(s, 16); s += __shfl_xor(s, 32);
                if (fq == 0) red[(ai * HALF + wr * 64 + m * 16 + fr) * 4 + wc] = s;
            }
        __syncthreads();
        const int t = threadIdx.x;
        if (t < 256) { const f32x4 v = *(const PG8_LAS f32x4*)(red + t * 4); ssq[(size_t)(u.pm * BM + t) * 4 + u.pn] = (v[0] + v[1]) + (v[2] + v[3]); }
    }
};

struct EpiGateUp {
    static constexpr bool PERM = true, AFTER_DRAIN = false, PREFETCH = false;
    bf16_t* act; float* ge; float* ue; const float* ssq; const float* cw; const float* cb;
    static constexpr int ncols = DFF, chbase = 0;
    __device__ __forceinline__ void operator()(f32x4 (&acc)[2][2][4][2], const Unit& u, int wr, int wc, int fr, int fq) const {
        asm volatile("" : "+v"(fr), "+v"(fq));
        const int lane = fr + 16 * fq;
        const int ch0 = u.pn * 128 + 32 * wc + 8 * fq;
        const int lprev = (lane & 48) | ((fr + 15) & 15), lnext = (lane & 48) | ((fr + 1) & 15);
#pragma unroll
        for (int ai = 0; ai < 2; ++ai) {
            const int crow0 = u.pm * BM + ai * HALF + wr * 64;
            const int chunk = crow0 >> 6;
#pragma unroll
            for (int m = 0; m < 4; ++m) {
                const f32x4 a = *(const f32x4*)(ssq + (size_t)(crow0 + m * 16 + fr) * 4);
                const float t = (a[0] + a[1]) + (a[2] + a[3]);
                const float rstd = __builtin_amdgcn_rsqf(t * (1.0f / 1024.0f) + 1e-6f);
#pragma unroll
                for (int n = 0; n < 2; ++n) { acc[ai][0][m][n] *= rstd; acc[ai][1][m][n] *= rstd; }
            }
            if (fr < 2) {
                float* g = ge + ((size_t)chunk * 4 + fr) * ncols + ch0;
                *(f32x4*)g = acc[ai][0][0][0]; *(f32x4*)(g + 4) = acc[ai][0][0][1];
                if (fr == 0) { float* q = ue + ((size_t)chunk * 2) * ncols + ch0; *(f32x4*)q = acc[ai][1][0][0]; *(f32x4*)(q + 4) = acc[ai][1][0][1]; }
            }
            if (fr >= 14) {
                float* g = ge + ((size_t)chunk * 4 + (fr - 12)) * ncols + ch0;
                *(f32x4*)g = acc[ai][0][3][0]; *(f32x4*)(g + 4) = acc[ai][0][3][1];
                if (fr == 15) { float* q = ue + ((size_t)chunk * 2 + 1) * ncols + ch0; *(f32x4*)q = acc[ai][1][3][0]; *(f32x4*)(q + 4) = acc[ai][1][3][1]; }
            }
        }
#pragma unroll
        for (int n = 0; n < 2; ++n) {
            const int gc = chbase + ch0 + 4 * n;
            const f32x4 w0 = *(const f32x4*)(cw + gc), w1 = *(const f32x4*)(cw + DFF + gc), w2 = *(const f32x4*)(cw + 2 * DFF + gc), bb = *(const f32x4*)(cb + gc);
#pragma unroll
            for (int ai = 0; ai < 2; ++ai) {
                const int crow0 = u.pm * BM + ai * HALF + wr * 64;
                float o[4][4];
#pragma unroll
                for (int j = 0; j < 4; ++j) {
                    float R[4], L[4];
#pragma unroll
                    for (int m = 0; m < 4; ++m) { R[m] = __shfl(acc[ai][0][m][n][j], lprev); L[m] = __shfl(acc[ai][0][m][n][j], lnext); }
#pragma unroll
                    for (int m = 0; m < 4; ++m) {
                        const float pv = (m > 0 && fr == 0) ? R[m > 0 ? m - 1 : 0] : R[m];
                        const float nx = (m < 3 && fr == 15) ? L[m < 3 ? m + 1 : 3] : L[m];
                        const float cv = bb[j] + w0[j] * pv + w1[j] * acc[ai][0][m][n][j] + w2[j] * nx;
                        o[m][j] = fast_silu(cv) * acc[ai][1][m][n][j];
                    }
                }
#pragma unroll
                for (int m = 0; m < 4; ++m) {
                    const bool edge = (m == 0 && fr == 0) || (m == 3 && fr == 15);
                    if (!edge) { uint2 w; w.x = cvt_pk_bf16(o[m][0], o[m][1]); w.y = cvt_pk_bf16(o[m][2], o[m][3]);
                        *(uint2*)(act + (size_t)(crow0 + m * 16 + fr) * ncols + ch0 + 4 * n) = w; }
                }
                __builtin_amdgcn_sched_barrier(0);
            }
        }
    }
};

struct EpiDown {
    static constexpr bool PERM = true, AFTER_DRAIN = false, PREFETCH = false;
    __device__ __forceinline__ void prefetch(const Unit& u, PG8_LAS unsigned char* lds) const {
        const int t = threadIdx.x; const float* xb = (u.pm * BM < M_PROMPT) ? xp : (xs - (size_t)M_PROMPT * DM);
        PG8_LAS unsigned* dummy = (PG8_LAS unsigned*)(lds + 131072 + 4096 + (t >> 6) * 256);
#pragma unroll
        for (int i = 0; i < 4; ++i) { const int L = t + 512 * i; __builtin_amdgcn_global_load_lds((const unsigned*)(xb + (size_t)(u.pm * BM + (L >> 3)) * DM + u.pn * BM + (L & 7) * 32), dummy, 4, 0, 0); }
#pragma unroll
        for (int i = 0; i < 2; ++i) { const int L = t + 512 * i; __builtin_amdgcn_global_load_lds((const unsigned*)(delta + (size_t)(u.pm * BM + (L >> 2)) * DM + u.pn * BM + (L & 3) * 64), dummy, 4, 0, 0); }
    }
    const float* xp; const float* xs; const bf16_t* delta; float* out;
    __device__ __forceinline__ void operator()(f32x4 (&acc)[2][2][4][2], const Unit& u, int wr, int wc, int fr, int fq) const {
        asm volatile("" : "+v"(fr), "+v"(fq));
        const int row0 = u.pm * BM + wr * 64 + fr, col0 = u.pn * BM + wc * 32 + 8 * fq;
        const float* xb = (u.pm * BM < M_PROMPT) ? xp : (xs - (size_t)M_PROMPT * DM);
#pragma unroll
        for (int ai = 0; ai < 2; ++ai)
#pragma unroll
            for (int m = 0; m < 4; ++m) { const size_t ro = (size_t)(row0 + ai * HALF + m * 16) * DM + col0;
#pragma unroll
                for (int bj = 0; bj < 2; ++bj) {
                    const u32x4 d = *(const u32x4*)(delta + ro + bj * HALF);
                    const f32x4 x0 = *(const f32x4*)(xb + ro + bj * HALF), x1 = *(const f32x4*)(xb + ro + bj * HALF + 4);
                    f32x4 d0, d1;
                    d0[0] = __uint_as_float(d.x << 16); d0[1] = __uint_as_float(d.x & 0xffff0000u); d0[2] = __uint_as_float(d.y << 16); d0[3] = __uint_as_float(d.y & 0xffff0000u);
                    d1[0] = __uint_as_float(d.z << 16); d1[1] = __uint_as_float(d.z & 0xffff0000u); d1[2] = __uint_as_float(d.w << 16); d1[3] = __uint_as_float(d.w & 0xffff0000u);
                    *(f32x4*)(out + ro + bj * HALF) = (x0 + d0) + acc[ai][bj][m][0];
                    *(f32x4*)(out + ro + bj * HALF + 4) = (x1 + d1) + acc[ai][bj][m][1];
                } }
    }
};
template <class Epi, class Sched, bool ALIGN_EPI = false, bool SP2 = false>
__device__ __forceinline__ void gemm_phase(PG8_LAS unsigned char* lds, const Gemm g, const Sched& S, const Epi& E) {
    const int tid = threadIdx.x, wid = __builtin_amdgcn_readfirstlane(tid >> 6), lane = tid & 63, wr = wid >> 2, wc = wid & 3, fr = lane & 15, fq = lane >> 4;
    const int K = g.K, nt = K / BK;
    unsigned voffA[2], voffB[2];
#pragma unroll
    for (int i = 0; i < 2; ++i) { int R, C; stage_rc(tid * 16 + i * 8192, R, C); const int Rb = Epi::PERM ? ((R & ~31) + perm32(R & 31)) : R;
        voffA[i] = (unsigned)(R * K + C) * 2u; voffB[i] = (unsigned)(Rb * K + C) * 2u; }
    const size_t kstep = (size_t)(BK * 2);
    const size_t hstep = (size_t)HALF * K * 2;
    const size_t tstep = 2 * hstep;
    const unsigned ldsw = (unsigned)wid * 1024u;
    const int aoff = lds_byte(wr * 64 + fr, fq * 8), boff = lds_byte(wc * 32 + fr, fq * 8);
#define PG8_SA(b, h) (((b) * 2 + (h)) * HTB)
#define PG8_SB(b, h) ((4 + (b) * 2 + (h)) * HTB)
#define PG8_STAGE(bufoff, gbase, voff) do { _Pragma("unroll") for (int _i = 0; _i < 2; ++_i) \
        __builtin_amdgcn_global_load_lds((const unsigned*)((const char*)(gbase) + (voff)[_i]), (PG8_LAS unsigned*)(lds + (bufoff) + ldsw + _i * 8192), 16, 0, 0); } while (0)
#define PG8_LDA(dst, b, h) do { _Pragma("unroll") for (int m = 0; m < 4; ++m) _Pragma("unroll") for (int k = 0; k < 2; ++k) dst[m][k] = *(const PG8_LAS bf16x8*)(lds + PG8_SA(b, h) + aoff + m * 2048 + k * 1024); } while (0)
#define PG8_LDB(dst, b, h) do { _Pragma("unroll") for (int n = 0; n < 2; ++n) _Pragma("unroll") for (int k = 0; k < 2; ++k) dst[n][k] = *(const PG8_LAS bf16x8*)(lds + PG8_SB(b, h) + boff + n * 2048 + k * 1024); } while (0)
#define PG8_MMA(ai, bj, At, Bt) do { __builtin_amdgcn_s_setprio(1); _Pragma("unroll") for (int m = 0; m < 4; ++m) _Pragma("unroll") for (int n = 0; n < 2; ++n) _Pragma("unroll") for (int k = 0; k < 2; ++k) \
        acc[ai][bj][m][n] = __builtin_amdgcn_mfma_f32_16x16x32_bf16(Bt[n][k], At[m][k], acc[ai][bj][m][n], 0, 0, 0); __builtin_amdgcn_s_setprio(0); } while (0)
#define PG8_WAIT_V(n) asm volatile("s_waitcnt vmcnt(" #n ")" ::: "memory")
#define PG8_WAIT_L(n) asm volatile("s_waitcnt lgkmcnt(" #n ")" ::: "memory")
#define PG8_BAR __builtin_amdgcn_s_barrier()
#define PG8_SCHED __builtin_amdgcn_sched_barrier(0)
    Unit cur, nxt; int ui = 0;
    if (!S.next(0, cur)) return;
    f32x4 acc[2][2][4][2];
#pragma unroll
    for (int a = 0; a < 2; ++a)
#pragma unroll
        for (int b = 0; b < 2; ++b)
#pragma unroll
            for (int m = 0; m < 4; ++m)
#pragma unroll
                for (int n = 0; n < 2; ++n) acc[a][b][m][n] = (f32x4){0.f, 0.f, 0.f, 0.f};
    bf16x8 At[4][2], B0[2][2], B1[2][2];
    const char* cA = (const char*)g.A + (size_t)cur.pm * tstep; const char* cB = (const char*)g.Bt + (size_t)cur.pn * tstep;
    S.a_ready(cur);
    if constexpr (Epi::PREFETCH) E.prefetch(cur, lds);
    if constexpr (SP2) {
        PG8_STAGE(PG8_SB(0, 0), cB, voffB); PG8_STAGE(PG8_SB(0, 1), cB + hstep, voffB); PG8_STAGE(PG8_SA(0, 0), cA, voffA); PG8_STAGE(PG8_SA(0, 1), cA + hstep, voffA);
        if (wr == 1) PG8_BAR;
        PG8_WAIT_V(2); PG8_BAR;
        PG8_STAGE(PG8_SB(1, 0), cB + kstep, voffB); PG8_STAGE(PG8_SA(1, 0), cA + kstep, voffA); PG8_STAGE(PG8_SB(1, 1), cB + hstep + kstep, voffB);
        PG8_WAIT_V(6); PG8_BAR;
    } else {
        PG8_STAGE(PG8_SB(0, 0), cB, voffB); PG8_STAGE(PG8_SA(0, 0), cA, voffA); PG8_STAGE(PG8_SB(0, 1), cB + hstep, voffB); PG8_STAGE(PG8_SA(0, 1), cA + hstep, voffA);
        if (wr == 1) PG8_BAR;
        PG8_WAIT_V(4); PG8_BAR;
        PG8_STAGE(PG8_SB(1, 0), cB + kstep, voffB); PG8_STAGE(PG8_SA(1, 0), cA + kstep, voffA); PG8_STAGE(PG8_SB(1, 1), cB + hstep + kstep, voffB);
        PG8_WAIT_V(6); PG8_BAR;
    }
    for (;;) {
        const bool has_next = S.next(ui + 1, nxt);
        const char* nA = has_next ? (const char*)g.A + (size_t)nxt.pm * tstep : cA; const char* nB = has_next ? (const char*)g.Bt + (size_t)nxt.pn * tstep : cB;
        for (int t = 0; t < nt; t += 2) {
            const bool last = (t == nt - 2);
            const char* a1 = cA + (size_t)(t + 1) * kstep;
            const char* a2 = last ? nA : cA + (size_t)(t + 2) * kstep; const char* b2 = last ? nB : cB + (size_t)(t + 2) * kstep;
            const char* a3 = a2 + kstep; const char* b3 = b2 + kstep;
            if (last && has_next) S.a_ready(nxt);
            if constexpr (SP2) {
            PG8_LDB(B0, 0, 0); PG8_LDB(B1, 0, 1); PG8_SCHED; PG8_LDA(At, 0, 0); PG8_STAGE(PG8_SA(1, 1), a1 + hstep, voffA);
            PG8_WAIT_V(8); PG8_WAIT_L(0); PG8_BAR; PG8_MMA(0, 0, At, B0); PG8_MMA(0, 1, At, B1); PG8_BAR; PG8_SCHED;
            PG8_LDA(At, 0, 1); PG8_STAGE(PG8_SB(0, 0), b2, voffB); PG8_STAGE(PG8_SB(0, 1), b2 + hstep, voffB); PG8_STAGE(PG8_SA(0, 0), a2, voffA);
            PG8_WAIT_V(8); PG8_WAIT_L(0); PG8_BAR; PG8_MMA(1, 0, At, B0); PG8_MMA(1, 1, At, B1); PG8_BAR; PG8_SCHED;
            PG8_LDB(B0, 1, 0); PG8_LDB(B1, 1, 1); PG8_SCHED; PG8_LDA(At, 1, 0); PG8_STAGE(PG8_SA(0, 1), a2 + hstep, voffA);
            PG8_WAIT_V(8); PG8_WAIT_L(0); PG8_BAR; PG8_MMA(0, 0, At, B0); PG8_MMA(0, 1, At, B1); PG8_BAR; PG8_SCHED;
            PG8_LDA(At, 1, 1); PG8_STAGE(PG8_SB(1, 0), b3, voffB); PG8_STAGE(PG8_SB(1, 1), b3 + hstep, voffB); PG8_STAGE(PG8_SA(1, 0), a3, voffA);
            PG8_WAIT_V(8); PG8_WAIT_L(0); PG8_BAR; PG8_MMA(1, 0, At, B0); PG8_MMA(1, 1, At, B1); PG8_BAR; PG8_SCHED;
            } else {
            PG8_LDB(B0, 0, 0); PG8_SCHED; PG8_LDA(At, 0, 0); PG8_STAGE(PG8_SA(1, 1), a1 + hstep, voffA);
            PG8_WAIT_L(8); PG8_BAR; PG8_WAIT_L(0); PG8_MMA(0, 0, At, B0); PG8_BAR; PG8_SCHED;
            PG8_LDB(B1, 0, 1); PG8_STAGE(PG8_SB(0, 0), b2, voffB);
            PG8_BAR; PG8_WAIT_L(0); PG8_MMA(0, 1, At, B1); PG8_BAR;
            PG8_LDA(At, 0, 1); PG8_STAGE(PG8_SA(0, 0), a2, voffA);
            PG8_BAR; PG8_WAIT_L(0); PG8_MMA(1, 0, At, B0); PG8_BAR; PG8_SCHED;
            PG8_STAGE(PG8_SB(0, 1), b2 + hstep, voffB);
            PG8_WAIT_V(6); PG8_BAR; PG8_MMA(1, 1, At, B1); PG8_BAR;
            PG8_LDB(B0, 1, 0); PG8_SCHED; PG8_LDA(At, 1, 0); PG8_STAGE(PG8_SA(0, 1), a2 + hstep, voffA);
            PG8_WAIT_L(8); PG8_BAR; PG8_WAIT_L(0); PG8_MMA(0, 0, At, B0); PG8_BAR; PG8_SCHED;
            PG8_LDB(B1, 1, 1); PG8_STAGE(PG8_SB(1, 0), b3, voffB);
            PG8_BAR; PG8_WAIT_L(0); PG8_MMA(0, 1, At, B1); PG8_BAR;
            PG8_LDA(At, 1, 1); PG8_STAGE(PG8_SA(1, 0), a3, voffA);
            PG8_BAR; PG8_WAIT_L(0); PG8_MMA(1, 0, At, B0); PG8_BAR; PG8_SCHED;
            PG8_STAGE(PG8_SB(1, 1), b3 + hstep, voffB);
            PG8_WAIT_V(6); PG8_BAR; PG8_MMA(1, 1, At, B1); PG8_BAR;
            }
        }
        if constexpr (ALIGN_EPI) { if (wr == 0) PG8_BAR; }
        if constexpr (!Epi::AFTER_DRAIN) { E(acc, cur, wr, wc, fr, fq); S.done(cur); }
        if (!has_next) break;
#pragma unroll
        for (int a = 0; a < 2; ++a)
#pragma unroll
            for (int b = 0; b < 2; ++b)
#pragma unroll
                for (int m = 0; m < 4; ++m)
#pragma unroll
                    for (int n = 0; n < 2; ++n) acc[a][b][m][n] = (f32x4){0.f, 0.f, 0.f, 0.f};
        cur = nxt; cA = nA; cB = nB; ++ui;
        if constexpr (Epi::PREFETCH) E.prefetch(cur, lds);
        if constexpr (ALIGN_EPI) { if (wr == 1) PG8_BAR; }
    }
    PG8_WAIT_V(0);
    if constexpr (!ALIGN_EPI) { if (wr == 0) PG8_BAR; }
    PG8_BAR;
    if constexpr (Epi::AFTER_DRAIN) { E.fused(acc, cur, wr, wc, fr, fq, lds, wid, lane); S.done(cur); }
#undef PG8_SA
#undef PG8_SB
#undef PG8_STAGE
#undef PG8_LDA
#undef PG8_LDB
#undef PG8_MMA
#undef PG8_WAIT_V
#undef PG8_WAIT_L
#undef PG8_BAR
#undef PG8_SCHED
}
}
#define LAS __attribute__((address_space(3)))
typedef unsigned short bf16;
typedef unsigned v4u __attribute__((ext_vector_type(4)));
typedef unsigned v2u __attribute__((ext_vector_type(2)));
typedef float f32x4 __attribute__((ext_vector_type(4)));
typedef float f32x16 __attribute__((ext_vector_type(16)));
typedef short bf16x8 __attribute__((ext_vector_type(8)));
typedef short s16x4 __attribute__((ext_vector_type(4)));
using pg8::cvt_pk_bf16; using pg8::M_TOK; using pg8::DM; using pg8::M_PROMPT; using pg8::DFF; using pg8::LOG2E; using pg8::seq_bounds; using pg8::fast_silu; using pg8::fast_sigmoid;
constexpr int NWAVES = 8, NTHR = 512;
constexpr int LDS_BYTES = 147456;
constexpr size_t MiB = 1u << 20;
constexpr size_t WS_WIN = 0, WS_WO = 4 * MiB, WS_WD = 6 * MiB, WS_SSQ = 12 * MiB, WS_BAR = 12 * MiB + 512 * 1024, BAR_BYTES = 16384;
constexpr size_t WS_H = 16 * MiB;
constexpr size_t WS_Q = 80 * MiB, WS_K = 112 * MiB, WS_VT = 120 * MiB, WS_U = 128 * MiB;
constexpr size_t WS_ACT = 16 * MiB;
constexpr size_t WS_DELTA = 192 * MiB, WS_END = 256 * MiB;
constexpr size_t DO_X1B = 0, DO_WGU = 64 * MiB, DO_GE = 76 * MiB, DO_UE = 99 * MiB;

__device__ __forceinline__ float wave_sum(float v) {
#pragma unroll
    for (int o = 1; o < 64; o <<= 1) v += __shfl_xor(v, o);
    return v;
}
__device__ __forceinline__ float wave_max(float v) {
#pragma unroll
    for (int o = 1; o < 64; o <<= 1) v = fmaxf(v, __shfl_xor(v, o));
    return v;
}
__device__ __forceinline__ void transpose_item(const float* W, int N, int k0, int n0, bf16* dst, int dpitch, const float* kscale, LAS float* scr, int lane) {
#pragma unroll 8
    for (int i = 0; i < 32; ++i) { const int kk = 2 * i + (lane >> 5); float v = W[(size_t)(k0 + kk) * N + n0 + (lane & 31)]; if (kscale) v *= kscale[k0 + kk]; scr[kk * 33 + (lane & 31)] = v; }
    asm volatile("s_waitcnt lgkmcnt(0)" ::: "memory");
    const int c = lane & 7;
#pragma unroll
    for (int j = 0; j < 4; ++j) { const int n = (lane >> 3) + 8 * j; const LAS float* s = scr + (8 * c) * 33 + n;
        v4u o; o.x = cvt_pk_bf16(s[0 * 33], s[1 * 33]); o.y = cvt_pk_bf16(s[2 * 33], s[3 * 33]); o.z = cvt_pk_bf16(s[4 * 33], s[5 * 33]); o.w = cvt_pk_bf16(s[6 * 33], s[7 * 33]);
        *(v4u*)(dst + (size_t)n * dpitch + 8 * c) = o; }
    asm volatile("s_waitcnt lgkmcnt(0)" ::: "memory");
}

struct Args {
    const float *xp, *xs, *norm1_g, *w_in, *q_norm_g, *k_norm_g, *attn_sink, *conv_dw_w, *conv_dw_b, *conv_ln_g, *conv_ln_b, *w_out, *norm2_g, *w_gate, *w_up, *ffn_dw_w, *ffn_dw_b, *w_down;
    float* out; unsigned char* ws; int ph_lo, ph_hi;
};

__device__ __forceinline__ void phase0(const Args& A, LAS unsigned char* lds, int gw, int NGW, int wave, int lane) {
    unsigned char* ws = A.ws;
    LAS float* scr = (LAS float*)(lds + wave * 16384);
    constexpr int I_IN = 16 * 56, I_O = 16 * 32, I_G = 16 * 88, I_D = 44 * 32;
    constexpr int NITEMS = I_IN + I_O + 2 * I_G + I_D;
    for (int it = gw; it < NITEMS; it += NGW) {
        int r = it;
        if (r < I_IN) {
            const int kb = r / 56, nb = r % 56, n0 = 32 * nb; int drow;
            if (n0 < 768) { const int pn = n0 >> 8, wc = (n0 >> 6) & 3, bj = (n0 >> 5) & 1; drow = 256 * pn + 128 * bj + 32 * wc; }
            else if (n0 < 1280) { const int ch = n0 - 768; drow = 256 * (3 + (ch >> 7)) + (ch & 127); }
            else { const int ch = n0 - 1280; drow = 256 * (3 + (ch >> 7)) + 128 + (ch & 127); }
            transpose_item(A.w_in, 1792, 64 * kb, n0, (bf16*)(ws + WS_WIN) + (size_t)drow * 1024 + 64 * kb, 1024, nullptr, scr, lane); continue; }
        r -= I_IN;
        if (r < I_O) { const int kb = r / 32, nb = r % 32; transpose_item(A.w_out, 1024, 64 * kb, 32 * nb, (bf16*)(ws + WS_WO) + (size_t)(32 * nb) * 1024 + 64 * kb, 1024, nullptr, scr, lane); continue; }
        r -= I_O;
        if (r < 2 * I_G) { const int up = r >= I_G; if (up) r -= I_G; const int kb = r / 88, nb = r % 88, ch = 32 * nb; const int drow = 256 * (ch >> 7) + 128 * up + (ch & 127);
            transpose_item(up ? A.w_up : A.w_gate, DFF, 64 * kb, ch, (bf16*)((unsigned char*)A.out + DO_WGU) + (size_t)drow * 1024 + 64 * kb, 1024, A.norm2_g, scr, lane); continue; }
        r -= 2 * I_G;
        { const int kb = r / 32, nb = r % 32, k0 = 64 * kb;
          transpose_item(A.w_down, 1024, k0, 32 * nb, (bf16*)(ws + WS_WD) + (size_t)(32 * nb) * DFF + k0, DFF, nullptr, scr, lane); }
    }
    f32x4 g[4];
#pragma unroll
    for (int j = 0; j < 4; ++j) g[j] = ((const f32x4*)A.norm1_g)[lane + 64 * j];
    bf16* H = (bf16*)(ws + WS_H);
    for (int m = gw; m < M_TOK; m += NGW) {
        const float* xrow = (m < M_PROMPT) ? A.xp + (size_t)m * DM : A.xs + (size_t)(m - M_PROMPT) * DM;
        f32x4 v[4]; float s = 0.f;
#pragma unroll
        for (int j = 0; j < 4; ++j) { v[j] = ((const f32x4*)xrow)[lane + 64 * j]; s += (v[j][0] * v[j][0] + v[j][1] * v[j][1]) + (v[j][2] * v[j][2] + v[j][3] * v[j][3]); }
        const float rs = __builtin_amdgcn_rsqf(wave_sum(s) * (1.0f / DM) + 1e-6f);
        uint2* o8 = (uint2*)(H + (size_t)m * DM) + lane;
#pragma unroll
        for (int j = 0; j < 4; ++j) { const f32x4 y = v[j] * rs * g[j]; uint2 w; w.x = cvt_pk_bf16(y[0], y[1]); w.y = cvt_pk_bf16(y[2], y[3]); o8[64 * j] = w; }
    }
}

constexpr int KP = 144, VP = 776;
constexpr int LDS_KOFF = 0, LDS_VOFF = 384 * KP;
__device__ __forceinline__ void attn_item(const Args& A, LAS unsigned char* lds, int item, int tid, int wave, int lane, float bound) {
    const bf16* Q = (const bf16*)(A.ws + WS_Q); const bf16* Kg = (const bf16*)(A.ws + WS_K); const bf16* VT = (const bf16*)(A.ws + WS_VT); bf16* MIX = (bf16*)(A.ws + WS_H);
    const int blk = item >> 1, kvh = item & 1, q0 = blk * 128, band0 = q0 - 128;
    int s0, s1; seq_bounds(q0, s0, s1);
    const int vlo = (q0 == s0) ? 128 : 0, vhi = (q0 + 128 == s1) ? 256 : 384;
    for (int c = tid; c < 384 * 8; c += NTHR) {
        const int i = c >> 3, part = c & 7;
        if (i >= vlo && i < vhi) { const v4u v = *(const v4u*)(Kg + (size_t)(band0 + i) * 128 + kvh * 64 + part * 8); *(LAS v4u*)(lds + LDS_KOFF + i * KP + part * 16) = v; }
    }
    for (int c = tid; c < 64 * 48; c += NTHR) {
        const int d = c / 48, part = c % 48, i = part * 8;
        if (i >= vlo && i < vhi) { const v4u v = *(const v4u*)(VT + (size_t)(kvh * 64 + d) * M_TOK + band0 + i);
            LAS v2u* p = (LAS v2u*)(lds + LDS_VOFF + d * VP + part * 16); p[0] = (v2u){v.x, v.y}; p[1] = (v2u){v.z, v.w}; }
    }
    __syncthreads();
    const int hl = wave >> 1, head = kvh * 4 + hl, r = lane & 31, h = lane >> 5;
    const float slope2 = LOG2E * __builtin_amdgcn_exp2f(-(float)(head + 1));
    const float sink = A.attn_sink[head];
    const float m2 = LOG2E * fmaxf(bound, sink), sinkterm = __builtin_amdgcn_exp2f(LOG2E * sink - m2);
#pragma unroll 1
    for (int qs = 0; qs < 2; ++qs) {
        const int qt = 128 + 64 * (wave & 1) + 32 * qs;
        const bf16* qrow = Q + (size_t)(band0 + qt + r) * 512 + head * 64 + 8 * h;
        bf16x8 qf[4];
#pragma unroll
        for (int kk = 0; kk < 4; ++kk) qf[kk] = *(const bf16x8*)(qrow + 16 * kk);
        f32x16 O0, O1;
#pragma unroll
        for (int i = 0; i < 16; ++i) { O0[i] = 0.f; O1[i] = 0.f; }
        float lsum = 0.f;
        const int kb_lo = max(qt - 128, vlo), kb_hi = min(qt + 160, vhi);
#pragma unroll 1
        for (int kb = kb_lo; kb < kb_hi; kb += 32) {
            f32x16 S;
#pragma unroll
            for (int i = 0; i < 16; ++i) S[i] = -m2;
            const LAS unsigned char* kp = lds + LDS_KOFF + (kb + r) * KP + h * 16;
#pragma unroll
            for (int kk = 0; kk < 4; ++kk) { const bf16x8 kf = *(const LAS bf16x8*)(kp + kk * 32); S = __builtin_amdgcn_mfma_f32_32x32x16_bf16(kf, qf[kk], S, 0, 0, 0); }
            const float dbase = (float)(qt + r - kb - 4 * h);
            float p[16];
            if (kb == qt - 128 || kb == qt + 128) {
#pragma unroll
                for (int i = 0; i < 16; ++i) {
                    const float d = dbase - (float)((i & 3) + 8 * (i >> 2));
                    const float e = __builtin_amdgcn_exp2f(S[i] - slope2 * fabsf(d));
                    p[i] = (fabsf(d) <= 128.0f) ? e : 0.f; lsum += p[i];
                }
            } else {
#pragma unroll
                for (int i = 0; i < 16; ++i) {
                    const float d = dbase - (float)((i & 3) + 8 * (i >> 2));
                    p[i] = __builtin_amdgcn_exp2f(S[i] - slope2 * fabsf(d)); lsum += p[i];
                }
            }
#pragma unroll
            for (int s = 0; s < 2; ++s) {
                v4u pk; pk.x = cvt_pk_bf16(p[8 * s], p[8 * s + 1]); pk.y = cvt_pk_bf16(p[8 * s + 2], p[8 * s + 3]); pk.z = cvt_pk_bf16(p[8 * s + 4], p[8 * s + 5]); pk.w = cvt_pk_bf16(p[8 * s + 6], p[8 * s + 7]);
                const bf16x8 ps = __builtin_bit_cast(bf16x8, pk);
                const LAS unsigned char* vp = lds + LDS_VOFF + r * VP + (kb + 16 * s + 4 * h) * 2;
                { const s16x4 lo = *(const LAS s16x4*)(vp), hi = *(const LAS s16x4*)(vp + 16);
                  const bf16x8 vf = __builtin_shufflevector(lo, hi, 0, 1, 2, 3, 4, 5, 6, 7); O0 = __builtin_amdgcn_mfma_f32_32x32x16_bf16(vf, ps, O0, 0, 0, 0); }
                { const s16x4 lo = *(const LAS s16x4*)(vp + 32 * VP), hi = *(const LAS s16x4*)(vp + 32 * VP + 16);
                  const bf16x8 vf = __builtin_shufflevector(lo, hi, 0, 1, 2, 3, 4, 5, 6, 7); O1 = __builtin_amdgcn_mfma_f32_32x32x16_bf16(vf, ps, O1, 0, 0, 0); }
            }
        }
        const float l = lsum + __shfl_xor(lsum, 32);
        const float inv = 1.0f / (l + sinkterm);
        bf16* orow = MIX + (size_t)(band0 + qt + r) * DM + head * 64 + 4 * h;
#pragma unroll
        for (int g = 0; g < 4; ++g) {
            uint2 w; w.x = cvt_pk_bf16(O0[4 * g] * inv, O0[4 * g + 1] * inv); w.y = cvt_pk_bf16(O0[4 * g + 2] * inv, O0[4 * g + 3] * inv); *(uint2*)(orow + 8 * g) = w;
            uint2 x; x.x = cvt_pk_bf16(O1[4 * g] * inv, O1[4 * g + 1] * inv); x.y = cvt_pk_bf16(O1[4 * g + 2] * inv, O1[4 * g + 3] * inv); *(uint2*)(orow + 32 + 8 * g) = x;
        }
    }
    __syncthreads();
}

constexpr int LDS_ST = 96 * 1024;
typedef float f32x2 __attribute__((ext_vector_type(2)));
__device__ __forceinline__ void conv_item(const Args& A, LAS unsigned char* lds, int item, int tid, int wave, int lane, const f32x2 (&w)[31], f32x2 bias, f32x2 lg, f32x2 lb) {
    const bf16* U = (const bf16*)(A.ws + WS_U); bf16* MIX = (bf16*)(A.ws + WS_H);
    const int t0 = item * 64; int s0, s1; seq_bounds(t0, s0, s1);
    for (int i = wave; i < 94; i += NWAVES) {
        const int tok = t0 - 15 + i;
        if (tok >= s0 && tok < s1) __builtin_amdgcn_global_load_lds((const unsigned*)(U + (size_t)tok * 512 + lane * 8), (LAS unsigned*)(lds + i * 1024), 16, 0, 0);
        else *(LAS v4u*)(lds + i * 1024 + lane * 16) = (v4u){0u, 0u, 0u, 0u};
    }
    const int cp = tid & 255, tgb = tid >> 8;
    asm volatile("s_waitcnt vmcnt(0)" ::: "memory");
    __syncthreads();
    LAS float* ST = (LAS float*)(lds + LDS_ST);
#pragma unroll 1
    for (int it = 0; it < 4; ++it) {
        const int tg = tgb + 2 * it;
        f32x2 res[8];
#pragma unroll
        for (int t = 0; t < 8; ++t) res[t] = bias;
        const LAS unsigned* xp = (const LAS unsigned*)(lds + (8 * tg) * 1024 + cp * 4);
#pragma unroll
        for (int c8 = 0; c8 < 5; ++c8) {
            unsigned xr[8];
#pragma unroll
            for (int q = 0; q < 8; ++q) { const int ii = 8 * c8 + q; if (ii < 38) xr[q] = xp[ii * 256]; }
            __builtin_amdgcn_sched_barrier(0);
#pragma unroll
            for (int q = 0; q < 8; ++q) { const int ii = 8 * c8 + q; if (ii < 38) {
                const f32x2 x2 = {__uint_as_float(xr[q] << 16), __uint_as_float(xr[q] & 0xffff0000u)};
#pragma unroll
                for (int t = 0; t < 8; ++t) { const int j = ii - t; if (j >= 0 && j <= 30) res[t] += w[j] * x2; } } }
            __builtin_amdgcn_sched_barrier(0);
        }
        float v[16];
#pragma unroll
        for (int t = 0; t < 8; ++t) { v[2 * t] = res[t].x + res[t].y; v[2 * t + 1] = res[t].x * res[t].x + res[t].y * res[t].y; }
#pragma unroll
        for (int i = 0; i < 8; ++i) { const bool up = lane & 32; const float send = up ? v[i] : v[i + 8], keep = up ? v[i + 8] : v[i]; v[i] = keep + __shfl_xor(send, 32); }
#pragma unroll
        for (int i = 0; i < 4; ++i) { const bool up = lane & 16; const float send = up ? v[i] : v[i + 4], keep = up ? v[i + 4] : v[i]; v[i] = keep + __shfl_xor(send, 16); }
#pragma unroll
        for (int i = 0; i < 2; ++i) { const bool up = lane & 8; const float send = up ? v[i] : v[i + 2], keep = up ? v[i + 2] : v[i]; v[i] = keep + __shfl_xor(send, 8); }
        { const bool up = lane & 4; const float send = up ? v[0] : v[1], keep = up ? v[1] : v[0]; v[0] = keep + __shfl_xor(send, 4); }
        v[0] += __shfl_xor(v[0], 2); v[0] += __shfl_xor(v[0], 1);
        if ((lane & 3) == 0) { const int idx = ((lane >> 5) & 1) * 8 + ((lane >> 4) & 1) * 4 + ((lane >> 3) & 1) * 2 + ((lane >> 2) & 1);
            ST[((8 * tg + (idx >> 1)) * 4 + (wave & 3)) * 2 + (idx & 1)] = v[0]; }
        __syncthreads();
#pragma unroll
        for (int t = 0; t < 8; ++t) {
            const LAS f32x4* sp = (const LAS f32x4*)(ST + (8 * tg + t) * 8); const f32x4 a = sp[0], b = sp[1];
            const float mean = ((a[0] + a[2]) + (b[0] + b[2])) * (1.0f / 512.0f), ex2 = ((a[1] + a[3]) + (b[1] + b[3])) * (1.0f / 512.0f);
            const float rstd = __builtin_amdgcn_rsqf(fmaxf(ex2 - mean * mean, 0.f) + 1e-5f);
            const f32x2 y = (res[t] - mean) * rstd * lg + lb;
            *(unsigned*)(MIX + (size_t)(t0 + 8 * tg + t) * DM + 512 + 2 * cp) = cvt_pk_bf16(fast_silu(y.x), fast_silu(y.y));
        }
    }
    __syncthreads();
}

__device__ __forceinline__ void fix_edges(const Args& A, int gtid, int gthreads) {
    constexpr int ncols = DFF, chbase = 0;
    const float* ge = (const float*)((unsigned char*)A.out + DO_GE); const float* ue = (const float*)((unsigned char*)A.out + DO_UE); bf16* act = (bf16*)(A.ws + WS_ACT);
    const int ng = ncols >> 2, total = 512 * 2 * ng;
    for (int idx = gtid; idx < total; idx += gthreads) {
        const int cg4 = idx % ng, rw = idx / ng, which = rw & 1, chunk = rw >> 1, col = 4 * cg4;
        const int row = 64 * chunk + (which ? 63 : 0); int s0, s1; seq_bounds(row, s0, s1);
        const f32x4 zero = {0.f, 0.f, 0.f, 0.f};
        f32x4 pv, cur, nx, up;
        if (which == 0) { pv = (row == s0) ? zero : *(const f32x4*)(ge + ((size_t)(chunk - 1) * 4 + 3) * ncols + col); cur = *(const f32x4*)(ge + ((size_t)chunk * 4 + 0) * ncols + col); nx = *(const f32x4*)(ge + ((size_t)chunk * 4 + 1) * ncols + col); up = *(const f32x4*)(ue + ((size_t)chunk * 2) * ncols + col); }
        else { pv = *(const f32x4*)(ge + ((size_t)chunk * 4 + 2) * ncols + col); cur = *(const f32x4*)(ge + ((size_t)chunk * 4 + 3) * ncols + col); nx = (row + 1 == s1) ? zero : *(const f32x4*)(ge + ((size_t)(chunk + 1) * 4 + 0) * ncols + col); up = *(const f32x4*)(ue + ((size_t)chunk * 2 + 1) * ncols + col); }
        const int gc = chbase + col;
        const f32x4 w0 = *(const f32x4*)(A.ffn_dw_w + gc), w1 = *(const f32x4*)(A.ffn_dw_w + DFF + gc), w2 = *(const f32x4*)(A.ffn_dw_w + 2 * DFF + gc), bb = *(const f32x4*)(A.ffn_dw_b + gc);
        float o[4];
#pragma unroll
        for (int j = 0; j < 4; ++j) { const float cv = bb[j] + w0[j] * pv[j] + w1[j] * cur[j] + w2[j] * nx[j]; o[j] = fast_silu(cv) * up[j]; }
        uint2 w; w.x = cvt_pk_bf16(o[0], o[1]); w.y = cvt_pk_bf16(o[2], o[3]);
        *(uint2*)(act + (size_t)row * ncols + col) = w;
    }
}

#define XB_TMO      128
#define XB_XCNT(j)  (256  + 64 * (j))
#define XB_XSUB(j)  (1280 + 64 * (j))
#define XB_XGEN(j)  (2304 + 64 * (j))
#define XB_TOP      3328
#define XB_TOPGEN   3392
#define XCD_BAR_WORDS 3456
#define XB_SPIN_CAP (1u << 18)

__device__ __forceinline__ unsigned xb_ld(unsigned* p)              { return __hip_atomic_load(p, __ATOMIC_RELAXED, __HIP_MEMORY_SCOPE_AGENT); }
__device__ __forceinline__ unsigned xb_add(unsigned* p, unsigned v) { return __hip_atomic_fetch_add(p, v, __ATOMIC_RELAXED, __HIP_MEMORY_SCOPE_AGENT); }
__device__ __forceinline__ unsigned xb_xcc_id() { return (unsigned)__builtin_amdgcn_s_getreg((3 << 11) | 20) & 0xFu; }
#define XB_SPIN(cond, bar) do { unsigned _sp = 0; while (cond) { __builtin_amdgcn_s_sleep(1); \
    if ((++_sp & 255u) == 0u) { if (xb_ld(&(bar)[XB_TMO])) break; if (_sp > XB_SPIN_CAP) { atomicAdd(&(bar)[XB_TMO], 1u); break; } } } } while (0)

struct XcdBarrier {
    unsigned* bar; unsigned x;
    volatile LAS unsigned* st;
};

__device__ __forceinline__ XcdBarrier xcd_barrier_post(unsigned* bar, volatile LAS unsigned* st) {
    XcdBarrier b; b.bar = bar; b.x = xb_xcc_id(); b.st = st;
    if (threadIdx.x == 0) (void)xb_add(&bar[XB_XCNT(b.x)], 1u);
    return b;
}
__device__ __forceinline__ void xcd_barrier_complete(unsigned* bar, unsigned x, unsigned& nloc, unsigned& nx) {
    const unsigned G = gridDim.x * gridDim.y * gridDim.z;
    unsigned sum, cnt, mine, sp = 0u;
    for (;;) {
        sum = 0u; cnt = 0u; mine = 0u;
#pragma unroll
        for (unsigned j = 0; j < 16; ++j) { const unsigned c = xb_ld(&bar[XB_XCNT(j)]); sum += c; cnt += (c > 0u) ? 1u : 0u; mine = (j == x) ? c : mine; }
        if (sum == G) break;
        __builtin_amdgcn_s_sleep(1);
        if ((++sp & 255u) == 0u) { if (xb_ld(&bar[XB_TMO])) break; if (sp > XB_SPIN_CAP) { atomicAdd(&bar[XB_TMO], 1u); break; } }
    }
    nloc = mine > 0u ? mine : 1u; nx = cnt > 0u ? cnt : 1u;
}

__device__ __forceinline__ void xcd_barrier(const XcdBarrier& b) {
    asm volatile("s_waitcnt vmcnt(0)" ::: "memory");
    __syncthreads();
    if (threadIdx.x == 0) {
        unsigned* bar = b.bar;
        __builtin_amdgcn_s_waitcnt(0);
        unsigned nloc = b.st[0], nx = b.st[1];
        if (nloc == 0u) { xcd_barrier_complete(bar, b.x, nloc, nx); b.st[0] = nloc; b.st[1] = nx; }
        const unsigned old = xb_add(&bar[XB_XSUB(b.x)], 1u);
        const unsigned gen = old / nloc;
        if (old + 1u == (gen + 1u) * nloc) {
            __builtin_amdgcn_fence(__ATOMIC_RELEASE, "agent");
            asm volatile("s_waitcnt vmcnt(0)" ::: "memory");
            const unsigned og = xb_add(&bar[XB_TOP], 1u);
            const unsigned tg = og / nx;
            if (og + 1u == (tg + 1u) * nx) xb_add(&bar[XB_TOPGEN], 1u);
            else XB_SPIN(xb_ld(&bar[XB_TOPGEN]) == tg, bar);
            __builtin_amdgcn_fence(__ATOMIC_ACQUIRE, "agent");
            xb_add(&bar[XB_XGEN(b.x)], 1u);
            asm volatile("s_waitcnt vmcnt(0)" ::: "memory");
        } else {
            XB_SPIN(xb_ld(&bar[XB_XGEN(b.x)]) == gen, bar);
            __builtin_amdgcn_fence(__ATOMIC_ACQUIRE, "agent");
            asm volatile("s_waitcnt vmcnt(0)" ::: "memory");
        }
    }
    __syncthreads();
}
__global__ void __launch_bounds__(NTHR, 2) hymba_fwd(Args A) {
    extern __shared__ __attribute__((aligned(16))) unsigned char lds_raw[];
    LAS unsigned char* lds = (LAS unsigned char*)lds_raw;
    cg::grid_group grid = cg::this_grid();
    const int tid = threadIdx.x, lane = tid & 63, wave = __builtin_amdgcn_readfirstlane(tid >> 6);
    const int G = gridDim.x, bx = blockIdx.x;
    const int gw = bx * NWAVES + wave, NGW = G * NWAVES;
    unsigned char* ws = A.ws; unsigned char* dob = (unsigned char*)A.out;
    const int lo = A.ph_lo, hi = A.ph_hi;
    volatile LAS unsigned* xb_st = (volatile LAS unsigned*)(lds + 131072 + 8192);
    if (tid < 4) xb_st[tid] = 0u;
    __syncthreads();
    const XcdBarrier xbar = xcd_barrier_post((unsigned*)(ws + WS_BAR), xb_st);
    if (lo > 1000) grid.sync();
#ifndef PMASK
#define PMASK 0x7f
#endif
#define IN(k) (((PMASK >> (k)) & 1) && lo <= (k) && (k) < hi)
#ifndef REPMASK
#define REPMASK 0
#endif
#ifndef XSYNC
#define XSYNC 0
#endif
#define REPS(k) (((REPMASK >> (k)) & 1) ? 2 : 1)
#define SEAM(k) do { if (IN(k) && IN((k) + 1)) { xcd_barrier(xbar); if ((k) == 0) for (int xs_ = 0; xs_ < XSYNC; ++xs_) xcd_barrier(xbar); } } while (0)
    if (IN(0)) for (int rep = 0; rep < REPS(0); ++rep) phase0(A, lds, gw, NGW, wave, lane);
    SEAM(0);
    if (IN(1)) {
        pg8::Gemm g{(const pg8::bf16_t*)(ws + WS_H), (const pg8::bf16_t*)(ws + WS_WIN), M_TOK, 1792, 1024}; pg8::StaticOrder S; S.init(M_TOK, 1792, G, bx); S.rep = REPS(1);
        pg8::EpiInProj E{(pg8::bf16_t*)(ws + WS_Q), (pg8::bf16_t*)(ws + WS_K), (pg8::bf16_t*)(ws + WS_VT), (pg8::bf16_t*)(ws + WS_U), A.q_norm_g, A.k_norm_g};
        pg8::gemm_phase<pg8::EpiInProj, pg8::StaticOrder, true, true>(lds, g, S, E);
    }
    SEAM(1);
    if (IN(2)) {
        const float gqm = wave_max(fabsf(A.q_norm_g[lane])), gkm = wave_max(fabsf(A.k_norm_g[lane]));
        const float bound = 8.0f * gqm * gkm;
#ifndef NO_ATTN
        for (int it = bx; it < 512 * REPS(2); it += G) attn_item(A, lds, it & 511, tid, wave, lane, bound);
#endif
#ifndef NO_CONV
        {
            const int cp = tid & 255;
            f32x2 w[31];
#pragma unroll
            for (int j = 0; j < 31; ++j) { const float2 t = *(const float2*)(A.conv_dw_w + j * 512 + 2 * cp); w[j] = (f32x2){t.x, t.y}; }
            const float2 b_ = *(const float2*)(A.conv_dw_b + 2 * cp), g_ = *(const float2*)(A.conv_ln_g + 2 * cp), l_ = *(const float2*)(A.conv_ln_b + 2 * cp);
            const f32x2 bias = {b_.x, b_.y}, lg = {g_.x, g_.y}, lb = {l_.x, l_.y};
#pragma unroll 1
            for (int it = bx; it < 512 * REPS(7); it += G) conv_item(A, lds, it & 511, tid, wave, lane, w, bias, lg, lb);
        }
#endif
    }
    SEAM(2);
    if (IN(3)) {
        pg8::Gemm g{(const pg8::bf16_t*)(ws + WS_H), (const pg8::bf16_t*)(ws + WS_WO), M_TOK, 1024, 1024}; pg8::StaticOrder S; S.init(M_TOK, 1024, G, bx); S.rep = REPS(3);
        pg8::EpiOutProj E{A.xp, A.xs, (pg8::bf16_t*)(ws + WS_DELTA), (pg8::bf16_t*)(dob + DO_X1B), (float*)(ws + WS_SSQ), (LAS float*)(lds + 131072)};
        pg8::gemm_phase<pg8::EpiOutProj, pg8::StaticOrder, true, true>(lds, g, S, E);
    }
    SEAM(3);
    if (IN(4)) {
        pg8::Gemm g{(const pg8::bf16_t*)(dob + DO_X1B), (const pg8::bf16_t*)(dob + DO_WGU), M_TOK, 2 * DFF, 1024}; pg8::StaticOrder S; S.init(M_TOK, 2 * DFF, G, bx); S.rep = REPS(4);
        pg8::EpiGateUp E{(pg8::bf16_t*)(ws + WS_ACT), (float*)(dob + DO_GE), (float*)(dob + DO_UE), (const float*)(ws + WS_SSQ), A.ffn_dw_w, A.ffn_dw_b};
        pg8::gemm_phase<pg8::EpiGateUp, pg8::StaticOrder, true, true>(lds, g, S, E);
    }
    SEAM(4);
    if (IN(5)) for (int rep = 0; rep < REPS(5); ++rep) fix_edges(A, bx * NTHR + tid, G * NTHR);
    SEAM(5);
    if (IN(6)) {
        pg8::Gemm g{(const pg8::bf16_t*)(ws + WS_ACT), (const pg8::bf16_t*)(ws + WS_WD), M_TOK, 1024, DFF}; pg8::StaticOrder S; S.init(M_TOK, 1024, G, bx); S.rep = REPS(6);
        pg8::EpiDown E{A.xp, A.xs, (const pg8::bf16_t*)(ws + WS_DELTA), A.out};
        pg8::gemm_phase<pg8::EpiDown, pg8::StaticOrder, true, true>(lds, g, S, E);
    }
#undef IN
#undef SEAM
}

#ifndef N_LAUNCH_PER_PHASE
#define N_LAUNCH_PER_PHASE 0
#endif
extern "C" void kernel_launch(void* const* d_in, const int* in_sizes, int n_in, void* d_out, int out_size, void* d_ws, size_t ws_size, hipStream_t stream) {
    static int grid = 0;
    if (grid == 0) {
        if (n_in != 18 || out_size != M_TOK * DM || ws_size < WS_END) { fprintf(stderr, "kernel_launch: unexpected shapes (n_in %d out %d ws %zu)\n", n_in, out_size, ws_size); grid = -1; return; }
        int dev = 0, cus = 0, per_cu = 0;
        hipGetDevice(&dev); hipDeviceGetAttribute(&cus, hipDeviceAttributeMultiprocessorCount, dev);
        if (hipFuncSetAttribute((const void*)hymba_fwd, hipFuncAttributeMaxDynamicSharedMemorySize, LDS_BYTES) != hipSuccess) { fprintf(stderr, "kernel_launch: hipFuncSetAttribute failed\n"); grid = -1; return; }
        if (hipOccupancyMaxActiveBlocksPerMultiprocessor(&per_cu, (const void*)hymba_fwd, NTHR, LDS_BYTES) != hipSuccess || per_cu < 1) { fprintf(stderr, "kernel_launch: occupancy query says %d\n", per_cu); per_cu = 1; }
        (void)hipGetLastError();
        grid = cus * 1;
    }
    if (grid < 0) return;
    if (hipMemsetAsync((char*)d_ws + WS_BAR, 0, BAR_BYTES, stream) != hipSuccess) { fprintf(stderr, "kernel_launch: memset failed\n"); return; }
    Args a{};
    const float** slots = (const float**)&a;
    for (int i = 0; i < 18; ++i) slots[i] = (const float*)d_in[i];
    a.out = (float*)d_out; a.ws = (unsigned char*)d_ws;
#if N_LAUNCH_PER_PHASE
    for (int p = 0; p < 7; ++p) { a.ph_lo = p; a.ph_hi = p + 1; hipLaunchKernelGGL(hymba_fwd, dim3(grid), dim3(NTHR), LDS_BYTES, stream, a); }
#else
    a.ph_lo = 0; a.ph_hi = 7;
    void* args[] = {&a};
    hipError_t e = hipLaunchCooperativeKernel((const void*)hymba_fwd, dim3(grid), dim3(NTHR), args, LDS_BYTES, stream);
    if (e != hipSuccess) fprintf(stderr, "cooperative launch failed: %s (grid %d)\n", hipGetErrorString(e), grid);
#endif
}
```

```cpp
#include <hip/hip_runtime.h>
#include <hip/hip_cooperative_groups.h>
#include <cstdio>
#include <cstdint>
namespace cg = cooperative_groups;
namespace pg8 {
#define PG8_LAS __attribute__((address_space(3)))
typedef unsigned short bf16_t;
typedef short bf16x8 __attribute__((ext_vector_type(8)));
typedef float f32x4 __attribute__((ext_vector_type(4)));
typedef unsigned u32x4 __attribute__((ext_vector_type(4)));
constexpr int BM = 256, BK = 64, HALF = 128, HTB = HALF * BK * 2  , STAGE_BYTES = 8 * HTB, NXCD = 8, WGM = 8;

__host__ __device__ __forceinline__ int lds_byte(int r, int c) { const int st = (r >> 4) * 2 + (c >> 5), rr = r & 15, cc = c & 31, ob = rr * 64 + cc * 2; return st * 1024 + (ob ^ (((ob >> 9) & 1) << 5)); }
__host__ __device__ __forceinline__ void stage_rc(int b, int& R, int& C) { const int st = b / 1024, sb = b % 1024, swz = sb ^ (((sb >> 9) & 1) << 5); R = (st >> 1) * 16 + swz / 64; C = (st & 1) * 32 + (swz % 64) / 2; }
__host__ __device__ __forceinline__ int perm32(int rho) { const int n = rho >> 4, i = rho & 15; return 8 * (i >> 2) + 4 * n + (i & 3); }

struct Unit { int pm, pn; };
struct Gemm { const bf16_t* A; const bf16_t* Bt; int M, N, K; };

struct StaticOrder {
    int nM, nN, nwg, G, c, rep = 1;
    __host__ __device__ void init(int M, int N, int G_, int c_) { nM = M / BM; nN = N / BM; nwg = nM * nN; G = G_; c = c_; }
    __host__ __device__ bool next(int i, Unit& u) const {
        const int rounds = (nwg - c + G - 1) / G; if (i >= rep * rounds) return false; const long L = (long)(i % rounds) * G + c;
        int wgid = (int)L; { const int q = nwg / NXCD, r = nwg % NXCD, xcd = wgid % NXCD, off = wgid / NXCD; wgid = (xcd < r ? xcd * (q + 1) : r * (q + 1) + (xcd - r) * q) + off; }
        const int nig = WGM * nN, gid = wgid / nig, fm = gid * WGM, gsz = (nM - fm) < WGM ? (nM - fm) : WGM;
        u.pm = fm + ((wgid % nig) % gsz); u.pn = (wgid % nig) / gsz; return true;
    }
    __device__ __forceinline__ void a_ready(const Unit&) const {}
    __device__ __forceinline__ void done(const Unit&) const {}
};

__device__ __forceinline__ unsigned cvt_pk_bf16(float lo, float hi) { unsigned r; asm volatile("v_cvt_pk_bf16_f32 %0, %1, %2" : "=v"(r) : "v"(lo), "v"(hi)); return r; }
typedef float f32x2 __attribute__((ext_vector_type(2)));
constexpr int M_TOK = 32768, DM = 1024, M_PROMPT = 16384, T_PROMPT = 2048, T_SAMPLE = 8192, DFF = 2816;
constexpr float LOG2E = 1.4426950408889634f;
constexpr float QSCALE = 0.125f * LOG2E;
__device__ __forceinline__ void seq_bounds(int row, int& s0, int& s1) {
    if (row < M_PROMPT) { s0 = row & ~(T_PROMPT - 1); s1 = s0 + T_PROMPT; }
    else { s0 = M_PROMPT + ((row - M_PROMPT) & ~(T_SAMPLE - 1)); s1 = s0 + T_SAMPLE; }
}
__device__ __forceinline__ float fast_sigmoid(float v) { return __builtin_amdgcn_rcpf(1.0f + __builtin_amdgcn_exp2f(-LOG2E * v)); }
__device__ __forceinline__ float fast_silu(float v) { return v * fast_sigmoid(v); }

struct EpiInProj {
    static constexpr bool PERM = true, AFTER_DRAIN = false, PREFETCH = false, TWICE = false, PRELOAD = false; struct Pre {};
    bf16_t* Q; bf16_t* Kb; bf16_t* VT; bf16_t* U; const float* gq; const float* gk;
    __device__ __forceinline__ void operator()(f32x4 (&acc)[2][2][4][2], const Unit& u, int wr, int wc, int fr, int fq) const {
        asm volatile("" : "+v"(fr), "+v"(fq));
        const int row0 = u.pm * BM + wr * 64 + fr;
        if (u.pn < 3) {
            const bool isq = u.pn < 2, isk = (u.pn == 2) && (wc < 2);
            if (isq || isk) {
                const float* g = isq ? gq : gk; const float sc = isq ? QSCALE : 1.0f;
                f32x4 gv[2][2];
#pragma unroll
                for (int bj = 0; bj < 2; ++bj)
#pragma unroll
                    for (int n = 0; n < 2; ++n) gv[bj][n] = *(const f32x4*)(g + 32 * bj + 8 * fq + 4 * n) * sc;
                bf16_t* dst = isq ? (Q + (size_t)(u.pn * 4 + wc) * 64) : (Kb + (size_t)wc * 64);
                const int pitch = isq ? 512 : 128;
#pragma unroll
                for (int ai = 0; ai < 2; ++ai)
#pragma unroll
                    for (int m = 0; m < 4; ++m) {
                        float s = 0.f;
#pragma unroll
                        for (int bj = 0; bj < 2; ++bj)
#pragma unroll
                            for (int n = 0; n < 2; ++n) { const f32x4 x = acc[ai][bj][m][n]; s += (x[0] * x[0] + x[1] * x[1]) + (x[2] * x[2] + x[3] * x[3]); }
                        s += __shfl_xor(s, 16); s += __shfl_xor(s, 32);
                        const float rs = __builtin_amdgcn_rsqf(s * (1.0f / 64.0f) + 1e-6f);
                        bf16_t* rowp = dst + (size_t)(row0 + ai * HALF + m * 16) * pitch + 8 * fq;
#pragma unroll
                        for (int bj = 0; bj < 2; ++bj) {
                            const f32x4 v0 = acc[ai][bj][m][0] * rs * gv[bj][0], v1 = acc[ai][bj][m][1] * rs * gv[bj][1];
                            u32x4 w; w.x = cvt_pk_bf16(v0[0], v0[1]); w.y = cvt_pk_bf16(v0[2], v0[3]); w.z = cvt_pk_bf16(v1[0], v1[1]); w.w = cvt_pk_bf16(v1[2], v1[3]);
                            *(u32x4*)(rowp + 32 * bj) = w;
                        }
                    }
            } else {
                bf16_t* vt = VT + (size_t)(wc - 2) * 64 * M_TOK;
#pragma unroll
                for (int ai = 0; ai < 2; ++ai)
#pragma unroll
                    for (int m = 0; m < 4; ++m) {
                        const int row = row0 + ai * HALF + m * 16;
#pragma unroll
                        for (int bj = 0; bj < 2; ++bj)
#pragma unroll
                            for (int n = 0; n < 2; ++n) {
                                const f32x4 x = acc[ai][bj][m][n]; const int d0 = 32 * bj + 8 * fq + 4 * n;
                                const unsigned p01 = cvt_pk_bf16(x[0], x[1]), p23 = cvt_pk_bf16(x[2], x[3]);
                                vt[(size_t)(d0 + 0) * M_TOK + row] = (bf16_t)(p01 & 0xffffu); vt[(size_t)(d0 + 1) * M_TOK + row] = (bf16_t)(p01 >> 16);
                                vt[(size_t)(d0 + 2) * M_TOK + row] = (bf16_t)(p23 & 0xffffu); vt[(size_t)(d0 + 3) * M_TOK + row] = (bf16_t)(p23 >> 16);
                            }
                    }
            }
        } else {
            bf16_t* dst = U + (size_t)(u.pn - 3) * 128 + 32 * wc + 8 * fq;
#pragma unroll
            for (int ai = 0; ai < 2; ++ai)
#pragma unroll
                for (int m = 0; m < 4; ++m) {
                    f32x4 o[2];
#pragma unroll
                    for (int n = 0; n < 2; ++n) { const f32x4 a = acc[ai][0][m][n], g = acc[ai][1][m][n];
#pragma unroll
                        for (int j = 0; j < 4; ++j) o[n][j] = a[j] * fast_sigmoid(g[j]); }
                    u32x4 w; w.x = cvt_pk_bf16(o[0][0], o[0][1]); w.y = cvt_pk_bf16(o[0][2], o[0][3]); w.z = cvt_pk_bf16(o[1][0], o[1][1]); w.w = cvt_pk_bf16(o[1][2], o[1][3]);
                    *(u32x4*)(dst + (size_t)(row0 + ai * HALF + m * 16) * 512) = w;
                }
        }
    }
};

struct EpiOutProj {
    static constexpr bool PERM = true, AFTER_DRAIN = false, PREFETCH = false, TWICE = false, PRELOAD = false; struct Pre {};
    __device__ __forceinline__ void prefetch(const Unit& u, PG8_LAS unsigned char* lds) const {
        const int t = threadIdx.x; const float* xb = (u.pm * BM < M_PROMPT) ? xp : (xs - (size_t)M_PROMPT * DM);
        PG8_LAS unsigned* dummy = (PG8_LAS unsigned*)(lds + 131072 + 4096 + (t >> 6) * 256);
#pragma unroll
        for (int i = 0; i < 4; ++i) { const int L = t + 512 * i; __builtin_amdgcn_global_load_lds((const unsigned*)(xb + (size_t)(u.pm * BM + (L >> 3)) * DM + u.pn * BM + (L & 7) * 32), dummy, 4, 0, 0); }
    }
    const float* xp; const float* xs; bf16_t* delta; bf16_t* x1b; float* ssq; PG8_LAS float* red;
    __device__ __forceinline__ void operator()(f32x4 (&acc)[2][2][4][2], const Unit& u, int wr, int wc, int fr, int fq) const {
        asm volatile("" : "+v"(fr), "+v"(fq));
        const int row0 = u.pm * BM + wr * 64 + fr, col0 = u.pn * BM + wc * 32 + 8 * fq;
        const float* xb = (u.pm * BM < M_PROMPT) ? xp : (xs - (size_t)M_PROMPT * DM);
#pragma unroll
        for (int ai = 0; ai < 2; ++ai)
#pragma unroll
            for (int mh = 0; mh < 2; ++mh) {
                f32x4 xv[2][2][2];
#pragma unroll
                for (int mm = 0; mm < 2; ++mm)
#pragma unroll
                    for (int bj = 0; bj < 2; ++bj) { const float* p = xb + (size_t)(row0 + ai * HALF + (2 * mh + mm) * 16) * DM + col0 + bj * HALF; xv[mm][bj][0] = *(const f32x4*)p; xv[mm][bj][1] = *(const f32x4*)(p + 4); }
                __builtin_amdgcn_sched_barrier(0);
#pragma unroll
                for (int mm = 0; mm < 2; ++mm) {
                    const int m = 2 * mh + mm; const int row = row0 + ai * HALF + m * 16; const size_t ro = (size_t)row * DM + col0; float s = 0.f;
#pragma unroll
                    for (int bj = 0; bj < 2; ++bj) {
                        const f32x4 a0 = acc[ai][bj][m][0], a1 = acc[ai][bj][m][1];
                        const f32x4 v0 = a0 + xv[mm][bj][0], v1 = a1 + xv[mm][bj][1];
                        s += ((v0[0] * v0[0] + v0[1] * v0[1]) + (v0[2] * v0[2] + v0[3] * v0[3])) + ((v1[0] * v1[0] + v1[1] * v1[1]) + (v1[2] * v1[2] + v1[3] * v1[3]));
                        u32x4 y; y.x = cvt_pk_bf16(v0[0], v0[1]); y.y = cvt_pk_bf16(v0[2], v0[3]); y.z = cvt_pk_bf16(v1[0], v1[1]); y.w = cvt_pk_bf16(v1[2], v1[3]);
                        *(u32x4*)(x1b + ro + bj * HALF) = y;
                    }
                    s += __shfl_xor(s, 16); s += __shfl_xor(s, 32);
                    if (fq == 0) red[(ai * HALF + wr * 64 + m * 16 + fr) * 4 + wc] = s;
                }
                __builtin_amdgcn_sched_barrier(0);
            }
        __syncthreads();
        const int t = threadIdx.x;
        if (t < 256) { const f32x4 v = *(const PG8_LAS f32x4*)(red + t * 4); ssq[(size_t)(u.pm * BM + t) * 4 + u.pn] = (v[0] + v[1]) + (v[2] + v[3]); }
    }
};

template <int CTRL> __device__ __forceinline__ float dpp_row(float v) { return __builtin_bit_cast(float, __builtin_amdgcn_update_dpp(0, __builtin_bit_cast(int, v), CTRL, 0xF, 0xF, false)); }
struct EpiGateUp {
    static constexpr bool PERM = true, AFTER_DRAIN = false, PREFETCH = false, TWICE = false, PRELOAD = true; struct Pre { f32x4 s[2]; };
    bf16_t* act; float* ge; float* ue; const float* ssq; const float* cw; const float* cb; PG8_LAS float* xch; int second = 0;
    static constexpr int ncols = DFF, chbase = 0;
    __device__ __forceinline__ void preload(const Unit& u, int wr, int wc, int lane, Pre& pre) const {
#pragma unroll
        for (int ai = 0; ai < 2; ++ai) pre.s[ai] = *(const f32x4*)(ssq + (size_t)(u.pm * BM + ai * HALF + wr * 64 + lane) * 4);
        const int wid = wr * 4 + wc, j = wid >> 1, half = wid & 1;
        const float* src = (j < 3 ? cw + (size_t)j * DFF : cb) + chbase + u.pn * 128 + half * 64 + lane;
        __builtin_amdgcn_global_load_lds((const unsigned*)src, (PG8_LAS unsigned*)(xch + 1024 + j * 128 + half * 64), 4, 0, 0);
    }
    __device__ __forceinline__ void operator()(f32x4 (&acc)[2][2][4][2], const Unit& u, int wr, int wc, int fr, int fq, const Pre& pre) const {
        asm volatile("" : "+v"(fr), "+v"(fq));
        const int lane = fr + 16 * fq, wid = wr * 4 + wc;
        const int ch0 = u.pn * 128 + 32 * wc + 8 * fq;
        const int lprev = (lane & 48) | ((fr + 15) & 15), lnext = (lane & 48) | ((fr + 1) & 15);
#pragma unroll
        for (int ai = 0; ai < 2; ++ai) {
            const int crow0 = u.pm * BM + ai * HALF + wr * 64;
            const float rs_own = __builtin_amdgcn_rsqf(((pre.s[ai][0] + pre.s[ai][1]) + (pre.s[ai][2] + pre.s[ai][3])) * (1.0f / 1024.0f) + 1e-6f);
#pragma unroll
            for (int m = 0; m < 4; ++m) {
                const float rstd = second ? 1.0f : __shfl(rs_own, 16 * m + fr);
                const float rsu = second ? 1.0f : rstd * (-0.6931471805599453f);
#pragma unroll
                for (int n = 0; n < 2; ++n) { acc[ai][0][m][n] *= rstd; acc[ai][1][m][n] *= rsu; }
            }
            if (fr == 0)  { PG8_LAS float* p = xch + (((wid * 2 + ai) * 2 + 0) * 4 + fq) * 8; *(PG8_LAS f32x4*)p = acc[ai][0][0][0]; *(PG8_LAS f32x4*)(p + 4) = acc[ai][0][0][1]; }
            if (fr == 15) { PG8_LAS float* p = xch + (((wid * 2 + ai) * 2 + 1) * 4 + fq) * 8; *(PG8_LAS f32x4*)p = acc[ai][0][3][0]; *(PG8_LAS f32x4*)(p + 4) = acc[ai][0][3][1]; }
            const int q = 2 * ai + wr;
            if (q == 0 && fr < 2) {
                float* g = ge + ((size_t)u.pm * 4 + fr) * ncols + ch0;
                *(f32x4*)g = acc[ai][0][0][0]; *(f32x4*)(g + 4) = acc[ai][0][0][1];
                if (fr == 0) { float* p = ue + ((size_t)u.pm * 2) * ncols + ch0; *(f32x4*)p = acc[ai][1][0][0] * (-LOG2E); *(f32x4*)(p + 4) = acc[ai][1][0][1] * (-LOG2E); }
            }
            if (q == 3 && fr >= 14) {
                float* g = ge + ((size_t)u.pm * 4 + (fr - 12)) * ncols + ch0;
                *(f32x4*)g = acc[ai][0][3][0]; *(f32x4*)(g + 4) = acc[ai][0][3][1];
                if (fr == 15) { float* p = ue + ((size_t)u.pm * 2 + 1) * ncols + ch0; *(f32x4*)p = acc[ai][1][3][0] * (-LOG2E); *(f32x4*)(p + 4) = acc[ai][1][3][1] * (-LOG2E); }
            }
        }
        __syncthreads();
#pragma unroll
        for (int ai = 0; ai < 2; ++ai) {
            const int crow0 = u.pm * BM + ai * HALF + wr * 64;
            const int q = 2 * ai + wr, qp = (q + 3) & 3, qn = (q + 1) & 3;
            unsigned pk[2][4][2];
#pragma unroll
            for (int n = 0; n < 2; ++n) {
                const PG8_LAS float* wl = xch + 1024 + 32 * wc + 8 * fq + 4 * n;
                const f32x4 w0 = *(const PG8_LAS f32x4*)(wl), w1 = *(const PG8_LAS f32x4*)(wl + 128), w2 = *(const PG8_LAS f32x4*)(wl + 256), bb = *(const PG8_LAS f32x4*)(wl + 384);
                const f32x4 pvx = *(const PG8_LAS f32x4*)(xch + (((((qp & 1) * 4 + wc) * 2 + (qp >> 1)) * 2 + 1) * 4 + fq) * 8 + 4 * n);
                const f32x4 nxx = *(const PG8_LAS f32x4*)(xch + (((((qn & 1) * 4 + wc) * 2 + (qn >> 1)) * 2 + 0) * 4 + fq) * 8 + 4 * n);
#pragma unroll
                for (int jp = 0; jp < 2; ++jp) {
                    const f32x2 w0p = (f32x2){w0[2 * jp], w0[2 * jp + 1]} * (-LOG2E), w1p = (f32x2){w1[2 * jp], w1[2 * jp + 1]} * (-LOG2E), w2p = (f32x2){w2[2 * jp], w2[2 * jp + 1]} * (-LOG2E), bbp = (f32x2){bb[2 * jp], bb[2 * jp + 1]} * (-LOG2E);
                    f32x2 g[4], R[4], L[4];
#pragma unroll
                    for (int m = 0; m < 4; ++m) { g[m] = (f32x2){acc[ai][0][m][n][2 * jp], acc[ai][0][m][n][2 * jp + 1]};
                        R[m] = (f32x2){dpp_row<0x121>(g[m].x), dpp_row<0x121>(g[m].y)}; L[m] = (f32x2){dpp_row<0x12F>(g[m].x), dpp_row<0x12F>(g[m].y)}; }
                    const f32x2 pvx2 = {pvx[2 * jp], pvx[2 * jp + 1]}, nxx2 = {nxx[2 * jp], nxx[2 * jp + 1]};
#pragma unroll
                    for (int m = 0; m < 4; ++m) {
                        const f32x2 pv = (fr == 0) ? (m > 0 ? R[m > 0 ? m - 1 : 0] : pvx2) : R[m];
                        const f32x2 nx = (fr == 15) ? (m < 3 ? L[m < 3 ? m + 1 : 3] : nxx2) : L[m];
                        const f32x2 cvs = bbp + w0p * pv + w1p * g[m] + w2p * nx;
                        f32x2 d = {__builtin_amdgcn_exp2f(cvs.x), __builtin_amdgcn_exp2f(cvs.y)}; d = d + 1.0f;
                        const f32x2 r = {__builtin_amdgcn_rcpf(d.x), __builtin_amdgcn_rcpf(d.y)};
                        const f32x2 upv = {acc[ai][1][m][n][2 * jp], acc[ai][1][m][n][2 * jp + 1]};
                        const f32x2 o = (cvs * r) * upv;
                        pk[n][m][jp] = cvt_pk_bf16(o.x, o.y);
                    }
                }
                __builtin_amdgcn_sched_barrier(0);
            }
#pragma unroll
            for (int m = 0; m < 4; ++m) {
                const bool edge = (q == 0 && m == 0 && fr == 0) || (q == 3 && m == 3 && fr == 15);
                if (!edge) { u32x4 w; w.x = pk[0][m][0]; w.y = pk[0][m][1]; w.z = pk[1][m][0]; w.w = pk[1][m][1];
                    *(u32x4*)(act + (size_t)(crow0 + m * 16 + fr) * ncols + ch0) = w; }
            }
        }
    }
};

struct EpiDown {
    static constexpr bool PERM = true, AFTER_DRAIN = false, PREFETCH = false, TWICE = false, PRELOAD = false; struct Pre {};
    __device__ __forceinline__ void prefetch(const Unit& u, PG8_LAS unsigned char* lds) const {
        const int t = threadIdx.x; const float* xb = (u.pm * BM < M_PROMPT) ? xp : (xs - (size_t)M_PROMPT * DM);
        PG8_LAS unsigned* dummy = (PG8_LAS unsigned*)(lds + 131072 + 4096 + (t >> 6) * 256);
#pragma unroll
        for (int i = 0; i < 4; ++i) { const int L = t + 512 * i; __builtin_amdgcn_global_load_lds((const unsigned*)(xb + (size_t)(u.pm * BM + (L >> 3)) * DM + u.pn * BM + (L & 7) * 32), dummy, 4, 0, 0); }
#pragma unroll
        for (int i = 0; i < 2; ++i) { const int L = t + 512 * i; __builtin_amdgcn_global_load_lds((const unsigned*)(delta + (size_t)(u.pm * BM + (L >> 2)) * DM + u.pn * BM + (L & 3) * 64), dummy, 4, 0, 0); }
    }
    const float* xp; const float* xs; const bf16_t* delta; float* out; int second = 0;
    __device__ __forceinline__ void operator()(f32x4 (&acc)[2][2][4][2], const Unit& u, int wr, int wc, int fr, int fq) const {
        asm volatile("" : "+v"(fr), "+v"(fq));
        const int row0 = u.pm * BM + wr * 64 + fr, col0 = u.pn * BM + wc * 32 + 8 * fq;
        const float* xb = (u.pm * BM < M_PROMPT) ? xp : (xs - (size_t)M_PROMPT * DM);
        u32x4 dv[2][4][2];
#pragma unroll
        for (int ai = 0; ai < 2; ++ai)
#pragma unroll
            for (int m = 0; m < 4; ++m)
#pragma unroll
                for (int bj = 0; bj < 2; ++bj) dv[ai][m][bj] = *(const u32x4*)(delta + (size_t)(row0 + ai * HALF + m * 16) * DM + col0 + bj * HALF);
        __builtin_amdgcn_sched_barrier(0);
#pragma unroll
        for (int ai = 0; ai < 2; ++ai)
#pragma unroll
            for (int m = 0; m < 4; ++m)
#pragma unroll
                for (int bj = 0; bj < 2; ++bj) { const size_t ro = (size_t)(row0 + ai * HALF + m * 16) * DM + col0 + bj * HALF;
                    const u32x4 d = dv[ai][m][bj]; f32x4 d0, d1;
                    d0[0] = __uint_as_float(d.x << 16); d0[1] = __uint_as_float(d.x & 0xffff0000u); d0[2] = __uint_as_float(d.y << 16); d0[3] = __uint_as_float(d.y & 0xffff0000u);
                    d1[0] = __uint_as_float(d.z << 16); d1[1] = __uint_as_float(d.z & 0xffff0000u); d1[2] = __uint_as_float(d.w << 16); d1[3] = __uint_as_float(d.w & 0xffff0000u);
                    *(f32x4*)(out + ro) = d0 + acc[ai][bj][m][0];
                    *(f32x4*)(out + ro + 4) = d1 + acc[ai][bj][m][1];
                }
    }
};
template <class Epi, class Sched, bool ALIGN_EPI = false, bool SP2 = false>
__device__ __forceinline__ void gemm_phase(PG8_LAS unsigned char* lds, const Gemm g, const Sched& S, const Epi& E) {
    const int tid = threadIdx.x, wid = __builtin_amdgcn_readfirstlane(tid >> 6), lane = tid & 63, wr = wid >> 2, wc = wid & 3, fr = lane & 15, fq = lane >> 4;
    const int K = g.K, nt = K / BK;
    unsigned voffA[2], voffB[2];
#pragma unroll
    for (int i = 0; i < 2; ++i) { int R, C; stage_rc(tid * 16 + i * 8192, R, C); const int Rb = Epi::PERM ? ((R & ~31) + perm32(R & 31)) : R;
        voffA[i] = (unsigned)(R * K + C) * 2u; voffB[i] = (unsigned)(Rb * K + C) * 2u; }
    const size_t kstep = (size_t)(BK * 2);
    const size_t hstep = (size_t)HALF * K * 2;
    const size_t tstep = 2 * hstep;
    const unsigned ldsw = (unsigned)wid * 1024u;
    const int aoff = lds_byte(wr * 64 + fr, fq * 8), boff = lds_byte(wc * 32 + fr, fq * 8);
#define PG8_SA(b, h) (((b) * 2 + (h)) * HTB)
#define PG8_SB(b, h) ((4 + (b) * 2 + (h)) * HTB)
#define PG8_STAGE(bufoff, gbase, voff) do { _Pragma("unroll") for (int _i = 0; _i < 2; ++_i) \
        __builtin_amdgcn_global_load_lds((const unsigned*)((const char*)(gbase) + (voff)[_i]), (PG8_LAS unsigned*)(lds + (bufoff) + ldsw + _i * 8192), 16, 0, 0); } while (0)
#define PG8_LDA(dst, b, h) do { _Pragma("unroll") for (int m = 0; m < 4; ++m) _Pragma("unroll") for (int k = 0; k < 2; ++k) dst[m][k] = *(const PG8_LAS bf16x8*)(lds + PG8_SA(b, h) + aoff + m * 2048 + k * 1024); } while (0)
#define PG8_LDB(dst, b, h) do { _Pragma("unroll") for (int n = 0; n < 2; ++n) _Pragma("unroll") for (int k = 0; k < 2; ++k) dst[n][k] = *(const PG8_LAS bf16x8*)(lds + PG8_SB(b, h) + boff + n * 2048 + k * 1024); } while (0)
#define PG8_MMA(ai, bj, At, Bt) do { __builtin_amdgcn_s_setprio(1); _Pragma("unroll") for (int m = 0; m < 4; ++m) _Pragma("unroll") for (int n = 0; n < 2; ++n) _Pragma("unroll") for (int k = 0; k < 2; ++k) \
        acc[ai][bj][m][n] = __builtin_amdgcn_mfma_f32_16x16x32_bf16(Bt[n][k], At[m][k], acc[ai][bj][m][n], 0, 0, 0); __builtin_amdgcn_s_setprio(0); } while (0)
#define PG8_WAIT_V(n) asm volatile("s_waitcnt vmcnt(" #n ")" ::: "memory")
#define PG8_WAIT_L(n) asm volatile("s_waitcnt lgkmcnt(" #n ")" ::: "memory")
#define PG8_BAR __builtin_amdgcn_s_barrier()
#define PG8_SCHED __builtin_amdgcn_sched_barrier(0)
    Unit cur, nxt; int ui = 0;
    typename Epi::Pre pre;
    if (!S.next(0, cur)) return;
    f32x4 acc[2][2][4][2];
#pragma unroll
    for (int a = 0; a < 2; ++a)
#pragma unroll
        for (int b = 0; b < 2; ++b)
#pragma unroll
            for (int m = 0; m < 4; ++m)
#pragma unroll
                for (int n = 0; n < 2; ++n) acc[a][b][m][n] = (f32x4){0.f, 0.f, 0.f, 0.f};
    bf16x8 At[4][2], B0[2][2], B1[2][2];
    const char* cA = (const char*)g.A + (size_t)cur.pm * tstep; const char* cB = (const char*)g.Bt + (size_t)cur.pn * tstep;
    S.a_ready(cur);
    if constexpr (Epi::PREFETCH) E.prefetch(cur, lds);
    if constexpr (SP2) {
        PG8_STAGE(PG8_SB(0, 0), cB, voffB); PG8_STAGE(PG8_SB(0, 1), cB + hstep, voffB); PG8_STAGE(PG8_SA(0, 0), cA, voffA); PG8_STAGE(PG8_SA(0, 1), cA + hstep, voffA);
        if (wr == 1) PG8_BAR;
        PG8_WAIT_V(2); PG8_BAR;
        PG8_STAGE(PG8_SB(1, 0), cB + kstep, voffB); PG8_STAGE(PG8_SA(1, 0), cA + kstep, voffA); PG8_STAGE(PG8_SB(1, 1), cB + hstep + kstep, voffB);
        PG8_WAIT_V(6); PG8_BAR;
    } else {
        PG8_STAGE(PG8_SB(0, 0), cB, voffB); PG8_STAGE(PG8_SA(0, 0), cA, voffA); PG8_STAGE(PG8_SB(0, 1), cB + hstep, voffB); PG8_STAGE(PG8_SA(0, 1), cA + hstep, voffA);
        if (wr == 1) PG8_BAR;
        PG8_WAIT_V(4); PG8_BAR;
        PG8_STAGE(PG8_SB(1, 0), cB + kstep, voffB); PG8_STAGE(PG8_SA(1, 0), cA + kstep, voffA); PG8_STAGE(PG8_SB(1, 1), cB + hstep + kstep, voffB);
        PG8_WAIT_V(6); PG8_BAR;
    }
    for (;;) {
        const bool has_next = S.next(ui + 1, nxt);
        const char* nA = has_next ? (const char*)g.A + (size_t)nxt.pm * tstep : cA; const char* nB = has_next ? (const char*)g.Bt + (size_t)nxt.pn * tstep : cB;
        for (int t = 0; t < nt; t += 2) {
            const bool last = (t == nt - 2);
            const char* a1 = cA + (size_t)(t + 1) * kstep;
            const char* a2 = last ? nA : cA + (size_t)(t + 2) * kstep; const char* b2 = last ? nB : cB + (size_t)(t + 2) * kstep;
            const char* a3 = a2 + kstep; const char* b3 = b2 + kstep;
            if (last && has_next) S.a_ready(nxt);
            if constexpr (Epi::PRELOAD) { if (last) E.preload(cur, wr, wc, lane, pre); }
            if constexpr (SP2) {
            PG8_LDB(B0, 0, 0); PG8_LDB(B1, 0, 1); PG8_SCHED; PG8_LDA(At, 0, 0); PG8_STAGE(PG8_SA(1, 1), a1 + hstep, voffA);
            PG8_WAIT_V(8); PG8_WAIT_L(0); PG8_BAR; PG8_MMA(0, 0, At, B0); PG8_MMA(0, 1, At, B1); PG8_BAR; PG8_SCHED;
            PG8_LDA(At, 0, 1); PG8_STAGE(PG8_SB(0, 0), b2, voffB); PG8_STAGE(PG8_SB(0, 1), b2 + hstep, voffB); PG8_STAGE(PG8_SA(0, 0), a2, voffA);
            PG8_WAIT_V(8); PG8_WAIT_L(0); PG8_BAR; PG8_MMA(1, 0, At, B0); PG8_MMA(1, 1, At, B1); PG8_BAR; PG8_SCHED;
            PG8_LDB(B0, 1, 0); PG8_LDB(B1, 1, 1); PG8_SCHED; PG8_LDA(At, 1, 0); PG8_STAGE(PG8_SA(0, 1), a2 + hstep, voffA);
            PG8_WAIT_V(8); PG8_WAIT_L(0); PG8_BAR; PG8_MMA(0, 0, At, B0); PG8_MMA(0, 1, At, B1); PG8_BAR; PG8_SCHED;
            PG8_LDA(At, 1, 1); PG8_STAGE(PG8_SB(1, 0), b3, voffB); PG8_STAGE(PG8_SB(1, 1), b3 + hstep, voffB); PG8_STAGE(PG8_SA(1, 0), a3, voffA);
            PG8_WAIT_V(8); PG8_WAIT_L(0); PG8_BAR; PG8_MMA(1, 0, At, B0); PG8_MMA(1, 1, At, B1); PG8_BAR; PG8_SCHED;
            } else {
            PG8_LDB(B0, 0, 0); PG8_SCHED; PG8_LDA(At, 0, 0); PG8_STAGE(PG8_SA(1, 1), a1 + hstep, voffA);
            PG8_WAIT_L(8); PG8_BAR; PG8_WAIT_L(0); PG8_MMA(0, 0, At, B0); PG8_BAR; PG8_SCHED;
            PG8_LDB(B1, 0, 1); PG8_STAGE(PG8_SB(0, 0), b2, voffB);
            PG8_BAR; PG8_WAIT_L(0); PG8_MMA(0, 1, At, B1); PG8_BAR;
            PG8_LDA(At, 0, 1); PG8_STAGE(PG8_SA(0, 0), a2, voffA);
            PG8_BAR; PG8_WAIT_L(0); PG8_MMA(1, 0, At, B0); PG8_BAR; PG8_SCHED;
            PG8_STAGE(PG8_SB(0, 1), b2 + hstep, voffB);
            PG8_WAIT_V(6); PG8_BAR; PG8_MMA(1, 1, At, B1); PG8_BAR;
            PG8_LDB(B0, 1, 0); PG8_SCHED; PG8_LDA(At, 1, 0); PG8_STAGE(PG8_SA(0, 1), a2 + hstep, voffA);
            PG8_WAIT_L(8); PG8_BAR; PG8_WAIT_L(0); PG8_MMA(0, 0, At, B0); PG8_BAR; PG8_SCHED;
            PG8_LDB(B1, 1, 1); PG8_STAGE(PG8_SB(1, 0), b3, voffB);
            PG8_BAR; PG8_WAIT_L(0); PG8_MMA(0, 1, At, B1); PG8_BAR;
            PG8_LDA(At, 1, 1); PG8_STAGE(PG8_SA(1, 0), a3, voffA);
            PG8_BAR; PG8_WAIT_L(0); PG8_MMA(1, 0, At, B0); PG8_BAR; PG8_SCHED;
            PG8_STAGE(PG8_SB(1, 1), b3 + hstep, voffB);
            PG8_WAIT_V(6); PG8_BAR; PG8_MMA(1, 1, At, B1); PG8_BAR;
            }
        }
        if constexpr (ALIGN_EPI) { if (wr == 0) PG8_BAR; }
        if constexpr (!Epi::AFTER_DRAIN) { if constexpr (Epi::PRELOAD) E(acc, cur, wr, wc, fr, fq, pre); else E(acc, cur, wr, wc, fr, fq); S.done(cur); }
#ifdef EPI2X
        if constexpr (Epi::TWICE) { Epi E2 = E; E2.second = 1; E2(acc, cur, wr, wc, fr, fq); }
#endif
        if (!has_next) break;
#pragma unroll
        for (int a = 0; a < 2; ++a)
#pragma unroll
            for (int b = 0; b < 2; ++b)
#pragma unroll
                for (int m = 0; m < 4; ++m)
#pragma unroll
                    for (int n = 0; n < 2; ++n) acc[a][b][m][n] = (f32x4){0.f, 0.f, 0.f, 0.f};
        cur = nxt; cA = nA; cB = nB; ++ui;
        if constexpr (Epi::PREFETCH) E.prefetch(cur, lds);
        if constexpr (ALIGN_EPI) { if (wr == 1) PG8_BAR; }
    }
    PG8_WAIT_V(0);
    if constexpr (!ALIGN_EPI) { if (wr == 0) PG8_BAR; }
    PG8_BAR;
    if constexpr (Epi::AFTER_DRAIN) { E.fused(acc, cur, wr, wc, fr, fq, lds, wid, lane); S.done(cur); }
#undef PG8_SA
#undef PG8_SB
#undef PG8_STAGE
#undef PG8_LDA
#undef PG8_LDB
#undef PG8_MMA
#undef PG8_WAIT_V
#undef PG8_WAIT_L
#undef PG8_BAR
#undef PG8_SCHED
}
}
#define LAS __attribute__((address_space(3)))
typedef unsigned short bf16;
typedef unsigned v4u __attribute__((ext_vector_type(4)));
typedef unsigned v2u __attribute__((ext_vector_type(2)));
typedef float f32x4 __attribute__((ext_vector_type(4)));
typedef float f32x16 __attribute__((ext_vector_type(16)));
typedef short bf16x8 __attribute__((ext_vector_type(8)));
typedef short s16x4 __attribute__((ext_vector_type(4)));
using pg8::cvt_pk_bf16; using pg8::M_TOK; using pg8::DM; using pg8::M_PROMPT; using pg8::DFF; using pg8::LOG2E; using pg8::seq_bounds; using pg8::fast_silu; using pg8::fast_sigmoid;
constexpr int NWAVES = 8, NTHR = 512;
constexpr int LDS_BYTES = 147456;
constexpr size_t MiB = 1u << 20;
constexpr size_t WS_WIN = 0, WS_WO = 4 * MiB, WS_WD = 6 * MiB, WS_SSQ = 12 * MiB, WS_BAR = 12 * MiB + 512 * 1024, BAR_BYTES = 16384;
constexpr size_t WS_H = 16 * MiB;
constexpr size_t WS_Q = 80 * MiB, WS_K = 112 * MiB, WS_VT = 120 * MiB, WS_U = 128 * MiB;
constexpr size_t WS_ACT = 16 * MiB;
constexpr size_t WS_DELTA = 192 * MiB, WS_END = 256 * MiB;
constexpr size_t DO_X1B = 0, DO_WGU = 64 * MiB, DO_GE = 76 * MiB, DO_UE = 99 * MiB;

__device__ __forceinline__ float wave_sum(float v) {
#pragma unroll
    for (int o = 1; o < 64; o <<= 1) v += __shfl_xor(v, o);
    return v;
}
__device__ __forceinline__ float wave_max(float v) {
#pragma unroll
    for (int o = 1; o < 64; o <<= 1) v = fmaxf(v, __shfl_xor(v, o));
    return v;
}
__device__ __forceinline__ void transpose_item(const float* W, int N, int k0, int n0, bf16* dst, int dpitch, const float* kscale, LAS float* scr, int lane) {
    float wv[32];
#pragma unroll
    for (int i = 0; i < 32; ++i) { const int kk = 2 * i + (lane >> 5); wv[i] = W[(size_t)(k0 + kk) * N + n0 + (lane & 31)]; }
    if (kscale) {
        float ks[32];
#pragma unroll
        for (int i = 0; i < 32; ++i) ks[i] = kscale[k0 + 2 * i + (lane >> 5)];
#pragma unroll
        for (int i = 0; i < 32; ++i) wv[i] *= ks[i];
    }
#pragma unroll
    for (int i = 0; i < 32; ++i) { const int kk = 2 * i + (lane >> 5); scr[kk * 33 + (lane & 31)] = wv[i]; }
    asm volatile("s_waitcnt lgkmcnt(0)" ::: "memory");
    const int c = lane & 7;
#pragma unroll
    for (int j = 0; j < 4; ++j) { const int n = (lane >> 3) + 8 * j; const LAS float* s = scr + (8 * c) * 33 + n;
        v4u o; o.x = cvt_pk_bf16(s[0 * 33], s[1 * 33]); o.y = cvt_pk_bf16(s[2 * 33], s[3 * 33]); o.z = cvt_pk_bf16(s[4 * 33], s[5 * 33]); o.w = cvt_pk_bf16(s[6 * 33], s[7 * 33]);
        *(v4u*)(dst + (size_t)n * dpitch + 8 * c) = o; }
    asm volatile("s_waitcnt lgkmcnt(0)" ::: "memory");
}

struct Args {
    const float *xp, *xs, *norm1_g, *w_in, *q_norm_g, *k_norm_g, *attn_sink, *conv_dw_w, *conv_dw_b, *conv_ln_g, *conv_ln_b, *w_out, *norm2_g, *w_gate, *w_up, *ffn_dw_w, *ffn_dw_b, *w_down;
    float* out; unsigned char* ws; int ph_lo, ph_hi;
};

__device__ __forceinline__ void phase0(const Args& A, LAS unsigned char* lds, int gw, int NGW, int wave, int lane, int part) {
    unsigned char* ws = A.ws;
    LAS float* scr = (LAS float*)(lds + wave * 16384);
    constexpr int I_IN = 16 * 56, I_O = 16 * 32, I_G = 16 * 88, I_D = 44 * 32;
    constexpr int NITEMS = I_IN + I_O + 2 * I_G + I_D;
    const int it_lo = part ? I_IN : 0, it_hi = part ? NITEMS : I_IN;
    for (int it = it_lo + gw; it < it_hi; it += NGW) {
        int r = it;
        if (r < I_IN) {
            const int kb = r / 56, nb = r % 56, n0 = 32 * nb; int drow;
            if (n0 < 768) { const int pn = n0 >> 8, wc = (n0 >> 6) & 3, bj = (n0 >> 5) & 1; drow = 256 * pn + 128 * bj + 32 * wc; }
            else if (n0 < 1280) { const int ch = n0 - 768; drow = 256 * (3 + (ch >> 7)) + (ch & 127); }
            else { const int ch = n0 - 1280; drow = 256 * (3 + (ch >> 7)) + 128 + (ch & 127); }
            transpose_item(A.w_in, 1792, 64 * kb, n0, (bf16*)(ws + WS_WIN) + (size_t)drow * 1024 + 64 * kb, 1024, nullptr, scr, lane); continue; }
        r -= I_IN;
        if (r < I_O) { const int kb = r / 32, nb = r % 32; transpose_item(A.w_out, 1024, 64 * kb, 32 * nb, (bf16*)(ws + WS_WO) + (size_t)(32 * nb) * 1024 + 64 * kb, 1024, nullptr, scr, lane); continue; }
        r -= I_O;
        if (r < 2 * I_G) { const int up = r >= I_G; if (up) r -= I_G; const int kb = r / 88, nb = r % 88, ch = 32 * nb; const int drow = 256 * (ch >> 7) + 128 * up + (ch & 127);
            transpose_item(up ? A.w_up : A.w_gate, DFF, 64 * kb, ch, (bf16*)((unsigned char*)A.out + DO_WGU) + (size_t)drow * 1024 + 64 * kb, 1024, A.norm2_g, scr, lane); continue; }
        r -= 2 * I_G;
        { const int kb = r / 32, nb = r % 32, k0 = 64 * kb;
          transpose_item(A.w_down, 1024, k0, 32 * nb, (bf16*)(ws + WS_WD) + (size_t)(32 * nb) * DFF + k0, DFF, nullptr, scr, lane); }
    }
    if (part) return;
    f32x4 g[4];
#pragma unroll
    for (int j = 0; j < 4; ++j) g[j] = ((const f32x4*)A.norm1_g)[lane + 64 * j];
    bf16* H = (bf16*)(ws + WS_H);
    for (int m = gw; m < M_TOK; m += NGW) {
        const float* xrow = (m < M_PROMPT) ? A.xp + (size_t)m * DM : A.xs + (size_t)(m - M_PROMPT) * DM;
        f32x4 v[4]; float s = 0.f;
#pragma unroll
        for (int j = 0; j < 4; ++j) { v[j] = ((const f32x4*)xrow)[lane + 64 * j]; s += (v[j][0] * v[j][0] + v[j][1] * v[j][1]) + (v[j][2] * v[j][2] + v[j][3] * v[j][3]); }
        const float rs = __builtin_amdgcn_rsqf(wave_sum(s) * (1.0f / DM) + 1e-6f);
        uint2* o8 = (uint2*)(H + (size_t)m * DM) + lane;
#pragma unroll
        for (int j = 0; j < 4; ++j) { const f32x4 y = v[j] * rs * g[j]; uint2 w; w.x = cvt_pk_bf16(y[0], y[1]); w.y = cvt_pk_bf16(y[2], y[3]); o8[64 * j] = w; }
    }
}

constexpr int KP = 144, VP = 776;
constexpr int LDS_KOFF = 0, LDS_VOFF = 384 * KP;
__device__ __forceinline__ void attn_item(const Args& A, LAS unsigned char* lds, int item, int tid, int wave, int lane, float bound) {
    const bf16* Q = (const bf16*)(A.ws + WS_Q); const bf16* Kg = (const bf16*)(A.ws + WS_K); const bf16* VT = (const bf16*)(A.ws + WS_VT); bf16* MIX = (bf16*)(A.ws + WS_H);
    const int blk = item >> 1, kvh = item & 1, q0 = blk * 128, band0 = q0 - 128;
    int s0, s1; seq_bounds(q0, s0, s1);
    const int vlo = (q0 == s0) ? 128 : 0, vhi = (q0 + 128 == s1) ? 256 : 384;
    const int hl = wave >> 1, head = kvh * 4 + hl, r = lane & 31, h = lane >> 5;
    const float sink = A.attn_sink[head];
    bf16x8 qf0[4];
    { const bf16* qrow = Q + (size_t)(band0 + 128 + 64 * (wave & 1) + r) * 512 + head * 64 + 8 * h;
#pragma unroll
      for (int kk = 0; kk < 4; ++kk) qf0[kk] = *(const bf16x8*)(qrow + 16 * kk); }
    {
        v4u kreg[6], vreg[6];
#pragma unroll
        for (int q = 0; q < 6; ++q) { const int c = tid + NTHR * q, i = c >> 3, part = c & 7, ic = min(max(i, vlo), vhi - 1);
            kreg[q] = *(const v4u*)(Kg + (size_t)(band0 + ic) * 128 + kvh * 64 + part * 8); }
#pragma unroll
        for (int q = 0; q < 6; ++q) { const int c = tid + NTHR * q, d = c / 48, part = c % 48, ic = min(max(part * 8, vlo), vhi - 8);
            vreg[q] = *(const v4u*)(VT + (size_t)(kvh * 64 + d) * M_TOK + band0 + ic); }
#pragma unroll
        for (int q = 0; q < 6; ++q) { const int c = tid + NTHR * q, i = c >> 3, part = c & 7; *(LAS v4u*)(lds + LDS_KOFF + i * KP + part * 16) = kreg[q]; }
#pragma unroll
        for (int q = 0; q < 6; ++q) { const int c = tid + NTHR * q, d = c / 48, part = c % 48;
            LAS v2u* p = (LAS v2u*)(lds + LDS_VOFF + d * VP + part * 16); p[0] = (v2u){vreg[q].x, vreg[q].y}; p[1] = (v2u){vreg[q].z, vreg[q].w}; }
    }
    __syncthreads();
    const float slope2 = LOG2E * __builtin_amdgcn_exp2f(-(float)(head + 1));
    const float m2 = LOG2E * fmaxf(bound, sink), sinkterm = __builtin_amdgcn_exp2f(LOG2E * sink - m2);
#pragma unroll 1
    for (int qs = 0; qs < 2; ++qs) {
        const int qt = 128 + 64 * (wave & 1) + 32 * qs;
        const bf16* qrow = Q + (size_t)(band0 + qt + r) * 512 + head * 64 + 8 * h;
        bf16x8 qf[4];
        if (qs == 0) {
#pragma unroll
            for (int kk = 0; kk < 4; ++kk) qf[kk] = qf0[kk];
        } else {
#pragma unroll
            for (int kk = 0; kk < 4; ++kk) qf[kk] = *(const bf16x8*)(qrow + 16 * kk);
        }
        f32x16 O0, O1, OS, NEG;
#pragma unroll
        for (int i = 0; i < 16; ++i) { O0[i] = 0.f; O1[i] = 0.f; OS[i] = 0.f; NEG[i] = -m2; }
        const bf16x8 ones = {(short)0x3f80, (short)0x3f80, (short)0x3f80, (short)0x3f80, (short)0x3f80, (short)0x3f80, (short)0x3f80, (short)0x3f80};
        const int kb_lo = max(qt - 128, vlo), kb_hi = min(qt + 160, vhi);
        bf16x8 kf[4];
        { const LAS unsigned char* kp = lds + LDS_KOFF + (kb_lo + r) * KP + h * 16;
#pragma unroll
          for (int kk = 0; kk < 4; ++kk) kf[kk] = *(const LAS bf16x8*)(kp + kk * 32); }
#pragma unroll 1
        for (int kb = kb_lo; kb < kb_hi; kb += 32) {
            const int kbn = (kb + 32 < kb_hi) ? kb + 32 : kb;
            const LAS unsigned char* vp = lds + LDS_VOFF + r * VP + (kb + 4 * h) * 2;
            const LAS unsigned char* kpn = lds + LDS_KOFF + (kbn + r) * KP + h * 16;
            s16x4 vlo_[2][2], vhi_[2][2]; bf16x8 kfn[4];
#pragma unroll
            for (int s = 0; s < 2; ++s)
#pragma unroll
                for (int db = 0; db < 2; ++db) { vlo_[s][db] = *(const LAS s16x4*)(vp + 32 * s + 32 * VP * db); vhi_[s][db] = *(const LAS s16x4*)(vp + 32 * s + 32 * VP * db + 16); }
#pragma unroll
            for (int kk = 0; kk < 4; ++kk) kfn[kk] = *(const LAS bf16x8*)(kpn + kk * 32);
            __builtin_amdgcn_sched_barrier(0);
            f32x16 S;
#pragma unroll
            for (int kk = 0; kk < 4; ++kk) S = __builtin_amdgcn_mfma_f32_32x32x16_bf16(kf[kk], qf[kk], kk ? S : NEG, 0, 0, 0);
            const float dbase = (float)(qt + r - kb - 4 * h);
            float p[16];
            if (kb == qt - 128 || kb == qt + 128) {
#pragma unroll
                for (int i = 0; i < 16; ++i) {
                    const float d = dbase - (float)((i & 3) + 8 * (i >> 2));
                    const float e = __builtin_amdgcn_exp2f(S[i] - slope2 * fabsf(d));
                    p[i] = (fabsf(d) <= 128.0f) ? e : 0.f;
                }
            } else {
#pragma unroll
                for (int i = 0; i < 16; ++i) {
                    const float d = dbase - (float)((i & 3) + 8 * (i >> 2));
                    p[i] = __builtin_amdgcn_exp2f(S[i] - slope2 * fabsf(d));
                }
            }
#pragma unroll
            for (int s = 0; s < 2; ++s) {
                v4u pk; pk.x = cvt_pk_bf16(p[8 * s], p[8 * s + 1]); pk.y = cvt_pk_bf16(p[8 * s + 2], p[8 * s + 3]); pk.z = cvt_pk_bf16(p[8 * s + 4], p[8 * s + 5]); pk.w = cvt_pk_bf16(p[8 * s + 6], p[8 * s + 7]);
                const bf16x8 ps = __builtin_bit_cast(bf16x8, pk);
                OS = __builtin_amdgcn_mfma_f32_32x32x16_bf16(ones, ps, OS, 0, 0, 0);
                O0 = __builtin_amdgcn_mfma_f32_32x32x16_bf16(__builtin_shufflevector(vlo_[s][0], vhi_[s][0], 0, 1, 2, 3, 4, 5, 6, 7), ps, O0, 0, 0, 0);
                O1 = __builtin_amdgcn_mfma_f32_32x32x16_bf16(__builtin_shufflevector(vlo_[s][1], vhi_[s][1], 0, 1, 2, 3, 4, 5, 6, 7), ps, O1, 0, 0, 0);
            }
#pragma unroll
            for (int kk = 0; kk < 4; ++kk) kf[kk] = kfn[kk];
        }
        const float l = OS[0];
        const float inv = 1.0f / (l + sinkterm);
        bf16* orow = MIX + (size_t)(band0 + qt + r) * DM + head * 64 + 4 * h;
#pragma unroll
        for (int g = 0; g < 4; ++g) {
            uint2 w; w.x = cvt_pk_bf16(O0[4 * g] * inv, O0[4 * g + 1] * inv); w.y = cvt_pk_bf16(O0[4 * g + 2] * inv, O0[4 * g + 3] * inv); *(uint2*)(orow + 8 * g) = w;
            uint2 x; x.x = cvt_pk_bf16(O1[4 * g] * inv, O1[4 * g + 1] * inv); x.y = cvt_pk_bf16(O1[4 * g + 2] * inv, O1[4 * g + 3] * inv); *(uint2*)(orow + 32 + 8 * g) = x;
        }
    }
    __syncthreads();
}

constexpr int LDS_ST = 96 * 1024;
typedef float f32x2 __attribute__((ext_vector_type(2)));
__device__ __forceinline__ void conv_item(const Args& A, LAS unsigned char* lds, int item, int tid, int wave, int lane, const f32x2 (&w)[31], f32x2 bias, f32x2 lg, f32x2 lb) {
    const bf16* U = (const bf16*)(A.ws + WS_U); bf16* MIX = (bf16*)(A.ws + WS_H);
    const int t0 = item * 64; int s0, s1; seq_bounds(t0, s0, s1);
    for (int i = wave; i < 94; i += NWAVES) {
        const int tok = t0 - 15 + i;
        if (tok >= s0 && tok < s1) __builtin_amdgcn_global_load_lds((const unsigned*)(U + (size_t)tok * 512 + lane * 8), (LAS unsigned*)(lds + i * 1024), 16, 0, 0);
        else *(LAS v4u*)(lds + i * 1024 + lane * 16) = (v4u){0u, 0u, 0u, 0u};
    }
    const int cp = tid & 255, tgb = tid >> 8;
    asm volatile("s_waitcnt vmcnt(0)" ::: "memory");
    __syncthreads();
    LAS float* ST = (LAS float*)(lds + LDS_ST);
#pragma unroll 1
    for (int it = 0; it < 4; ++it) {
        const int tg = tgb + 2 * it;
        f32x2 res[8];
#pragma unroll
        for (int t = 0; t < 8; ++t) res[t] = bias;
        const LAS unsigned* xp = (const LAS unsigned*)(lds + (8 * tg) * 1024 + cp * 4);
        unsigned xr[2][8];
#pragma unroll
        for (int q = 0; q < 8; ++q) xr[0][q] = xp[q * 256];
#pragma unroll
        for (int c8 = 0; c8 < 5; ++c8) {
            if (c8 < 4) {
#pragma unroll
                for (int q = 0; q < 8; ++q) { const int ii = 8 * (c8 + 1) + q; if (ii < 38) xr[(c8 + 1) & 1][q] = xp[ii * 256]; }
            }
            __builtin_amdgcn_sched_barrier(0);
#pragma unroll
            for (int q = 0; q < 8; ++q) { const int ii = 8 * c8 + q; if (ii < 38) {
                const unsigned xv = xr[c8 & 1][q];
                const f32x2 x2 = {__uint_as_float(xv << 16), __uint_as_float(xv & 0xffff0000u)};
#pragma unroll
                for (int t = 0; t < 8; ++t) { const int j = ii - t; if (j >= 0 && j <= 30) res[t] += w[j] * x2; } } }
            __builtin_amdgcn_sched_barrier(0);
        }
        float v[16];
#pragma unroll
        for (int t = 0; t < 8; ++t) { v[2 * t] = res[t].x + res[t].y; v[2 * t + 1] = res[t].x * res[t].x + res[t].y * res[t].y; }
#pragma unroll
        for (int i = 0; i < 8; ++i) { const bool up = lane & 32; const float send = up ? v[i] : v[i + 8], keep = up ? v[i + 8] : v[i]; v[i] = keep + __shfl_xor(send, 32); }
#pragma unroll
        for (int i = 0; i < 4; ++i) { const bool up = lane & 16; const float send = up ? v[i] : v[i + 4], keep = up ? v[i + 4] : v[i]; v[i] = keep + __shfl_xor(send, 16); }
#pragma unroll
        for (int i = 0; i < 2; ++i) { const bool up = lane & 8; const float send = up ? v[i] : v[i + 2], keep = up ? v[i + 2] : v[i]; v[i] = keep + __shfl_xor(send, 8); }
        { const bool up = lane & 4; const float send = up ? v[0] : v[1], keep = up ? v[1] : v[0]; v[0] = keep + __shfl_xor(send, 4); }
        v[0] += __shfl_xor(v[0], 2); v[0] += __shfl_xor(v[0], 1);
        if ((lane & 3) == 0) { const int idx = ((lane >> 5) & 1) * 8 + ((lane >> 4) & 1) * 4 + ((lane >> 3) & 1) * 2 + ((lane >> 2) & 1);
            ST[((8 * tg + (idx >> 1)) * 4 + (wave & 3)) * 2 + (idx & 1)] = v[0]; }
        __syncthreads();
#pragma unroll
        for (int t = 0; t < 8; ++t) {
            const LAS f32x4* sp = (const LAS f32x4*)(ST + (8 * tg + t) * 8); const f32x4 a = sp[0], b = sp[1];
            const float mean = ((a[0] + a[2]) + (b[0] + b[2])) * (1.0f / 512.0f), ex2 = ((a[1] + a[3]) + (b[1] + b[3])) * (1.0f / 512.0f);
            const float rstd = __builtin_amdgcn_rsqf(fmaxf(ex2 - mean * mean, 0.f) + 1e-5f);
            const f32x2 y = (res[t] - mean) * rstd * lg + lb;
            *(unsigned*)(MIX + (size_t)(t0 + 8 * tg + t) * DM + 512 + 2 * cp) = cvt_pk_bf16(fast_silu(y.x), fast_silu(y.y));
        }
    }
    __syncthreads();
}

__device__ __forceinline__ void fix_edges(const Args& A, int gtid, int gthreads) {
    constexpr int ncols = DFF;
    const float* __restrict__ ge = (const float*)((unsigned char*)A.out + DO_GE); const float* __restrict__ ue = (const float*)((unsigned char*)A.out + DO_UE); bf16* __restrict__ act = (bf16*)(A.ws + WS_ACT);
    const int ng = ncols >> 2, total = 128 * 2 * ng;
    constexpr int NB_ = 2;
    for (int idx0 = gtid; idx0 < total; idx0 += NB_ * gthreads) {
        f32x4 pv[NB_], cur[NB_], nx[NB_], up[NB_], w0[NB_], w1[NB_], w2[NB_], bb[NB_]; int row[NB_], col[NB_]; bool ok[NB_];
        const f32x4 zero = {0.f, 0.f, 0.f, 0.f};
#pragma unroll
        for (int q = 0; q < NB_; ++q) {
            const int idx = idx0 + q * gthreads; ok[q] = idx < total; const int id = ok[q] ? idx : gtid;
            const int cg4 = id % ng, rw = id / ng, which = rw & 1, chunk = rw >> 1; col[q] = 4 * cg4;
            row[q] = 256 * chunk + (which ? 255 : 0); int s0, s1; seq_bounds(row[q], s0, s1);
            const float* gc = ge + (size_t)chunk * 4 * ncols + col[q];
            if (which == 0) { pv[q] = (row[q] == s0) ? zero : *(const f32x4*)(gc - ncols); cur[q] = *(const f32x4*)(gc); nx[q] = *(const f32x4*)(gc + ncols); up[q] = *(const f32x4*)(ue + ((size_t)chunk * 2) * ncols + col[q]); }
            else { pv[q] = *(const f32x4*)(gc + 2 * ncols); cur[q] = *(const f32x4*)(gc + 3 * ncols); nx[q] = (row[q] + 1 == s1) ? zero : *(const f32x4*)(gc + 4 * ncols); up[q] = *(const f32x4*)(ue + ((size_t)chunk * 2 + 1) * ncols + col[q]); }
            w0[q] = *(const f32x4*)(A.ffn_dw_w + col[q]); w1[q] = *(const f32x4*)(A.ffn_dw_w + DFF + col[q]); w2[q] = *(const f32x4*)(A.ffn_dw_w + 2 * DFF + col[q]); bb[q] = *(const f32x4*)(A.ffn_dw_b + col[q]);
        }
#pragma unroll
        for (int q = 0; q < NB_; ++q) {
            float o[4];
#pragma unroll
            for (int j = 0; j < 4; ++j) { const float cv = bb[q][j] + w0[q][j] * pv[q][j] + w1[q][j] * cur[q][j] + w2[q][j] * nx[q][j]; o[j] = fast_silu(cv) * up[q][j]; }
            uint2 w; w.x = cvt_pk_bf16(o[0], o[1]); w.y = cvt_pk_bf16(o[2], o[3]);
            if (ok[q]) *(uint2*)(act + (size_t)row[q] * ncols + col[q]) = w;
        }
    }
}

#define XB_TMO      128
#define XB_XCNT(j)  (256  + 64 * (j))
#define XB_XSUB(j)  (1280 + 64 * (j))
#define XB_XGEN(j)  (2304 + 64 * (j))
#define XB_TOP      3328
#define XB_TOPGEN   3392
#define XCD_BAR_WORDS 3456
#define XB_SPIN_CAP (1u << 18)

__device__ __forceinline__ unsigned xb_ld(unsigned* p)              { return __hip_atomic_load(p, __ATOMIC_RELAXED, __HIP_MEMORY_SCOPE_AGENT); }
__device__ __forceinline__ unsigned xb_add(unsigned* p, unsigned v) { return __hip_atomic_fetch_add(p, v, __ATOMIC_RELAXED, __HIP_MEMORY_SCOPE_AGENT); }
__device__ __forceinline__ unsigned xb_xcc_id() { return (unsigned)__builtin_amdgcn_s_getreg((3 << 11) | 20) & 0xFu; }
#define XB_SPIN(cond, bar) do { unsigned _sp = 0; while (cond) { __builtin_amdgcn_s_sleep(1); \
    if ((++_sp & 255u) == 0u) { if (xb_ld(&(bar)[XB_TMO])) break; if (_sp > XB_SPIN_CAP) { atomicAdd(&(bar)[XB_TMO], 1u); break; } } } } while (0)

struct XcdBarrier {
    unsigned* bar; unsigned x;
    volatile LAS unsigned* st;
};

__device__ __forceinline__ XcdBarrier xcd_barrier_post(unsigned* bar, volatile LAS unsigned* st) {
    XcdBarrier b; b.bar = bar; b.x = xb_xcc_id(); b.st = st;
    if (threadIdx.x == 0) (void)xb_add(&bar[XB_XCNT(b.x)], 1u);
    return b;
}
__device__ __forceinline__ void xcd_barrier_complete(unsigned* bar, unsigned x, unsigned& nloc, unsigned& nx) {
    const unsigned G = gridDim.x * gridDim.y * gridDim.z;
    unsigned sum, cnt, mine, sp = 0u;
    for (;;) {
        sum = 0u; cnt = 0u; mine = 0u;
#pragma unroll
        for (unsigned j = 0; j < 16; ++j) { const unsigned c = xb_ld(&bar[XB_XCNT(j)]); sum += c; cnt += (c > 0u) ? 1u : 0u; mine = (j == x) ? c : mine; }
        if (sum == G) break;
        __builtin_amdgcn_s_sleep(1);
        if ((++sp & 255u) == 0u) { if (xb_ld(&bar[XB_TMO])) break; if (sp > XB_SPIN_CAP) { atomicAdd(&bar[XB_TMO], 1u); break; } }
    }
    nloc = mine > 0u ? mine : 1u; nx = cnt > 0u ? cnt : 1u;
}

__device__ __forceinline__ void xcd_barrier(const XcdBarrier& b) {
    asm volatile("s_waitcnt vmcnt(0)" ::: "memory");
    __syncthreads();
    if (threadIdx.x == 0) {
        unsigned* bar = b.bar;
        __builtin_amdgcn_s_waitcnt(0);
        unsigned nloc = b.st[0], nx = b.st[1];
        if (nloc == 0u) { xcd_barrier_complete(bar, b.x, nloc, nx); b.st[0] = nloc; b.st[1] = nx; }
        const unsigned old = xb_add(&bar[XB_XSUB(b.x)], 1u);
        const unsigned gen = old / nloc;
        if (old + 1u == (gen + 1u) * nloc) {
            __builtin_amdgcn_fence(__ATOMIC_RELEASE, "agent");
            asm volatile("s_waitcnt vmcnt(0)" ::: "memory");
            const unsigned og = xb_add(&bar[XB_TOP], 1u);
            const unsigned tg = og / nx;
            if (og + 1u == (tg + 1u) * nx) xb_add(&bar[XB_TOPGEN], 1u);
            else XB_SPIN(xb_ld(&bar[XB_TOPGEN]) == tg, bar);
            __builtin_amdgcn_fence(__ATOMIC_ACQUIRE, "agent");
            xb_add(&bar[XB_XGEN(b.x)], 1u);
            asm volatile("s_waitcnt vmcnt(0)" ::: "memory");
        } else {
            XB_SPIN(xb_ld(&bar[XB_XGEN(b.x)]) == gen, bar);
            __builtin_amdgcn_fence(__ATOMIC_ACQUIRE, "agent");
            asm volatile("s_waitcnt vmcnt(0)" ::: "memory");
        }
    }
    __syncthreads();
}
__device__ __forceinline__ void skew_delay(int group, int ticks_per_group) {
    const unsigned long long t0 = __builtin_amdgcn_s_memrealtime(); const unsigned long long d = (unsigned long long)(group * ticks_per_group);
    while (__builtin_amdgcn_s_memrealtime() - t0 < d) __builtin_amdgcn_s_sleep(8);
}
#ifndef SKEW3
#define SKEW3 0
#endif
#ifndef SKEW5
#define SKEW5 0
#endif
__global__ void __launch_bounds__(NTHR, 2) hymba_fwd(Args A) {
    extern __shared__ __attribute__((aligned(16))) unsigned char lds_raw[];
    LAS unsigned char* lds = (LAS unsigned char*)lds_raw;
    cg::grid_group grid = cg::this_grid();
    const int tid = threadIdx.x, lane = tid & 63, wave = __builtin_amdgcn_readfirstlane(tid >> 6);
    const int G = gridDim.x, bx = blockIdx.x;
    const int gw = bx * NWAVES + wave, NGW = G * NWAVES;
    unsigned char* ws = A.ws; unsigned char* dob = (unsigned char*)A.out;
    const int lo = A.ph_lo, hi = A.ph_hi;
    volatile LAS unsigned* xb_st = (volatile LAS unsigned*)(lds + 131072 + 8192);
    if (tid < 4) xb_st[tid] = 0u;
    __syncthreads();
    const XcdBarrier xbar = xcd_barrier_post((unsigned*)(ws + WS_BAR), xb_st);
    if (lo > 1000) grid.sync();
#ifndef PMASK
#define PMASK 0x7f
#endif
#define IN(k) (((PMASK >> (k)) & 1) && lo <= (k) && (k) < hi)
#ifndef REPMASK
#define REPMASK 0
#endif
#ifndef XSYNC
#define XSYNC 0
#endif
#define REPS(k) (((REPMASK >> (k)) & 1) ? 2 : 1)
#define SEAM(k) do { if (IN(k) && IN((k) + 1)) { xcd_barrier(xbar); if ((k) == 0) for (int xs_ = 0; xs_ < XSYNC; ++xs_) xcd_barrier(xbar); } } while (0)
    if (IN(0)) for (int rep = 0; rep < REPS(0); ++rep) phase0(A, lds, gw, NGW, wave, lane, 0);
    SEAM(0);
    if (IN(1)) {
        pg8::Gemm g{(const pg8::bf16_t*)(ws + WS_H), (const pg8::bf16_t*)(ws + WS_WIN), M_TOK, 1792, 1024}; pg8::StaticOrder S; S.init(M_TOK, 1792, G, bx); S.rep = REPS(1);
        pg8::EpiInProj E{(pg8::bf16_t*)(ws + WS_Q), (pg8::bf16_t*)(ws + WS_K), (pg8::bf16_t*)(ws + WS_VT), (pg8::bf16_t*)(ws + WS_U), A.q_norm_g, A.k_norm_g};
        pg8::gemm_phase<pg8::EpiInProj, pg8::StaticOrder, true, true>(lds, g, S, E);
        { const int nfull = (896 % G) ? (896 % G) : G;
          if (nfull < G) { if (bx >= nfull) phase0(A, lds, (bx - nfull) * NWAVES + wave, (G - nfull) * NWAVES, wave, lane, 1); }
          else phase0(A, lds, gw, NGW, wave, lane, 1); }
    }
    float bound = 0.f;
    if (IN(2)) { const float gqm = wave_max(fabsf(A.q_norm_g[lane])), gkm = wave_max(fabsf(A.k_norm_g[lane])); bound = 8.0f * gqm * gkm; }
    SEAM(1);
    if (IN(2)) {
#ifndef NO_ATTN
        for (int it = bx; it < 512 * REPS(2); it += G) attn_item(A, lds, it & 511, tid, wave, lane, bound);
#endif
#ifndef NO_CONV
        {
            const int cp = tid & 255;
            f32x2 w[31];
#pragma unroll
            for (int j = 0; j < 31; ++j) { const float2 t = *(const float2*)(A.conv_dw_w + j * 512 + 2 * cp); w[j] = (f32x2){t.x, t.y}; }
            const float2 b_ = *(const float2*)(A.conv_dw_b + 2 * cp), g_ = *(const float2*)(A.conv_ln_g + 2 * cp), l_ = *(const float2*)(A.conv_ln_b + 2 * cp);
            const f32x2 bias = {b_.x, b_.y}, lg = {g_.x, g_.y}, lb = {l_.x, l_.y};
#pragma unroll 1
            for (int it = bx; it < 512 * REPS(7); it += G) conv_item(A, lds, it & 511, tid, wave, lane, w, bias, lg, lb);
        }
#endif
    }
    SEAM(2);
    if (IN(3)) {
        pg8::Gemm g{(const pg8::bf16_t*)(ws + WS_H), (const pg8::bf16_t*)(ws + WS_WO), M_TOK, 1024, 1024}; pg8::StaticOrder S; S.init(M_TOK, 1024, G, bx); S.rep = REPS(3);
        if (SKEW3) skew_delay((bx >> 3) & 3, SKEW3);
        pg8::EpiOutProj E{A.xp, A.xs, nullptr, (pg8::bf16_t*)(ws + WS_DELTA), (float*)(ws + WS_SSQ), (LAS float*)(lds + 131072)};
        pg8::gemm_phase<pg8::EpiOutProj, pg8::StaticOrder, true, true>(lds, g, S, E);
    }
    SEAM(3);
    if (IN(4)) {
        pg8::Gemm g{(const pg8::bf16_t*)(ws + WS_DELTA), (const pg8::bf16_t*)(dob + DO_WGU), M_TOK, 2 * DFF, 1024}; pg8::StaticOrder S; S.init(M_TOK, 2 * DFF, G, bx); S.rep = REPS(4);
        pg8::EpiGateUp E{(pg8::bf16_t*)(ws + WS_ACT), (float*)(dob + DO_GE), (float*)(dob + DO_UE), (const float*)(ws + WS_SSQ), A.ffn_dw_w, A.ffn_dw_b, (LAS float*)(lds + 131072)};
        pg8::gemm_phase<pg8::EpiGateUp, pg8::StaticOrder, true, true>(lds, g, S, E);
    }
    SEAM(4);
    if (IN(5)) for (int rep = 0; rep < REPS(5); ++rep) fix_edges(A, bx * NTHR + tid, G * NTHR);
    SEAM(5);
    if (IN(6)) {
        pg8::Gemm g{(const pg8::bf16_t*)(ws + WS_ACT), (const pg8::bf16_t*)(ws + WS_WD), M_TOK, 1024, DFF}; pg8::StaticOrder S; S.init(M_TOK, 1024, G, bx); S.rep = REPS(6);
        pg8::EpiDown E{A.xp, A.xs, (const pg8::bf16_t*)(ws + WS_DELTA), A.out};
        if (SKEW5) skew_delay((bx >> 3) & 3, SKEW5);
        pg8::gemm_phase<pg8::EpiDown, pg8::StaticOrder, true, true>(lds, g, S, E);
    }
#undef IN
#undef SEAM
}

#ifndef N_LAUNCH_PER_PHASE
#define N_LAUNCH_PER_PHASE 0
#endif
extern "C" void kernel_launch(void* const* d_in, const int* in_sizes, int n_in, void* d_out, int out_size, void* d_ws, size_t ws_size, hipStream_t stream) {
    static int grid = 0;
    if (grid == 0) {
        if (n_in != 18 || out_size != M_TOK * DM || ws_size < WS_END) { fprintf(stderr, "kernel_launch: unexpected shapes (n_in %d out %d ws %zu)\n", n_in, out_size, ws_size); grid = -1; return; }
        int dev = 0, cus = 0, per_cu = 0;
        hipGetDevice(&dev); hipDeviceGetAttribute(&cus, hipDeviceAttributeMultiprocessorCount, dev);
        if (hipFuncSetAttribute((const void*)hymba_fwd, hipFuncAttributeMaxDynamicSharedMemorySize, LDS_BYTES) != hipSuccess) { fprintf(stderr, "kernel_launch: hipFuncSetAttribute failed\n"); grid = -1; return; }
        if (hipOccupancyMaxActiveBlocksPerMultiprocessor(&per_cu, (const void*)hymba_fwd, NTHR, LDS_BYTES) != hipSuccess || per_cu < 1) { fprintf(stderr, "kernel_launch: occupancy query says %d\n", per_cu); per_cu = 1; }
        (void)hipGetLastError();
        grid = cus * 1;
    }
    if (grid < 0) return;
    if (hipMemsetAsync((char*)d_ws + WS_BAR, 0, BAR_BYTES, stream) != hipSuccess) { fprintf(stderr, "kernel_launch: memset failed\n"); return; }
    Args a{};
    const float** slots = (const float**)&a;
    for (int i = 0; i < 18; ++i) slots[i] = (const float*)d_in[i];
    a.out = (float*)d_out; a.ws = (unsigned char*)d_ws;
#if N_LAUNCH_PER_PHASE
    for (int p = 0; p < 7; ++p) { a.ph_lo = p; a.ph_hi = p + 1; hipLaunchKernelGGL(hymba_fwd, dim3(grid), dim3(NTHR), LDS_BYTES, stream, a); }
#else
    a.ph_lo = 0; a.ph_hi = 7;
    void* args[] = {&a};
    hipError_t e = hipLaunchCooperativeKernel((const void*)hymba_fwd, dim3(grid), dim3(NTHR), args, LDS_BYTES, stream);
    if (e != hipSuccess) fprintf(stderr, "cooperative launch failed: %s (grid %d)\n", hipGetErrorString(e), grid);
#endif
}
```

```cpp
#include <hip/hip_runtime.h>
#include <hip/hip_cooperative_groups.h>
#include <cstdio>
#include <cstdint>
namespace cg = cooperative_groups;
namespace pg8 {
#define PG8_LAS __attribute__((address_space(3)))
typedef unsigned short bf16_t;
typedef short bf16x8 __attribute__((ext_vector_type(8)));
typedef float f32x4 __attribute__((ext_vector_type(4)));
typedef unsigned u32x4 __attribute__((ext_vector_type(4)));
constexpr int BM = 256, BK = 64, HALF = 128, HTB = HALF * BK * 2  , STAGE_BYTES = 8 * HTB, NXCD = 8, WGM = 8;

__host__ __device__ __forceinline__ int lds_byte(int r, int c) { const int st = (r >> 4) * 2 + (c >> 5), rr = r & 15, cc = c & 31, ob = rr * 64 + cc * 2; return st * 1024 + (ob ^ (((ob >> 9) & 1) << 5)); }
__host__ __device__ __forceinline__ void stage_rc(int b, int& R, int& C) { const int st = b / 1024, sb = b % 1024, swz = sb ^ (((sb >> 9) & 1) << 5); R = (st >> 1) * 16 + swz / 64; C = (st & 1) * 32 + (swz % 64) / 2; }
__host__ __device__ __forceinline__ int perm32(int rho) { const int n = rho >> 4, i = rho & 15; return 8 * (i >> 2) + 4 * n + (i & 3); }

struct Unit { int pm, pn; };
struct Gemm { const bf16_t* A; const bf16_t* Bt; int M, N, K; };

struct StaticOrder {
    int nM, nN, nwg, G, c, rep = 1;
    __host__ __device__ void init(int M, int N, int G_, int c_) { nM = M / BM; nN = N / BM; nwg = nM * nN; G = G_; c = c_; }
    __host__ __device__ bool next(int i, Unit& u) const {
        const int rounds = (nwg - c + G - 1) / G; if (i >= rep * rounds) return false; const long L = (long)(i % rounds) * G + c;
        int wgid = (int)L; { const int q = nwg / NXCD, r = nwg % NXCD, xcd = wgid % NXCD, off = wgid / NXCD; wgid = (xcd < r ? xcd * (q + 1) : r * (q + 1) + (xcd - r) * q) + off; }
        const int nig = WGM * nN, gid = wgid / nig, fm = gid * WGM, gsz = (nM - fm) < WGM ? (nM - fm) : WGM;
        u.pm = fm + ((wgid % nig) % gsz); u.pn = (wgid % nig) / gsz; return true;
    }
    __device__ __forceinline__ void a_ready(const Unit&) const {}
    __device__ __forceinline__ void done(const Unit&) const {}
};

__device__ __forceinline__ unsigned cvt_pk_bf16(float lo, float hi) { unsigned r; asm volatile("v_cvt_pk_bf16_f32 %0, %1, %2" : "=v"(r) : "v"(lo), "v"(hi)); return r; }
typedef float f32x2 __attribute__((ext_vector_type(2)));
constexpr int M_TOK = 32768, DM = 1024, M_PROMPT = 16384, T_PROMPT = 2048, T_SAMPLE = 8192, DFF = 2816;
constexpr float LOG2E = 1.4426950408889634f;
constexpr float QSCALE = 0.125f * LOG2E;
__device__ __forceinline__ void seq_bounds(int row, int& s0, int& s1) {
    if (row < M_PROMPT) { s0 = row & ~(T_PROMPT - 1); s1 = s0 + T_PROMPT; }
    else { s0 = M_PROMPT + ((row - M_PROMPT) & ~(T_SAMPLE - 1)); s1 = s0 + T_SAMPLE; }
}
__device__ __forceinline__ float fast_sigmoid(float v) { return __builtin_amdgcn_rcpf(1.0f + __builtin_amdgcn_exp2f(-LOG2E * v)); }
__device__ __forceinline__ float fast_silu(float v) { return v * fast_sigmoid(v); }

struct EpiInProj {
    static constexpr bool PERM = true, AFTER_DRAIN = false, PREFETCH = false, TWICE = false, PRELOAD = false; struct Pre {};
    bf16_t* Q; bf16_t* Kb; bf16_t* VT; bf16_t* U; const float* gq; const float* gk;
    __device__ __forceinline__ void operator()(f32x4 (&acc)[2][2][4][2], const Unit& u, int wr, int wc, int fr, int fq) const {
        asm volatile("" : "+v"(fr), "+v"(fq));
        const int row0 = u.pm * BM + wr * 64 + fr;
        if (u.pn < 3) {
            const bool isq = u.pn < 2, isk = (u.pn == 2) && (wc < 2);
            if (isq || isk) {
                const float* g = isq ? gq : gk; const float sc = isq ? QSCALE : 1.0f;
                f32x4 gv[2][2];
#pragma unroll
                for (int bj = 0; bj < 2; ++bj)
#pragma unroll
                    for (int n = 0; n < 2; ++n) gv[bj][n] = *(const f32x4*)(g + 32 * bj + 8 * fq + 4 * n) * sc;
                bf16_t* dst = isq ? (Q + (size_t)(u.pn * 4 + wc) * 64) : (Kb + (size_t)wc * 64);
                const int pitch = isq ? 512 : 128;
#pragma unroll
                for (int ai = 0; ai < 2; ++ai)
#pragma unroll
                    for (int m = 0; m < 4; ++m) {
                        float s = 0.f;
#pragma unroll
                        for (int bj = 0; bj < 2; ++bj)
#pragma unroll
                            for (int n = 0; n < 2; ++n) { const f32x4 x = acc[ai][bj][m][n]; s += (x[0] * x[0] + x[1] * x[1]) + (x[2] * x[2] + x[3] * x[3]); }
                        s += __shfl_xor(s, 16); s += __shfl_xor(s, 32);
                        const float rs = __builtin_amdgcn_rsqf(s * (1.0f / 64.0f) + 1e-6f);
                        bf16_t* rowp = dst + (size_t)(row0 + ai * HALF + m * 16) * pitch + 8 * fq;
#pragma unroll
                        for (int bj = 0; bj < 2; ++bj) {
                            const f32x4 v0 = acc[ai][bj][m][0] * rs * gv[bj][0], v1 = acc[ai][bj][m][1] * rs * gv[bj][1];
                            u32x4 w; w.x = cvt_pk_bf16(v0[0], v0[1]); w.y = cvt_pk_bf16(v0[2], v0[3]); w.z = cvt_pk_bf16(v1[0], v1[1]); w.w = cvt_pk_bf16(v1[2], v1[3]);
                            *(u32x4*)(rowp + 32 * bj) = w;
                        }
                    }
            } else {
                bf16_t* vt = VT + (size_t)(wc - 2) * 64 * M_TOK;
#pragma unroll
                for (int ai = 0; ai < 2; ++ai)
#pragma unroll
                    for (int m = 0; m < 4; ++m) {
                        const int row = row0 + ai * HALF + m * 16;
#pragma unroll
                        for (int bj = 0; bj < 2; ++bj)
#pragma unroll
                            for (int n = 0; n < 2; ++n) {
                                const f32x4 x = acc[ai][bj][m][n]; const int d0 = 32 * bj + 8 * fq + 4 * n;
                                const unsigned p01 = cvt_pk_bf16(x[0], x[1]), p23 = cvt_pk_bf16(x[2], x[3]);
                                vt[(size_t)(d0 + 0) * M_TOK + row] = (bf16_t)(p01 & 0xffffu); vt[(size_t)(d0 + 1) * M_TOK + row] = (bf16_t)(p01 >> 16);
                                vt[(size_t)(d0 + 2) * M_TOK + row] = (bf16_t)(p23 & 0xffffu); vt[(size_t)(d0 + 3) * M_TOK + row] = (bf16_t)(p23 >> 16);
                            }
                    }
            }
        } else {
            bf16_t* dst = U + (size_t)(u.pn - 3) * 128 + 32 * wc + 8 * fq;
#pragma unroll
            for (int ai = 0; ai < 2; ++ai)
#pragma unroll
                for (int m = 0; m < 4; ++m) {
                    f32x4 o[2];
#pragma unroll
                    for (int n = 0; n < 2; ++n) { const f32x4 a = acc[ai][0][m][n], g = acc[ai][1][m][n];
#pragma unroll
                        for (int j = 0; j < 4; ++j) o[n][j] = a[j] * fast_sigmoid(g[j]); }
                    u32x4 w; w.x = cvt_pk_bf16(o[0][0], o[0][1]); w.y = cvt_pk_bf16(o[0][2], o[0][3]); w.z = cvt_pk_bf16(o[1][0], o[1][1]); w.w = cvt_pk_bf16(o[1][2], o[1][3]);
                    *(u32x4*)(dst + (size_t)(row0 + ai * HALF + m * 16) * 512) = w;
                }
        }
    }
};

struct EpiOutProj {
    static constexpr bool PERM = true, AFTER_DRAIN = false, PREFETCH = false, TWICE = false, PRELOAD = false; struct Pre {};
    __device__ __forceinline__ void prefetch(const Unit& u, PG8_LAS unsigned char* lds) const {
        const int t = threadIdx.x; const float* xb = (u.pm * BM < M_PROMPT) ? xp : (xs - (size_t)M_PROMPT * DM);
        PG8_LAS unsigned* dummy = (PG8_LAS unsigned*)(lds + 131072 + 4096 + (t >> 6) * 256);
#pragma unroll
        for (int i = 0; i < 4; ++i) { const int L = t + 512 * i; __builtin_amdgcn_global_load_lds((const unsigned*)(xb + (size_t)(u.pm * BM + (L >> 3)) * DM + u.pn * BM + (L & 7) * 32), dummy, 4, 0, 0); }
    }
    const float* xp; const float* xs; bf16_t* delta; bf16_t* x1b; float* ssq; PG8_LAS float* red;
    __device__ __forceinline__ void operator()(f32x4 (&acc)[2][2][4][2], const Unit& u, int wr, int wc, int fr, int fq) const {
        asm volatile("" : "+v"(fr), "+v"(fq));
        const int row0 = u.pm * BM + wr * 64 + fr, col0 = u.pn * BM + wc * 32 + 8 * fq;
        const float* xb = (u.pm * BM < M_PROMPT) ? xp : (xs - (size_t)M_PROMPT * DM);
#pragma unroll
        for (int ai = 0; ai < 2; ++ai)
#pragma unroll
            for (int mh = 0; mh < 2; ++mh) {
                f32x4 xv[2][2][2];
#pragma unroll
                for (int mm = 0; mm < 2; ++mm)
#pragma unroll
                    for (int bj = 0; bj < 2; ++bj) { const float* p = xb + (size_t)(row0 + ai * HALF + (2 * mh + mm) * 16) * DM + col0 + bj * HALF; xv[mm][bj][0] = *(const f32x4*)p; xv[mm][bj][1] = *(const f32x4*)(p + 4); }
                __builtin_amdgcn_sched_barrier(0);
#pragma unroll
                for (int mm = 0; mm < 2; ++mm) {
                    const int m = 2 * mh + mm; const int row = row0 + ai * HALF + m * 16; const size_t ro = (size_t)row * DM + col0; float s = 0.f;
#pragma unroll
                    for (int bj = 0; bj < 2; ++bj) {
                        const f32x4 a0 = acc[ai][bj][m][0], a1 = acc[ai][bj][m][1];
                        const f32x4 v0 = a0 + xv[mm][bj][0], v1 = a1 + xv[mm][bj][1];
                        s += ((v0[0] * v0[0] + v0[1] * v0[1]) + (v0[2] * v0[2] + v0[3] * v0[3])) + ((v1[0] * v1[0] + v1[1] * v1[1]) + (v1[2] * v1[2] + v1[3] * v1[3]));
                        u32x4 y; y.x = cvt_pk_bf16(v0[0], v0[1]); y.y = cvt_pk_bf16(v0[2], v0[3]); y.z = cvt_pk_bf16(v1[0], v1[1]); y.w = cvt_pk_bf16(v1[2], v1[3]);
                        *(u32x4*)(x1b + ro + bj * HALF) = y;
                    }
                    s += __shfl_xor(s, 16); s += __shfl_xor(s, 32);
                    if (fq == 0) red[(ai * HALF + wr * 64 + m * 16 + fr) * 4 + wc] = s;
                }
                __builtin_amdgcn_sched_barrier(0);
            }
        __syncthreads();
        const int t = threadIdx.x;
        if (t < 256) { const f32x4 v = *(const PG8_LAS f32x4*)(red + t * 4); ssq[(size_t)(u.pm * BM + t) * 4 + u.pn] = (v[0] + v[1]) + (v[2] + v[3]); }
    }
};

template <int CTRL> __device__ __forceinline__ float dpp_row(float v) { return __builtin_bit_cast(float, __builtin_amdgcn_update_dpp(0, __builtin_bit_cast(int, v), CTRL, 0xF, 0xF, false)); }
struct EpiGateUp {
    static constexpr bool PERM = true, AFTER_DRAIN = false, PREFETCH = false, TWICE = false, PRELOAD = true; struct Pre { f32x4 s[2]; };
    bf16_t* act; float* ge; float* ue; const float* ssq; const float* cw; const float* cb; PG8_LAS float* xch; int second = 0;
    static constexpr int ncols = DFF, chbase = 0;
    __device__ __forceinline__ void preload(const Unit& u, int wr, int wc, int lane, Pre& pre) const {
#pragma unroll
        for (int ai = 0; ai < 2; ++ai) pre.s[ai] = *(const f32x4*)(ssq + (size_t)(u.pm * BM + ai * HALF + wr * 64 + lane) * 4);
        const int wid = wr * 4 + wc, j = wid >> 1, half = wid & 1;
        const float* src = (j < 3 ? cw + (size_t)j * DFF : cb) + chbase + u.pn * 128 + half * 64 + lane;
        __builtin_amdgcn_global_load_lds((const unsigned*)src, (PG8_LAS unsigned*)(xch + 1024 + j * 128 + half * 64), 4, 0, 0);
    }
    __device__ __forceinline__ void operator()(f32x4 (&acc)[2][2][4][2], const Unit& u, int wr, int wc, int fr, int fq, const Pre& pre) const {
        asm volatile("" : "+v"(fr), "+v"(fq));
        const int lane = fr + 16 * fq, wid = wr * 4 + wc;
        const int ch0 = u.pn * 128 + 32 * wc + 8 * fq;
        const int lprev = (lane & 48) | ((fr + 15) & 15), lnext = (lane & 48) | ((fr + 1) & 15);
#pragma unroll
        for (int ai = 0; ai < 2; ++ai) {
            const int crow0 = u.pm * BM + ai * HALF + wr * 64;
            const float rs_own = __builtin_amdgcn_rsqf(((pre.s[ai][0] + pre.s[ai][1]) + (pre.s[ai][2] + pre.s[ai][3])) * (1.0f / 1024.0f) + 1e-6f);
#pragma unroll
            for (int m = 0; m < 4; ++m) {
                const float rstd = second ? 1.0f : __shfl(rs_own, 16 * m + fr);
                const float rsu = second ? 1.0f : rstd * (-0.6931471805599453f);
#pragma unroll
                for (int n = 0; n < 2; ++n) { acc[ai][0][m][n] *= rstd; acc[ai][1][m][n] *= rsu; }
            }
            if (fr == 0)  { PG8_LAS float* p = xch + (((wid * 2 + ai) * 2 + 0) * 4 + fq) * 8; *(PG8_LAS f32x4*)p = acc[ai][0][0][0]; *(PG8_LAS f32x4*)(p + 4) = acc[ai][0][0][1]; }
            if (fr == 15) { PG8_LAS float* p = xch + (((wid * 2 + ai) * 2 + 1) * 4 + fq) * 8; *(PG8_LAS f32x4*)p = acc[ai][0][3][0]; *(PG8_LAS f32x4*)(p + 4) = acc[ai][0][3][1]; }
            const int q = 2 * ai + wr;
            if (q == 0 && fr < 2) {
                float* g = ge + ((size_t)u.pm * 4 + fr) * ncols + ch0;
                *(f32x4*)g = acc[ai][0][0][0]; *(f32x4*)(g + 4) = acc[ai][0][0][1];
                if (fr == 0) { float* p = ue + ((size_t)u.pm * 2) * ncols + ch0; *(f32x4*)p = acc[ai][1][0][0] * (-LOG2E); *(f32x4*)(p + 4) = acc[ai][1][0][1] * (-LOG2E); }
            }
            if (q == 3 && fr >= 14) {
                float* g = ge + ((size_t)u.pm * 4 + (fr - 12)) * ncols + ch0;
                *(f32x4*)g = acc[ai][0][3][0]; *(f32x4*)(g + 4) = acc[ai][0][3][1];
                if (fr == 15) { float* p = ue + ((size_t)u.pm * 2 + 1) * ncols + ch0; *(f32x4*)p = acc[ai][1][3][0] * (-LOG2E); *(f32x4*)(p + 4) = acc[ai][1][3][1] * (-LOG2E); }
            }
        }
        if (wid == 0) { PG8_LAS f32x4* wp = (PG8_LAS f32x4*)(xch + 1024) + lane; wp[0] = wp[0] * (-LOG2E); wp[64] = wp[64] * (-LOG2E); }
        __syncthreads();
#pragma unroll
        for (int ai = 0; ai < 2; ++ai) {
            const int crow0 = u.pm * BM + ai * HALF + wr * 64;
            const int q = 2 * ai + wr, qp = (q + 3) & 3, qn = (q + 1) & 3;
            unsigned pk[2][4][2];
#pragma unroll
            for (int n = 0; n < 2; ++n) {
                const PG8_LAS float* wl = xch + 1024 + 32 * wc + 8 * fq + 4 * n;
                const f32x4 w0 = *(const PG8_LAS f32x4*)(wl), w1 = *(const PG8_LAS f32x4*)(wl + 128), w2 = *(const PG8_LAS f32x4*)(wl + 256), bb = *(const PG8_LAS f32x4*)(wl + 384);
                const f32x4 pvx = *(const PG8_LAS f32x4*)(xch + (((((qp & 1) * 4 + wc) * 2 + (qp >> 1)) * 2 + 1) * 4 + fq) * 8 + 4 * n);
                const f32x4 nxx = *(const PG8_LAS f32x4*)(xch + (((((qn & 1) * 4 + wc) * 2 + (qn >> 1)) * 2 + 0) * 4 + fq) * 8 + 4 * n);
#pragma unroll
                for (int jp = 0; jp < 2; ++jp) {
                    const f32x2 w0p = {w0[2 * jp], w0[2 * jp + 1]}, w1p = {w1[2 * jp], w1[2 * jp + 1]}, w2p = {w2[2 * jp], w2[2 * jp + 1]}, bbp = {bb[2 * jp], bb[2 * jp + 1]};
                    f32x2 g[4], R[4], L[4];
#pragma unroll
                    for (int m = 0; m < 4; ++m) { g[m] = (f32x2){acc[ai][0][m][n][2 * jp], acc[ai][0][m][n][2 * jp + 1]};
                        R[m] = (f32x2){dpp_row<0x121>(g[m].x), dpp_row<0x121>(g[m].y)}; L[m] = (f32x2){dpp_row<0x12F>(g[m].x), dpp_row<0x12F>(g[m].y)}; }
                    const f32x2 pvx2 = {pvx[2 * jp], pvx[2 * jp + 1]}, nxx2 = {nxx[2 * jp], nxx[2 * jp + 1]};
#pragma unroll
                    for (int m = 0; m < 4; ++m) {
                        const f32x2 pv = (fr == 0) ? (m > 0 ? R[m > 0 ? m - 1 : 0] : pvx2) : R[m];
                        const f32x2 nx = (fr == 15) ? (m < 3 ? L[m < 3 ? m + 1 : 3] : nxx2) : L[m];
                        const f32x2 cvs = bbp + w0p * pv + w1p * g[m] + w2p * nx;
                        f32x2 d = {__builtin_amdgcn_exp2f(cvs.x), __builtin_amdgcn_exp2f(cvs.y)}; d = d + 1.0f;
                        const f32x2 r = {__builtin_amdgcn_rcpf(d.x), __builtin_amdgcn_rcpf(d.y)};
                        const f32x2 upv = {acc[ai][1][m][n][2 * jp], acc[ai][1][m][n][2 * jp + 1]};
                        const f32x2 o = (cvs * r) * upv;
                        pk[n][m][jp] = cvt_pk_bf16(o.x, o.y);
                    }
                }
                __builtin_amdgcn_sched_barrier(0);
            }
#pragma unroll
            for (int m = 0; m < 4; ++m) {
                const bool edge = (q == 0 && m == 0 && fr == 0) || (q == 3 && m == 3 && fr == 15);
                if (!edge) { u32x4 w; w.x = pk[0][m][0]; w.y = pk[0][m][1]; w.z = pk[1][m][0]; w.w = pk[1][m][1];
                    *(u32x4*)(act + (size_t)(crow0 + m * 16 + fr) * ncols + ch0) = w; }
            }
        }
    }
};

struct EpiDown {
    static constexpr bool PERM = true, AFTER_DRAIN = false, PREFETCH = false, TWICE = false, PRELOAD = false; struct Pre {};
    __device__ __forceinline__ void prefetch(const Unit& u, PG8_LAS unsigned char* lds) const {
        const int t = threadIdx.x; const float* xb = (u.pm * BM < M_PROMPT) ? xp : (xs - (size_t)M_PROMPT * DM);
        PG8_LAS unsigned* dummy = (PG8_LAS unsigned*)(lds + 131072 + 4096 + (t >> 6) * 256);
#pragma unroll
        for (int i = 0; i < 4; ++i) { const int L = t + 512 * i; __builtin_amdgcn_global_load_lds((const unsigned*)(xb + (size_t)(u.pm * BM + (L >> 3)) * DM + u.pn * BM + (L & 7) * 32), dummy, 4, 0, 0); }
#pragma unroll
        for (int i = 0; i < 2; ++i) { const int L = t + 512 * i; __builtin_amdgcn_global_load_lds((const unsigned*)(delta + (size_t)(u.pm * BM + (L >> 2)) * DM + u.pn * BM + (L & 3) * 64), dummy, 4, 0, 0); }
    }
    const float* xp; const float* xs; const bf16_t* delta; float* out; int second = 0;
    __device__ __forceinline__ void operator()(f32x4 (&acc)[2][2][4][2], const Unit& u, int wr, int wc, int fr, int fq) const {
        asm volatile("" : "+v"(fr), "+v"(fq));
        const int row0 = u.pm * BM + wr * 64 + fr, col0 = u.pn * BM + wc * 32 + 8 * fq;
        const float* xb = (u.pm * BM < M_PROMPT) ? xp : (xs - (size_t)M_PROMPT * DM);
        u32x4 dv[2][4][2];
#pragma unroll
        for (int ai = 0; ai < 2; ++ai)
#pragma unroll
            for (int m = 0; m < 4; ++m)
#pragma unroll
                for (int bj = 0; bj < 2; ++bj) dv[ai][m][bj] = *(const u32x4*)(delta + (size_t)(row0 + ai * HALF + m * 16) * DM + col0 + bj * HALF);
        __builtin_amdgcn_sched_barrier(0);
#pragma unroll
        for (int ai = 0; ai < 2; ++ai)
#pragma unroll
            for (int m = 0; m < 4; ++m)
#pragma unroll
                for (int bj = 0; bj < 2; ++bj) { const size_t ro = (size_t)(row0 + ai * HALF + m * 16) * DM + col0 + bj * HALF;
                    const u32x4 d = dv[ai][m][bj]; f32x4 d0, d1;
                    d0[0] = __uint_as_float(d.x << 16); d0[1] = __uint_as_float(d.x & 0xffff0000u); d0[2] = __uint_as_float(d.y << 16); d0[3] = __uint_as_float(d.y & 0xffff0000u);
                    d1[0] = __uint_as_float(d.z << 16); d1[1] = __uint_as_float(d.z & 0xffff0000u); d1[2] = __uint_as_float(d.w << 16); d1[3] = __uint_as_float(d.w & 0xffff0000u);
                    *(f32x4*)(out + ro) = d0 + acc[ai][bj][m][0];
                    *(f32x4*)(out + ro + 4) = d1 + acc[ai][bj][m][1];
                }
    }
};
template <class Epi, class Sched, bool ALIGN_EPI = false, bool SP2 = false>
__device__ __forceinline__ void gemm_phase(PG8_LAS unsigned char* lds, const Gemm g, const Sched& S, const Epi& E) {
    const int tid = threadIdx.x, wid = __builtin_amdgcn_readfirstlane(tid >> 6), lane = tid & 63, wr = wid >> 2, wc = wid & 3, fr = lane & 15, fq = lane >> 4;
    const int K = g.K, nt = K / BK;
    unsigned voffA[2], voffB[2];
#pragma unroll
    for (int i = 0; i < 2; ++i) { int R, C; stage_rc(tid * 16 + i * 8192, R, C); const int Rb = Epi::PERM ? ((R & ~31) + perm32(R & 31)) : R;
        voffA[i] = (unsigned)(R * K + C) * 2u; voffB[i] = (unsigned)(Rb * K + C) * 2u; }
    const size_t kstep = (size_t)(BK * 2);
    const size_t hstep = (size_t)HALF * K * 2;
    const size_t tstep = 2 * hstep;
    const unsigned ldsw = (unsigned)wid * 1024u;
    const int aoff = lds_byte(wr * 64 + fr, fq * 8), boff = lds_byte(wc * 32 + fr, fq * 8);
#define PG8_SA(b, h) (((b) * 2 + (h)) * HTB)
#define PG8_SB(b, h) ((4 + (b) * 2 + (h)) * HTB)
#define PG8_STAGE(bufoff, gbase, voff) do { _Pragma("unroll") for (int _i = 0; _i < 2; ++_i) \
        __builtin_amdgcn_global_load_lds((const unsigned*)((const char*)(gbase) + (voff)[_i]), (PG8_LAS unsigned*)(lds + (bufoff) + ldsw + _i * 8192), 16, 0, 0); } while (0)
#define PG8_LDA(dst, b, h) do { _Pragma("unroll") for (int m = 0; m < 4; ++m) _Pragma("unroll") for (int k = 0; k < 2; ++k) dst[m][k] = *(const PG8_LAS bf16x8*)(lds + PG8_SA(b, h) + aoff + m * 2048 + k * 1024); } while (0)
#define PG8_LDB(dst, b, h) do { _Pragma("unroll") for (int n = 0; n < 2; ++n) _Pragma("unroll") for (int k = 0; k < 2; ++k) dst[n][k] = *(const PG8_LAS bf16x8*)(lds + PG8_SB(b, h) + boff + n * 2048 + k * 1024); } while (0)
#define PG8_MMA(ai, bj, At, Bt) do { __builtin_amdgcn_s_setprio(1); _Pragma("unroll") for (int m = 0; m < 4; ++m) _Pragma("unroll") for (int n = 0; n < 2; ++n) _Pragma("unroll") for (int k = 0; k < 2; ++k) \
        acc[ai][bj][m][n] = __builtin_amdgcn_mfma_f32_16x16x32_bf16(Bt[n][k], At[m][k], acc[ai][bj][m][n], 0, 0, 0); __builtin_amdgcn_s_setprio(0); } while (0)
#define PG8_WAIT_V(n) asm volatile("s_waitcnt vmcnt(" #n ")" ::: "memory")
#define PG8_WAIT_L(n) asm volatile("s_waitcnt lgkmcnt(" #n ")" ::: "memory")
#define PG8_BAR __builtin_amdgcn_s_barrier()
#define PG8_SCHED __builtin_amdgcn_sched_barrier(0)
    Unit cur, nxt; int ui = 0;
    typename Epi::Pre pre;
    if (!S.next(0, cur)) return;
    f32x4 acc[2][2][4][2];
#pragma unroll
    for (int a = 0; a < 2; ++a)
#pragma unroll
        for (int b = 0; b < 2; ++b)
#pragma unroll
            for (int m = 0; m < 4; ++m)
#pragma unroll
                for (int n = 0; n < 2; ++n) acc[a][b][m][n] = (f32x4){0.f, 0.f, 0.f, 0.f};
    bf16x8 At[4][2], B0[2][2], B1[2][2];
    const char* cA = (const char*)g.A + (size_t)cur.pm * tstep; const char* cB = (const char*)g.Bt + (size_t)cur.pn * tstep;
    S.a_ready(cur);
    if constexpr (Epi::PREFETCH) E.prefetch(cur, lds);
    if constexpr (SP2) {
        PG8_STAGE(PG8_SB(0, 0), cB, voffB); PG8_STAGE(PG8_SB(0, 1), cB + hstep, voffB); PG8_STAGE(PG8_SA(0, 0), cA, voffA); PG8_STAGE(PG8_SA(0, 1), cA + hstep, voffA);
        if (wr == 1) PG8_BAR;
        PG8_WAIT_V(2); PG8_BAR;
        PG8_STAGE(PG8_SB(1, 0), cB + kstep, voffB); PG8_STAGE(PG8_SA(1, 0), cA + kstep, voffA); PG8_STAGE(PG8_SB(1, 1), cB + hstep + kstep, voffB);
        PG8_WAIT_V(6); PG8_BAR;
    } else {
        PG8_STAGE(PG8_SB(0, 0), cB, voffB); PG8_STAGE(PG8_SA(0, 0), cA, voffA); PG8_STAGE(PG8_SB(0, 1), cB + hstep, voffB); PG8_STAGE(PG8_SA(0, 1), cA + hstep, voffA);
        if (wr == 1) PG8_BAR;
        PG8_WAIT_V(4); PG8_BAR;
        PG8_STAGE(PG8_SB(1, 0), cB + kstep, voffB); PG8_STAGE(PG8_SA(1, 0), cA + kstep, voffA); PG8_STAGE(PG8_SB(1, 1), cB + hstep + kstep, voffB);
        PG8_WAIT_V(6); PG8_BAR;
    }
    for (;;) {
        const bool has_next = S.next(ui + 1, nxt);
        const char* nA = has_next ? (const char*)g.A + (size_t)nxt.pm * tstep : cA; const char* nB = has_next ? (const char*)g.Bt + (size_t)nxt.pn * tstep : cB;
        for (int t = 0; t < nt; t += 2) {
            const bool last = (t == nt - 2);
            const char* a1 = cA + (size_t)(t + 1) * kstep;
            const char* a2 = last ? nA : cA + (size_t)(t + 2) * kstep; const char* b2 = last ? nB : cB + (size_t)(t + 2) * kstep;
            const char* a3 = a2 + kstep; const char* b3 = b2 + kstep;
            if (last && has_next) S.a_ready(nxt);
            if constexpr (Epi::PRELOAD) { if (last) E.preload(cur, wr, wc, lane, pre); }
            if constexpr (SP2) {
            PG8_LDB(B0, 0, 0); PG8_LDB(B1, 0, 1); PG8_SCHED; PG8_LDA(At, 0, 0); PG8_STAGE(PG8_SA(1, 1), a1 + hstep, voffA);
            PG8_WAIT_V(8); PG8_WAIT_L(0); PG8_BAR; PG8_MMA(0, 0, At, B0); PG8_MMA(0, 1, At, B1); PG8_BAR; PG8_SCHED;
            PG8_LDA(At, 0, 1); PG8_STAGE(PG8_SB(0, 0), b2, voffB); PG8_STAGE(PG8_SB(0, 1), b2 + hstep, voffB); PG8_STAGE(PG8_SA(0, 0), a2, voffA);
            PG8_WAIT_V(8); PG8_WAIT_L(0); PG8_BAR; PG8_MMA(1, 0, At, B0); PG8_MMA(1, 1, At, B1); PG8_BAR; PG8_SCHED;
            PG8_LDB(B0, 1, 0); PG8_LDB(B1, 1, 1); PG8_SCHED; PG8_LDA(At, 1, 0); PG8_STAGE(PG8_SA(0, 1), a2 + hstep, voffA);
            PG8_WAIT_V(8); PG8_WAIT_L(0); PG8_BAR; PG8_MMA(0, 0, At, B0); PG8_MMA(0, 1, At, B1); PG8_BAR; PG8_SCHED;
            PG8_LDA(At, 1, 1); PG8_STAGE(PG8_SB(1, 0), b3, voffB); PG8_STAGE(PG8_SB(1, 1), b3 + hstep, voffB); PG8_STAGE(PG8_SA(1, 0), a3, voffA);
            PG8_WAIT_V(8); PG8_WAIT_L(0); PG8_BAR; PG8_MMA(1, 0, At, B0); PG8_MMA(1, 1, At, B1); PG8_BAR; PG8_SCHED;
            } else {
            PG8_LDB(B0, 0, 0); PG8_SCHED; PG8_LDA(At, 0, 0); PG8_STAGE(PG8_SA(1, 1), a1 + hstep, voffA);
            PG8_WAIT_L(8); PG8_BAR; PG8_WAIT_L(0); PG8_MMA(0, 0, At, B0); PG8_BAR; PG8_SCHED;
            PG8_LDB(B1, 0, 1); PG8_STAGE(PG8_SB(0, 0), b2, voffB);
            PG8_BAR; PG8_WAIT_L(0); PG8_MMA(0, 1, At, B1); PG8_BAR;
            PG8_LDA(At, 0, 1); PG8_STAGE(PG8_SA(0, 0), a2, voffA);
            PG8_BAR; PG8_WAIT_L(0); PG8_MMA(1, 0, At, B0); PG8_BAR; PG8_SCHED;
            PG8_STAGE(PG8_SB(0, 1), b2 + hstep, voffB);
            PG8_WAIT_V(6); PG8_BAR; PG8_MMA(1, 1, At, B1); PG8_BAR;
            PG8_LDB(B0, 1, 0); PG8_SCHED; PG8_LDA(At, 1, 0); PG8_STAGE(PG8_SA(0, 1), a2 + hstep, voffA);
            PG8_WAIT_L(8); PG8_BAR; PG8_WAIT_L(0); PG8_MMA(0, 0, At, B0); PG8_BAR; PG8_SCHED;
            PG8_LDB(B1, 1, 1); PG8_STAGE(PG8_SB(1, 0), b3, voffB);
            PG8_BAR; PG8_WAIT_L(0); PG8_MMA(0, 1, At, B1); PG8_BAR;
            PG8_LDA(At, 1, 1); PG8_STAGE(PG8_SA(1, 0), a3, voffA);
            PG8_BAR; PG8_WAIT_L(0); PG8_MMA(1, 0, At, B0); PG8_BAR; PG8_SCHED;
            PG8_STAGE(PG8_SB(1, 1), b3 + hstep, voffB);
            PG8_WAIT_V(6); PG8_BAR; PG8_MMA(1, 1, At, B1); PG8_BAR;
            }
        }
        if constexpr (ALIGN_EPI) { if (wr == 0) PG8_BAR; }
        if constexpr (!Epi::AFTER_DRAIN) { if constexpr (Epi::PRELOAD) E(acc, cur, wr, wc, fr, fq, pre); else E(acc, cur, wr, wc, fr, fq); S.done(cur); }
#ifdef EPI2X
        if constexpr (Epi::TWICE) { Epi E2 = E; E2.second = 1; E2(acc, cur, wr, wc, fr, fq); }
#endif
        if (!has_next) break;
#pragma unroll
        for (int a = 0; a < 2; ++a)
#pragma unroll
            for (int b = 0; b < 2; ++b)
#pragma unroll
                for (int m = 0; m < 4; ++m)
#pragma unroll
                    for (int n = 0; n < 2; ++n) acc[a][b][m][n] = (f32x4){0.f, 0.f, 0.f, 0.f};
        cur = nxt; cA = nA; cB = nB; ++ui;
        if constexpr (Epi::PREFETCH) E.prefetch(cur, lds);
        if constexpr (ALIGN_EPI) { if (wr == 1) PG8_BAR; }
    }
    PG8_WAIT_V(0);
    if constexpr (!ALIGN_EPI) { if (wr == 0) PG8_BAR; }
    PG8_BAR;
    if constexpr (Epi::AFTER_DRAIN) { E.fused(acc, cur, wr, wc, fr, fq, lds, wid, lane); S.done(cur); }
#undef PG8_SA
#undef PG8_SB
#undef PG8_STAGE
#undef PG8_LDA
#undef PG8_LDB
#undef PG8_MMA
#undef PG8_WAIT_V
#undef PG8_WAIT_L
#undef PG8_BAR
#undef PG8_SCHED
}
}
#define LAS __attribute__((address_space(3)))
typedef unsigned short bf16;
typedef unsigned v4u __attribute__((ext_vector_type(4)));
typedef unsigned v2u __attribute__((ext_vector_type(2)));
typedef float f32x4 __attribute__((ext_vector_type(4)));
typedef float f32x16 __attribute__((ext_vector_type(16)));
typedef short bf16x8 __attribute__((ext_vector_type(8)));
typedef short s16x4 __attribute__((ext_vector_type(4)));
using pg8::cvt_pk_bf16; using pg8::M_TOK; using pg8::DM; using pg8::M_PROMPT; using pg8::DFF; using pg8::LOG2E; using pg8::seq_bounds; using pg8::fast_silu; using pg8::fast_sigmoid;
constexpr int NWAVES = 8, NTHR = 512;
constexpr int LDS_BYTES = 147456;
constexpr size_t MiB = 1u << 20;
constexpr size_t WS_WIN = 0, WS_WO = 4 * MiB, WS_WD = 6 * MiB, WS_SSQ = 12 * MiB, WS_BAR = 12 * MiB + 512 * 1024, BAR_BYTES = 16384;
constexpr size_t WS_H = 16 * MiB;
constexpr size_t WS_Q = 80 * MiB, WS_K = 112 * MiB, WS_VT = 120 * MiB, WS_U = 128 * MiB;
constexpr size_t WS_ACT = 16 * MiB;
constexpr size_t WS_DELTA = 192 * MiB, WS_END = 256 * MiB;
constexpr size_t DO_X1B = 0, DO_WGU = 64 * MiB, DO_GE = 76 * MiB, DO_UE = 99 * MiB;

__device__ __forceinline__ float wave_sum(float v) {
#pragma unroll
    for (int o = 1; o < 64; o <<= 1) v += __shfl_xor(v, o);
    return v;
}
__device__ __forceinline__ float wave_max(float v) {
#pragma unroll
    for (int o = 1; o < 64; o <<= 1) v = fmaxf(v, __shfl_xor(v, o));
    return v;
}
__device__ __forceinline__ void transpose_item(const float* W, int N, int k0, int n0, bf16* dst, int dpitch, const float* kscale, LAS float* scr, int lane) {
    float wv[32];
#pragma unroll
    for (int i = 0; i < 32; ++i) { const int kk = 2 * i + (lane >> 5); wv[i] = W[(size_t)(k0 + kk) * N + n0 + (lane & 31)]; }
    if (kscale) {
        float ks[32];
#pragma unroll
        for (int i = 0; i < 32; ++i) ks[i] = kscale[k0 + 2 * i + (lane >> 5)];
#pragma unroll
        for (int i = 0; i < 32; ++i) wv[i] *= ks[i];
    }
#pragma unroll
    for (int i = 0; i < 32; ++i) { const int kk = 2 * i + (lane >> 5); scr[kk * 33 + (lane & 31)] = wv[i]; }
    asm volatile("s_waitcnt lgkmcnt(0)" ::: "memory");
    const int c = lane & 7;
#pragma unroll
    for (int j = 0; j < 4; ++j) { const int n = (lane >> 3) + 8 * j; const LAS float* s = scr + (8 * c) * 33 + n;
        v4u o; o.x = cvt_pk_bf16(s[0 * 33], s[1 * 33]); o.y = cvt_pk_bf16(s[2 * 33], s[3 * 33]); o.z = cvt_pk_bf16(s[4 * 33], s[5 * 33]); o.w = cvt_pk_bf16(s[6 * 33], s[7 * 33]);
        *(v4u*)(dst + (size_t)n * dpitch + 8 * c) = o; }
    asm volatile("s_waitcnt lgkmcnt(0)" ::: "memory");
}

struct Args {
    const float *xp, *xs, *norm1_g, *w_in, *q_norm_g, *k_norm_g, *attn_sink, *conv_dw_w, *conv_dw_b, *conv_ln_g, *conv_ln_b, *w_out, *norm2_g, *w_gate, *w_up, *ffn_dw_w, *ffn_dw_b, *w_down;
    float* out; unsigned char* ws; int ph_lo, ph_hi;
};

__device__ __forceinline__ void phase0(const Args& A, LAS unsigned char* lds, int gw, int NGW, int wave, int lane, int part) {
    unsigned char* ws = A.ws;
    LAS float* scr = (LAS float*)(lds + wave * 16384);
    constexpr int I_IN = 16 * 56, I_O = 16 * 32, I_G = 16 * 88, I_D = 44 * 32;
    constexpr int NITEMS = I_IN + I_O + 2 * I_G + I_D;
    const int it_lo = part ? I_IN : 0, it_hi = part ? NITEMS : I_IN;
    for (int it = it_lo + gw; it < it_hi; it += NGW) {
        int r = it;
        if (r < I_IN) {
            const int kb = r / 56, nb = r % 56, n0 = 32 * nb; int drow;
            if (n0 < 768) { const int pn = n0 >> 8, wc = (n0 >> 6) & 3, bj = (n0 >> 5) & 1; drow = 256 * pn + 128 * bj + 32 * wc; }
            else if (n0 < 1280) { const int ch = n0 - 768; drow = 256 * (3 + (ch >> 7)) + (ch & 127); }
            else { const int ch = n0 - 1280; drow = 256 * (3 + (ch >> 7)) + 128 + (ch & 127); }
            transpose_item(A.w_in, 1792, 64 * kb, n0, (bf16*)(ws + WS_WIN) + (size_t)drow * 1024 + 64 * kb, 1024, nullptr, scr, lane); continue; }
        r -= I_IN;
        if (r < I_O) { const int kb = r / 32, nb = r % 32; transpose_item(A.w_out, 1024, 64 * kb, 32 * nb, (bf16*)(ws + WS_WO) + (size_t)(32 * nb) * 1024 + 64 * kb, 1024, nullptr, scr, lane); continue; }
        r -= I_O;
        if (r < 2 * I_G) { const int up = r >= I_G; if (up) r -= I_G; const int kb = r / 88, nb = r % 88, ch = 32 * nb; const int drow = 256 * (ch >> 7) + 128 * up + (ch & 127);
            transpose_item(up ? A.w_up : A.w_gate, DFF, 64 * kb, ch, (bf16*)((unsigned char*)A.out + DO_WGU) + (size_t)drow * 1024 + 64 * kb, 1024, A.norm2_g, scr, lane); continue; }
        r -= 2 * I_G;
        { const int kb = r / 32, nb = r % 32, k0 = 64 * kb;
          transpose_item(A.w_down, 1024, k0, 32 * nb, (bf16*)(ws + WS_WD) + (size_t)(32 * nb) * DFF + k0, DFF, nullptr, scr, lane); }
    }
    if (part) return;
    f32x4 g[4];
#pragma unroll
    for (int j = 0; j < 4; ++j) g[j] = ((const f32x4*)A.norm1_g)[lane + 64 * j];
    bf16* H = (bf16*)(ws + WS_H);
    for (int m = gw; m < M_TOK; m += NGW) {
        const float* xrow = (m < M_PROMPT) ? A.xp + (size_t)m * DM : A.xs + (size_t)(m - M_PROMPT) * DM;
        f32x4 v[4]; float s = 0.f;
#pragma unroll
        for (int j = 0; j < 4; ++j) { v[j] = ((const f32x4*)xrow)[lane + 64 * j]; s += (v[j][0] * v[j][0] + v[j][1] * v[j][1]) + (v[j][2] * v[j][2] + v[j][3] * v[j][3]); }
        const float rs = __builtin_amdgcn_rsqf(wave_sum(s) * (1.0f / DM) + 1e-6f);
        uint2* o8 = (uint2*)(H + (size_t)m * DM) + lane;
#pragma unroll
        for (int j = 0; j < 4; ++j) { const f32x4 y = v[j] * rs * g[j]; uint2 w; w.x = cvt_pk_bf16(y[0], y[1]); w.y = cvt_pk_bf16(y[2], y[3]); o8[64 * j] = w; }
    }
}

constexpr int KP = 144, VP = 776;
constexpr int LDS_KOFF = 0, LDS_VOFF = 384 * KP;
__device__ __forceinline__ void attn_item(const Args& A, LAS unsigned char* lds, int item, int tid, int wave, int lane, float bound) {
    const bf16* Q = (const bf16*)(A.ws + WS_Q); const bf16* Kg = (const bf16*)(A.ws + WS_K); const bf16* VT = (const bf16*)(A.ws + WS_VT); bf16* MIX = (bf16*)(A.ws + WS_H);
    const int blk = item >> 1, kvh = item & 1, q0 = blk * 128, band0 = q0 - 128;
    int s0, s1; seq_bounds(q0, s0, s1);
    const int vlo = (q0 == s0) ? 128 : 0, vhi = (q0 + 128 == s1) ? 256 : 384;
    const int hl = wave >> 1, head = kvh * 4 + hl, r = lane & 31, h = lane >> 5;
    const float sink = A.attn_sink[head];
    bf16x8 qf0[4];
    { const bf16* qrow = Q + (size_t)(band0 + 128 + 64 * (wave & 1) + r) * 512 + head * 64 + 8 * h;
#pragma unroll
      for (int kk = 0; kk < 4; ++kk) qf0[kk] = *(const bf16x8*)(qrow + 16 * kk); }
    {
        v4u kreg[6], vreg[6];
#pragma unroll
        for (int q = 0; q < 6; ++q) { const int c = tid + NTHR * q, i = c >> 3, part = c & 7, ic = min(max(i, vlo), vhi - 1);
            kreg[q] = *(const v4u*)(Kg + (size_t)(band0 + ic) * 128 + kvh * 64 + part * 8); }
#pragma unroll
        for (int q = 0; q < 6; ++q) { const int c = tid + NTHR * q, d = c / 48, part = c % 48, ic = min(max(part * 8, vlo), vhi - 8);
            vreg[q] = *(const v4u*)(VT + (size_t)(kvh * 64 + d) * M_TOK + band0 + ic); }
#pragma unroll
        for (int q = 0; q < 6; ++q) { const int c = tid + NTHR * q, i = c >> 3, part = c & 7; *(LAS v4u*)(lds + LDS_KOFF + i * KP + part * 16) = kreg[q]; }
#pragma unroll
        for (int q = 0; q < 6; ++q) { const int c = tid + NTHR * q, d = c / 48, part = c % 48;
            LAS v2u* p = (LAS v2u*)(lds + LDS_VOFF + d * VP + part * 16); p[0] = (v2u){vreg[q].x, vreg[q].y}; p[1] = (v2u){vreg[q].z, vreg[q].w}; }
    }
    __syncthreads();
    const float slope2 = LOG2E * __builtin_amdgcn_exp2f(-(float)(head + 1));
    const float m2 = LOG2E * fmaxf(bound, sink), sinkterm = __builtin_amdgcn_exp2f(LOG2E * sink - m2);
#pragma unroll 1
    for (int qs = 0; qs < 2; ++qs) {
        const int qt = 128 + 64 * (wave & 1) + 32 * qs;
        const bf16* qrow = Q + (size_t)(band0 + qt + r) * 512 + head * 64 + 8 * h;
        bf16x8 qf[4];
        if (qs == 0) {
#pragma unroll
            for (int kk = 0; kk < 4; ++kk) qf[kk] = qf0[kk];
        } else {
#pragma unroll
            for (int kk = 0; kk < 4; ++kk) qf[kk] = *(const bf16x8*)(qrow + 16 * kk);
        }
        f32x16 O0, O1, OS, NEG;
#pragma unroll
        for (int i = 0; i < 16; ++i) { O0[i] = 0.f; O1[i] = 0.f; OS[i] = 0.f; NEG[i] = -m2; }
        const bf16x8 ones = {(short)0x3f80, (short)0x3f80, (short)0x3f80, (short)0x3f80, (short)0x3f80, (short)0x3f80, (short)0x3f80, (short)0x3f80};
        const int kb_lo = max(qt - 128, vlo), kb_hi = min(qt + 160, vhi);
#pragma unroll 2
        for (int kb = kb_lo; kb < kb_hi; kb += 32) {
            f32x16 S;
            const LAS unsigned char* kp = lds + LDS_KOFF + (kb + r) * KP + h * 16;
#pragma unroll
            for (int kk = 0; kk < 4; ++kk) { const bf16x8 kf = *(const LAS bf16x8*)(kp + kk * 32); S = __builtin_amdgcn_mfma_f32_32x32x16_bf16(kf, qf[kk], kk ? S : NEG, 0, 0, 0); }
            const float dbase = (float)(qt + r - kb - 4 * h);
            float p[16];
            if (kb == qt - 128 || kb == qt + 128) {
#pragma unroll
                for (int i = 0; i < 16; ++i) {
                    const float d = dbase - (float)((i & 3) + 8 * (i >> 2));
                    const float e = __builtin_amdgcn_exp2f(S[i] - slope2 * fabsf(d));
                    p[i] = (fabsf(d) <= 128.0f) ? e : 0.f;
                }
            } else {
#pragma unroll
                for (int i = 0; i < 16; ++i) {
                    const float d = dbase - (float)((i & 3) + 8 * (i >> 2));
                    p[i] = __builtin_amdgcn_exp2f(S[i] - slope2 * fabsf(d));
                }
            }
#pragma unroll
            for (int s = 0; s < 2; ++s) {
                v4u pk; pk.x = cvt_pk_bf16(p[8 * s], p[8 * s + 1]); pk.y = cvt_pk_bf16(p[8 * s + 2], p[8 * s + 3]); pk.z = cvt_pk_bf16(p[8 * s + 4], p[8 * s + 5]); pk.w = cvt_pk_bf16(p[8 * s + 6], p[8 * s + 7]);
                const bf16x8 ps = __builtin_bit_cast(bf16x8, pk);
                OS = __builtin_amdgcn_mfma_f32_32x32x16_bf16(ones, ps, OS, 0, 0, 0);
                const LAS unsigned char* vp = lds + LDS_VOFF + r * VP + (kb + 16 * s + 4 * h) * 2;
                { const s16x4 lo = *(const LAS s16x4*)(vp), hi = *(const LAS s16x4*)(vp + 16);
                  const bf16x8 vf = __builtin_shufflevector(lo, hi, 0, 1, 2, 3, 4, 5, 6, 7); O0 = __builtin_amdgcn_mfma_f32_32x32x16_bf16(vf, ps, O0, 0, 0, 0); }
                { const s16x4 lo = *(const LAS s16x4*)(vp + 32 * VP), hi = *(const LAS s16x4*)(vp + 32 * VP + 16);
                  const bf16x8 vf = __builtin_shufflevector(lo, hi, 0, 1, 2, 3, 4, 5, 6, 7); O1 = __builtin_amdgcn_mfma_f32_32x32x16_bf16(vf, ps, O1, 0, 0, 0); }
            }
        }
        const float l = OS[0];
        const float inv = 1.0f / (l + sinkterm);
        bf16* orow = MIX + (size_t)(band0 + qt + r) * DM + head * 64 + 4 * h;
#pragma unroll
        for (int g = 0; g < 4; ++g) {
            uint2 w; w.x = cvt_pk_bf16(O0[4 * g] * inv, O0[4 * g + 1] * inv); w.y = cvt_pk_bf16(O0[4 * g + 2] * inv, O0[4 * g + 3] * inv); *(uint2*)(orow + 8 * g) = w;
            uint2 x; x.x = cvt_pk_bf16(O1[4 * g] * inv, O1[4 * g + 1] * inv); x.y = cvt_pk_bf16(O1[4 * g + 2] * inv, O1[4 * g + 3] * inv); *(uint2*)(orow + 32 + 8 * g) = x;
        }
    }
    __syncthreads();
}

constexpr int LDS_ST = 96 * 1024;
typedef float f32x2 __attribute__((ext_vector_type(2)));
__device__ __forceinline__ void conv_item(const Args& A, LAS unsigned char* lds, int item, int tid, int wave, int lane, const f32x2 (&w)[31], f32x2 bias, f32x2 lg, f32x2 lb) {
    const bf16* U = (const bf16*)(A.ws + WS_U); bf16* MIX = (bf16*)(A.ws + WS_H);
    const int t0 = item * 64; int s0, s1; seq_bounds(t0, s0, s1);
    for (int i = wave; i < 94; i += NWAVES) {
        const int tok = t0 - 15 + i;
        if (tok >= s0 && tok < s1) __builtin_amdgcn_global_load_lds((const unsigned*)(U + (size_t)tok * 512 + lane * 8), (LAS unsigned*)(lds + i * 1024), 16, 0, 0);
        else *(LAS v4u*)(lds + i * 1024 + lane * 16) = (v4u){0u, 0u, 0u, 0u};
    }
    const int cp = tid & 255, tgb = tid >> 8;
    asm volatile("s_waitcnt vmcnt(0)" ::: "memory");
    __syncthreads();
    LAS float* ST = (LAS float*)(lds + LDS_ST);
#pragma unroll 1
    for (int it = 0; it < 4; ++it) {
        const int tg = tgb + 2 * it;
        f32x2 res[8];
#pragma unroll
        for (int t = 0; t < 8; ++t) res[t] = bias;
        const LAS unsigned* xp = (const LAS unsigned*)(lds + (8 * tg) * 1024 + cp * 4);
        unsigned xr[2][8];
#pragma unroll
        for (int q = 0; q < 8; ++q) xr[0][q] = xp[q * 256];
#pragma unroll
        for (int c8 = 0; c8 < 5; ++c8) {
            if (c8 < 4) {
#pragma unroll
                for (int q = 0; q < 8; ++q) { const int ii = 8 * (c8 + 1) + q; if (ii < 38) xr[(c8 + 1) & 1][q] = xp[ii * 256]; }
            }
            __builtin_amdgcn_sched_barrier(0);
#pragma unroll
            for (int q = 0; q < 8; ++q) { const int ii = 8 * c8 + q; if (ii < 38) {
                const unsigned xv = xr[c8 & 1][q];
                const f32x2 x2 = {__uint_as_float(xv << 16), __uint_as_float(xv & 0xffff0000u)};
#pragma unroll
                for (int t = 0; t < 8; ++t) { const int j = ii - t; if (j >= 0 && j <= 30) res[t] += w[j] * x2; } } }
            __builtin_amdgcn_sched_barrier(0);
        }
        float v[16];
#pragma unroll
        for (int t = 0; t < 8; ++t) { v[2 * t] = res[t].x + res[t].y; v[2 * t + 1] = res[t].x * res[t].x + res[t].y * res[t].y; }
#pragma unroll
        for (int i = 0; i < 8; ++i) { const bool up = lane & 32; const float send = up ? v[i] : v[i + 8], keep = up ? v[i + 8] : v[i]; v[i] = keep + __shfl_xor(send, 32); }
#pragma unroll
        for (int i = 0; i < 4; ++i) { const bool up = lane & 16; const float send = up ? v[i] : v[i + 4], keep = up ? v[i + 4] : v[i]; v[i] = keep + __shfl_xor(send, 16); }
#pragma unroll
        for (int i = 0; i < 2; ++i) { const bool up = lane & 8; const float send = up ? v[i] : v[i + 2], keep = up ? v[i + 2] : v[i]; v[i] = keep + __shfl_xor(send, 8); }
        { const bool up = lane & 4; const float send = up ? v[0] : v[1], keep = up ? v[1] : v[0]; v[0] = keep + __shfl_xor(send, 4); }
        v[0] += __shfl_xor(v[0], 2); v[0] += __shfl_xor(v[0], 1);
        if ((lane & 3) == 0) { const int idx = ((lane >> 5) & 1) * 8 + ((lane >> 4) & 1) * 4 + ((lane >> 3) & 1) * 2 + ((lane >> 2) & 1);
            ST[((8 * tg + (idx >> 1)) * 4 + (wave & 3)) * 2 + (idx & 1)] = v[0]; }
        __syncthreads();
#pragma unroll
        for (int t = 0; t < 8; ++t) {
            const LAS f32x4* sp = (const LAS f32x4*)(ST + (8 * tg + t) * 8); const f32x4 a = sp[0], b = sp[1];
            const float mean = ((a[0] + a[2]) + (b[0] + b[2])) * (1.0f / 512.0f), ex2 = ((a[1] + a[3]) + (b[1] + b[3])) * (1.0f / 512.0f);
            const float rstd = __builtin_amdgcn_rsqf(fmaxf(ex2 - mean * mean, 0.f) + 1e-5f);
            const f32x2 y = (res[t] - mean) * rstd * lg + lb;
            *(unsigned*)(MIX + (size_t)(t0 + 8 * tg + t) * DM + 512 + 2 * cp) = cvt_pk_bf16(fast_silu(y.x), fast_silu(y.y));
        }
    }
    __syncthreads();
}

__device__ __forceinline__ void fix_edges(const Args& A, int gtid, int gthreads) {
    constexpr int ncols = DFF;
    const float* __restrict__ ge = (const float*)((unsigned char*)A.out + DO_GE); const float* __restrict__ ue = (const float*)((unsigned char*)A.out + DO_UE); bf16* __restrict__ act = (bf16*)(A.ws + WS_ACT);
    const int ng = ncols >> 2, total = 128 * 2 * ng;
    constexpr int NB_ = 2;
    for (int idx0 = gtid; idx0 < total; idx0 += NB_ * gthreads) {
        f32x4 pv[NB_], cur[NB_], nx[NB_], up[NB_], w0[NB_], w1[NB_], w2[NB_], bb[NB_]; int row[NB_], col[NB_]; bool ok[NB_];
        const f32x4 zero = {0.f, 0.f, 0.f, 0.f};
#pragma unroll
        for (int q = 0; q < NB_; ++q) {
            const int idx = idx0 + q * gthreads; ok[q] = idx < total; const int id = ok[q] ? idx : gtid;
            const int cg4 = id % ng, rw = id / ng, which = rw & 1, chunk = rw >> 1; col[q] = 4 * cg4;
            row[q] = 256 * chunk + (which ? 255 : 0); int s0, s1; seq_bounds(row[q], s0, s1);
            const float* gc = ge + (size_t)chunk * 4 * ncols + col[q];
            if (which == 0) { pv[q] = (row[q] == s0) ? zero : *(const f32x4*)(gc - ncols); cur[q] = *(const f32x4*)(gc); nx[q] = *(const f32x4*)(gc + ncols); up[q] = *(const f32x4*)(ue + ((size_t)chunk * 2) * ncols + col[q]); }
            else { pv[q] = *(const f32x4*)(gc + 2 * ncols); cur[q] = *(const f32x4*)(gc + 3 * ncols); nx[q] = (row[q] + 1 == s1) ? zero : *(const f32x4*)(gc + 4 * ncols); up[q] = *(const f32x4*)(ue + ((size_t)chunk * 2 + 1) * ncols + col[q]); }
            w0[q] = *(const f32x4*)(A.ffn_dw_w + col[q]); w1[q] = *(const f32x4*)(A.ffn_dw_w + DFF + col[q]); w2[q] = *(const f32x4*)(A.ffn_dw_w + 2 * DFF + col[q]); bb[q] = *(const f32x4*)(A.ffn_dw_b + col[q]);
        }
#pragma unroll
        for (int q = 0; q < NB_; ++q) {
            float o[4];
#pragma unroll
            for (int j = 0; j < 4; ++j) { const float cv = bb[q][j] + w0[q][j] * pv[q][j] + w1[q][j] * cur[q][j] + w2[q][j] * nx[q][j]; o[j] = fast_silu(cv) * up[q][j]; }
            uint2 w; w.x = cvt_pk_bf16(o[0], o[1]); w.y = cvt_pk_bf16(o[2], o[3]);
            if (ok[q]) *(uint2*)(act + (size_t)row[q] * ncols + col[q]) = w;
        }
    }
}

#define XB_TMO      128
#define XB_XCNT(j)  (256  + 64 * (j))
#define XB_XSUB(j)  (1280 + 64 * (j))
#define XB_XGEN(j)  (2304 + 64 * (j))
#define XB_TOP      3328
#define XB_TOPGEN   3392
#define XCD_BAR_WORDS 3456
#define XB_SPIN_CAP (1u << 18)

__device__ __forceinline__ unsigned xb_ld(unsigned* p)              { return __hip_atomic_load(p, __ATOMIC_RELAXED, __HIP_MEMORY_SCOPE_AGENT); }
__device__ __forceinline__ unsigned xb_add(unsigned* p, unsigned v) { return __hip_atomic_fetch_add(p, v, __ATOMIC_RELAXED, __HIP_MEMORY_SCOPE_AGENT); }
__device__ __forceinline__ unsigned xb_xcc_id() { return (unsigned)__builtin_amdgcn_s_getreg((3 << 11) | 20) & 0xFu; }
#define XB_SPIN(cond, bar) do { unsigned _sp = 0; while (cond) { __builtin_amdgcn_s_sleep(1); \
    if ((++_sp & 255u) == 0u) { if (xb_ld(&(bar)[XB_TMO])) break; if (_sp > XB_SPIN_CAP) { atomicAdd(&(bar)[XB_TMO], 1u); break; } } } } while (0)

struct XcdBarrier {
    unsigned* bar; unsigned x;
    volatile LAS unsigned* st;
};

__device__ __forceinline__ XcdBarrier xcd_barrier_post(unsigned* bar, volatile LAS unsigned* st) {
    XcdBarrier b; b.bar = bar; b.x = xb_xcc_id(); b.st = st;
    if (threadIdx.x == 0) (void)xb_add(&bar[XB_XCNT(b.x)], 1u);
    return b;
}
__device__ __forceinline__ void xcd_barrier_complete(unsigned* bar, unsigned x, unsigned& nloc, unsigned& nx) {
    const unsigned G = gridDim.x * gridDim.y * gridDim.z;
    unsigned sum, cnt, mine, sp = 0u;
    for (;;) {
        sum = 0u; cnt = 0u; mine = 0u;
#pragma unroll
        for (unsigned j = 0; j < 16; ++j) { const unsigned c = xb_ld(&bar[XB_XCNT(j)]); sum += c; cnt += (c > 0u) ? 1u : 0u; mine = (j == x) ? c : mine; }
        if (sum == G) break;
        __builtin_amdgcn_s_sleep(1);
        if ((++sp & 255u) == 0u) { if (xb_ld(&bar[XB_TMO])) break; if (sp > XB_SPIN_CAP) { atomicAdd(&bar[XB_TMO], 1u); break; } }
    }
    nloc = mine > 0u ? mine : 1u; nx = cnt > 0u ? cnt : 1u;
}

__device__ __forceinline__ void xcd_barrier(const XcdBarrier& b) {
    asm volatile("s_waitcnt vmcnt(0)" ::: "memory");
    __syncthreads();
    if (threadIdx.x == 0) {
        unsigned* bar = b.bar;
        __builtin_amdgcn_s_waitcnt(0);
        unsigned nloc = b.st[0], nx = b.st[1];
        if (nloc == 0u) { xcd_barrier_complete(bar, b.x, nloc, nx); b.st[0] = nloc; b.st[1] = nx; }
        const unsigned old = xb_add(&bar[XB_XSUB(b.x)], 1u);
        const unsigned gen = old / nloc;
        if (old + 1u == (gen + 1u) * nloc) {
            __builtin_amdgcn_fence(__ATOMIC_RELEASE, "agent");
            asm volatile("s_waitcnt vmcnt(0)" ::: "memory");
            const unsigned og = xb_add(&bar[XB_TOP], 1u);
            const unsigned tg = og / nx;
            if (og + 1u == (tg + 1u) * nx) xb_add(&bar[XB_TOPGEN], 1u);
            else XB_SPIN(xb_ld(&bar[XB_TOPGEN]) == tg, bar);
            __builtin_amdgcn_fence(__ATOMIC_ACQUIRE, "agent");
            xb_add(&bar[XB_XGEN(b.x)], 1u);
            asm volatile("s_waitcnt vmcnt(0)" ::: "memory");
        } else {
            XB_SPIN(xb_ld(&bar[XB_XGEN(b.x)]) == gen, bar);
            __builtin_amdgcn_fence(__ATOMIC_ACQUIRE, "agent");
            asm volatile("s_waitcnt vmcnt(0)" ::: "memory");
        }
    }
    __syncthreads();
}
__device__ __forceinline__ void skew_delay(int group, int ticks_per_group) {
    const unsigned long long t0 = __builtin_amdgcn_s_memrealtime(); const unsigned long long d = (unsigned long long)(group * ticks_per_group);
    while (__builtin_amdgcn_s_memrealtime() - t0 < d) __builtin_amdgcn_s_sleep(8);
}
#ifndef SKEW3
#define SKEW3 0
#endif
#ifndef SKEW5
#define SKEW5 0
#endif
__global__ void __launch_bounds__(NTHR, 2) hymba_fwd(Args A) {
    extern __shared__ __attribute__((aligned(16))) unsigned char lds_raw[];
    LAS unsigned char* lds = (LAS unsigned char*)lds_raw;
    cg::grid_group grid = cg::this_grid();
    const int tid = threadIdx.x, lane = tid & 63, wave = __builtin_amdgcn_readfirstlane(tid >> 6);
    const int G = gridDim.x, bx = blockIdx.x;
    const int gw = bx * NWAVES + wave, NGW = G * NWAVES;
    unsigned char* ws = A.ws; unsigned char* dob = (unsigned char*)A.out;
    const int lo = A.ph_lo, hi = A.ph_hi;
    volatile LAS unsigned* xb_st = (volatile LAS unsigned*)(lds + 131072 + 8192);
    if (tid < 4) xb_st[tid] = 0u;
    __syncthreads();
    const XcdBarrier xbar = xcd_barrier_post((unsigned*)(ws + WS_BAR), xb_st);
    if (lo > 1000) grid.sync();
#ifndef PMASK
#define PMASK 0x7f
#endif
#define IN(k) (((PMASK >> (k)) & 1) && lo <= (k) && (k) < hi)
#ifndef REPMASK
#define REPMASK 0
#endif
#ifndef XSYNC
#define XSYNC 0
#endif
#define REPS(k) (((REPMASK >> (k)) & 1) ? 2 : 1)
#define SEAM(k) do { if (IN(k) && IN((k) + 1)) { xcd_barrier(xbar); if ((k) == 0) for (int xs_ = 0; xs_ < XSYNC; ++xs_) xcd_barrier(xbar); } } while (0)
    if (IN(0)) for (int rep = 0; rep < REPS(0); ++rep) phase0(A, lds, gw, NGW, wave, lane, 0);
    SEAM(0);
    if (IN(1)) {
        pg8::Gemm g{(const pg8::bf16_t*)(ws + WS_H), (const pg8::bf16_t*)(ws + WS_WIN), M_TOK, 1792, 1024}; pg8::StaticOrder S; S.init(M_TOK, 1792, G, bx); S.rep = REPS(1);
        pg8::EpiInProj E{(pg8::bf16_t*)(ws + WS_Q), (pg8::bf16_t*)(ws + WS_K), (pg8::bf16_t*)(ws + WS_VT), (pg8::bf16_t*)(ws + WS_U), A.q_norm_g, A.k_norm_g};
        pg8::gemm_phase<pg8::EpiInProj, pg8::StaticOrder, true, true>(lds, g, S, E);
        { const int nfull = (896 % G) ? (896 % G) : G;
          if (nfull < G) { if (bx >= nfull) phase0(A, lds, (bx - nfull) * NWAVES + wave, (G - nfull) * NWAVES, wave, lane, 1); }
          else phase0(A, lds, gw, NGW, wave, lane, 1); }
    }
    float bound = 0.f;
    if (IN(2)) { const float gqm = wave_max(fabsf(A.q_norm_g[lane])), gkm = wave_max(fabsf(A.k_norm_g[lane])); bound = 8.0f * gqm * gkm; }
    SEAM(1);
    if (IN(2)) {
#ifndef NO_ATTN
        for (int it = bx; it < 512 * REPS(2); it += G) attn_item(A, lds, it & 511, tid, wave, lane, bound);
#endif
#ifndef NO_CONV
        {
            const int cp = tid & 255;
            f32x2 w[31];
#pragma unroll
            for (int j = 0; j < 31; ++j) { const float2 t = *(const float2*)(A.conv_dw_w + j * 512 + 2 * cp); w[j] = (f32x2){t.x, t.y}; }
            const float2 b_ = *(const float2*)(A.conv_dw_b + 2 * cp), g_ = *(const float2*)(A.conv_ln_g + 2 * cp), l_ = *(const float2*)(A.conv_ln_b + 2 * cp);
            const f32x2 bias = {b_.x, b_.y}, lg = {g_.x, g_.y}, lb = {l_.x, l_.y};
#pragma unroll 1
            for (int it = bx; it < 512 * REPS(7); it += G) conv_item(A, lds, it & 511, tid, wave, lane, w, bias, lg, lb);
        }
#endif
    }
    SEAM(2);
    if (IN(3)) {
        pg8::Gemm g{(const pg8::bf16_t*)(ws + WS_H), (const pg8::bf16_t*)(ws + WS_WO), M_TOK, 1024, 1024}; pg8::StaticOrder S; S.init(M_TOK, 1024, G, bx); S.rep = REPS(3);
        if (SKEW3) skew_delay((bx >> 3) & 3, SKEW3);
        pg8::EpiOutProj E{A.xp, A.xs, nullptr, (pg8::bf16_t*)(ws + WS_DELTA), (float*)(ws + WS_SSQ), (LAS float*)(lds + 131072)};
        pg8::gemm_phase<pg8::EpiOutProj, pg8::StaticOrder, true, true>(lds, g, S, E);
    }
    SEAM(3);
    if (IN(4)) {
        pg8::Gemm g{(const pg8::bf16_t*)(ws + WS_DELTA), (const pg8::bf16_t*)(dob + DO_WGU), M_TOK, 2 * DFF, 1024}; pg8::StaticOrder S; S.init(M_TOK, 2 * DFF, G, bx); S.rep = REPS(4);
        pg8::EpiGateUp E{(pg8::bf16_t*)(ws + WS_ACT), (float*)(dob + DO_GE), (float*)(dob + DO_UE), (const float*)(ws + WS_SSQ), A.ffn_dw_w, A.ffn_dw_b, (LAS float*)(lds + 131072)};
        pg8::gemm_phase<pg8::EpiGateUp, pg8::StaticOrder, true, true>(lds, g, S, E);
    }
    SEAM(4);
    if (IN(5)) for (int rep = 0; rep < REPS(5); ++rep) fix_edges(A, bx * NTHR + tid, G * NTHR);
    SEAM(5);
    if (IN(6)) {
        pg8::Gemm g{(const pg8::bf16_t*)(ws + WS_ACT), (const pg8::bf16_t*)(ws + WS_WD), M_TOK, 1024, DFF}; pg8::StaticOrder S; S.init(M_TOK, 1024, G, bx); S.rep = REPS(6);
        pg8::EpiDown E{A.xp, A.xs, (const pg8::bf16_t*)(ws + WS_DELTA), A.out};
        if (SKEW5) skew_delay((bx >> 3) & 3, SKEW5);
        pg8::gemm_phase<pg8::EpiDown, pg8::StaticOrder, true, true>(lds, g, S, E);
    }
#undef IN
#undef SEAM
}

#ifndef N_LAUNCH_PER_PHASE
#define N_LAUNCH_PER_PHASE 0
#endif
extern "C" void kernel_launch(void* const* d_in, const int* in_sizes, int n_in, void* d_out, int out_size, void* d_ws, size_t ws_size, hipStream_t stream) {
    static int grid = 0;
    if (grid == 0) {
        if (n_in != 18 || out_size != M_TOK * DM || ws_size < WS_END) { fprintf(stderr, "kernel_launch: unexpected shapes (n_in %d out %d ws %zu)\n", n_in, out_size, ws_size); grid = -1; return; }
        int dev = 0, cus = 0, per_cu = 0;
        hipGetDevice(&dev); hipDeviceGetAttribute(&cus, hipDeviceAttributeMultiprocessorCount, dev);
        if (hipFuncSetAttribute((const void*)hymba_fwd, hipFuncAttributeMaxDynamicSharedMemorySize, LDS_BYTES) != hipSuccess) { fprintf(stderr, "kernel_launch: hipFuncSetAttribute failed\n"); grid = -1; return; }
        if (hipOccupancyMaxActiveBlocksPerMultiprocessor(&per_cu, (const void*)hymba_fwd, NTHR, LDS_BYTES) != hipSuccess || per_cu < 1) { fprintf(stderr, "kernel_launch: occupancy query says %d\n", per_cu); per_cu = 1; }
        (void)hipGetLastError();
        grid = cus * 1;
    }
    if (grid < 0) return;
    if (hipMemsetAsync((char*)d_ws + WS_BAR, 0, BAR_BYTES, stream) != hipSuccess) { fprintf(stderr, "kernel_launch: memset failed\n"); return; }
    Args a{};
    const float** slots = (const float**)&a;
    for (int i = 0; i < 18; ++i) slots[i] = (const float*)d_in[i];
    a.out = (float*)d_out; a.ws = (unsigned char*)d_ws;
#if N_LAUNCH_PER_PHASE
    for (int p = 0; p < 7; ++p) { a.ph_lo = p; a.ph_hi = p + 1; hipLaunchKernelGGL(hymba_fwd, dim3(grid), dim3(NTHR), LDS_BYTES, stream, a); }
#else
    a.ph_lo = 0; a.ph_hi = 7;
    void* args[] = {&a};
    hipError_t e = hipLaunchCooperativeKernel((const void*)hymba_fwd, dim3(grid), dim3(NTHR), args, LDS_BYTES, stream);
    if (e != hipSuccess) fprintf(stderr, "cooperative launch failed: %s (grid %d)\n", hipGetErrorString(e), grid);
#endif
}
```

```cpp
#include <hip/hip_runtime.h>
#include <hip/hip_cooperative_groups.h>
#include <cstdio>
#include <cstdint>
namespace cg = cooperative_groups;
namespace pg8 {
#define PG8_LAS __attribute__((address_space(3)))
typedef unsigned short bf16_t;
typedef short bf16x8 __attribute__((ext_vector_type(8)));
typedef float f32x4 __attribute__((ext_vector_type(4)));
typedef unsigned u32x4 __attribute__((ext_vector_type(4)));
constexpr int BM = 256, BK = 64, HALF = 128, HTB = HALF * BK * 2  , STAGE_BYTES = 8 * HTB, NXCD = 8, WGM = 8;

__host__ __device__ __forceinline__ int lds_byte(int r, int c) { const int st = (r >> 4) * 2 + (c >> 5), rr = r & 15, cc = c & 31, ob = rr * 64 + cc * 2; return st * 1024 + (ob ^ (((ob >> 9) & 1) << 5)); }
__host__ __device__ __forceinline__ void stage_rc(int b, int& R, int& C) { const int st = b / 1024, sb = b % 1024, swz = sb ^ (((sb >> 9) & 1) << 5); R = (st >> 1) * 16 + swz / 64; C = (st & 1) * 32 + (swz % 64) / 2; }
__host__ __device__ __forceinline__ int perm32(int rho) { const int n = rho >> 4, i = rho & 15; return 8 * (i >> 2) + 4 * n + (i & 3); }

struct Unit { int pm, pn; };
struct Gemm { const bf16_t* A; const bf16_t* Bt; int M, N, K; };

struct StaticOrder {
    int nM, nN, nwg, G, c, rep = 1;
    __host__ __device__ void init(int M, int N, int G_, int c_) { nM = M / BM; nN = N / BM; nwg = nM * nN; G = G_; c = c_; }
    __host__ __device__ bool next(int i, Unit& u) const {
        const int rounds = (nwg - c + G - 1) / G; if (i >= rep * rounds) return false; const long L = (long)(i % rounds) * G + c;
        int wgid = (int)L; { const int q = nwg / NXCD, r = nwg % NXCD, xcd = wgid % NXCD, off = wgid / NXCD; wgid = (xcd < r ? xcd * (q + 1) : r * (q + 1) + (xcd - r) * q) + off; }
        const int nig = WGM * nN, gid = wgid / nig, fm = gid * WGM, gsz = (nM - fm) < WGM ? (nM - fm) : WGM;
        u.pm = fm + ((wgid % nig) % gsz); u.pn = (wgid % nig) / gsz; return true;
    }
    __device__ __forceinline__ void a_ready(const Unit&) const {}
    __device__ __forceinline__ void done(const Unit&) const {}
};

__device__ __forceinline__ unsigned cvt_pk_bf16(float lo, float hi) { unsigned r; asm volatile("v_cvt_pk_bf16_f32 %0, %1, %2" : "=v"(r) : "v"(lo), "v"(hi)); return r; }
typedef float f32x2 __attribute__((ext_vector_type(2)));
constexpr int M_TOK = 32768, DM = 1024, M_PROMPT = 16384, T_PROMPT = 2048, T_SAMPLE = 8192, DFF = 2816;
constexpr float LOG2E = 1.4426950408889634f;
constexpr float QSCALE = 0.125f * LOG2E;
__device__ __forceinline__ void seq_bounds(int row, int& s0, int& s1) {
    if (row < M_PROMPT) { s0 = row & ~(T_PROMPT - 1); s1 = s0 + T_PROMPT; }
    else { s0 = M_PROMPT + ((row - M_PROMPT) & ~(T_SAMPLE - 1)); s1 = s0 + T_SAMPLE; }
}
__device__ __forceinline__ float fast_sigmoid(float v) { return __builtin_amdgcn_rcpf(1.0f + __builtin_amdgcn_exp2f(-LOG2E * v)); }
__device__ __forceinline__ float fast_silu(float v) { return v * fast_sigmoid(v); }

struct EpiInProj {
    static constexpr bool PERM = true, AFTER_DRAIN = false, PREFETCH = false, TWICE = false, PRELOAD = false; struct Pre {};
    bf16_t* Q; bf16_t* Kb; bf16_t* VT; bf16_t* U; const float* gq; const float* gk;
    __device__ __forceinline__ void operator()(f32x4 (&acc)[2][2][4][2], const Unit& u, int wr, int wc, int fr, int fq) const {
        asm volatile("" : "+v"(fr), "+v"(fq));
        const int row0 = u.pm * BM + wr * 64 + fr;
        if (u.pn < 3) {
            const bool isq = u.pn < 2, isk = (u.pn == 2) && (wc < 2);
            if (isq || isk) {
                const float* g = isq ? gq : gk; const float sc = isq ? QSCALE : 1.0f;
                f32x4 gv[2][2];
#pragma unroll
                for (int bj = 0; bj < 2; ++bj)
#pragma unroll
                    for (int n = 0; n < 2; ++n) gv[bj][n] = *(const f32x4*)(g + 32 * bj + 8 * fq + 4 * n) * sc;
                bf16_t* dst = isq ? (Q + (size_t)(u.pn * 4 + wc) * 64) : (Kb + (size_t)wc * 64);
                const int pitch = isq ? 512 : 128;
#pragma unroll
                for (int ai = 0; ai < 2; ++ai)
#pragma unroll
                    for (int m = 0; m < 4; ++m) {
                        float s = 0.f;
#pragma unroll
                        for (int bj = 0; bj < 2; ++bj)
#pragma unroll
                            for (int n = 0; n < 2; ++n) { const f32x4 x = acc[ai][bj][m][n]; s += (x[0] * x[0] + x[1] * x[1]) + (x[2] * x[2] + x[3] * x[3]); }
                        s += __shfl_xor(s, 16); s += __shfl_xor(s, 32);
                        const float rs = __builtin_amdgcn_rsqf(s * (1.0f / 64.0f) + 1e-6f);
                        bf16_t* rowp = dst + (size_t)(row0 + ai * HALF + m * 16) * pitch + 8 * fq;
#pragma unroll
                        for (int bj = 0; bj < 2; ++bj) {
                            const f32x4 v0 = acc[ai][bj][m][0] * rs * gv[bj][0], v1 = acc[ai][bj][m][1] * rs * gv[bj][1];
                            u32x4 w; w.x = cvt_pk_bf16(v0[0], v0[1]); w.y = cvt_pk_bf16(v0[2], v0[3]); w.z = cvt_pk_bf16(v1[0], v1[1]); w.w = cvt_pk_bf16(v1[2], v1[3]);
                            *(u32x4*)(rowp + 32 * bj) = w;
                        }
                    }
            } else {
                bf16_t* vt = VT + (size_t)(wc - 2) * 64 * M_TOK;
#pragma unroll
                for (int ai = 0; ai < 2; ++ai)
#pragma unroll
                    for (int m = 0; m < 4; ++m) {
                        const int row = row0 + ai * HALF + m * 16;
#pragma unroll
                        for (int bj = 0; bj < 2; ++bj)
#pragma unroll
                            for (int n = 0; n < 2; ++n) {
                                const f32x4 x = acc[ai][bj][m][n]; const int d0 = 32 * bj + 8 * fq + 4 * n;
                                const unsigned p01 = cvt_pk_bf16(x[0], x[1]), p23 = cvt_pk_bf16(x[2], x[3]);
                                vt[(size_t)(d0 + 0) * M_TOK + row] = (bf16_t)(p01 & 0xffffu); vt[(size_t)(d0 + 1) * M_TOK + row] = (bf16_t)(p01 >> 16);
                                vt[(size_t)(d0 + 2) * M_TOK + row] = (bf16_t)(p23 & 0xffffu); vt[(size_t)(d0 + 3) * M_TOK + row] = (bf16_t)(p23 >> 16);
                            }
                    }
            }
        } else {
            bf16_t* dst = U + (size_t)(u.pn - 3) * 128 + 32 * wc + 8 * fq;
#pragma unroll
            for (int ai = 0; ai < 2; ++ai)
#pragma unroll
                for (int m = 0; m < 4; ++m) {
                    f32x4 o[2];
#pragma unroll
                    for (int n = 0; n < 2; ++n) { const f32x4 a = acc[ai][0][m][n], g = acc[ai][1][m][n];
#pragma unroll
                        for (int j = 0; j < 4; ++j) o[n][j] = a[j] * fast_sigmoid(g[j]); }
                    u32x4 w; w.x = cvt_pk_bf16(o[0][0], o[0][1]); w.y = cvt_pk_bf16(o[0][2], o[0][3]); w.z = cvt_pk_bf16(o[1][0], o[1][1]); w.w = cvt_pk_bf16(o[1][2], o[1][3]);
                    *(u32x4*)(dst + (size_t)(row0 + ai * HALF + m * 16) * 512) = w;
                }
        }
    }
};

struct EpiOutProj {
    static constexpr bool PERM = true, AFTER_DRAIN = false, PREFETCH = false, TWICE = false, PRELOAD = false; struct Pre {};
    __device__ __forceinline__ void prefetch(const Unit& u, PG8_LAS unsigned char* lds) const {
        const int t = threadIdx.x; const float* xb = (u.pm * BM < M_PROMPT) ? xp : (xs - (size_t)M_PROMPT * DM);
        PG8_LAS unsigned* dummy = (PG8_LAS unsigned*)(lds + 131072 + 4096 + (t >> 6) * 256);
#pragma unroll
        for (int i = 0; i < 4; ++i) { const int L = t + 512 * i; __builtin_amdgcn_global_load_lds((const unsigned*)(xb + (size_t)(u.pm * BM + (L >> 3)) * DM + u.pn * BM + (L & 7) * 32), dummy, 4, 0, 0); }
    }
    const float* xp; const float* xs; bf16_t* delta; bf16_t* x1b; float* ssq; PG8_LAS float* red;
    __device__ __forceinline__ void operator()(f32x4 (&acc)[2][2][4][2], const Unit& u, int wr, int wc, int fr, int fq) const {
        asm volatile("" : "+v"(fr), "+v"(fq));
        const int row0 = u.pm * BM + wr * 64 + fr, col0 = u.pn * BM + wc * 32 + 8 * fq;
        const float* xb = (u.pm * BM < M_PROMPT) ? xp : (xs - (size_t)M_PROMPT * DM);
#pragma unroll
        for (int ai = 0; ai < 2; ++ai)
#pragma unroll
            for (int mh = 0; mh < 2; ++mh) {
                f32x4 xv[2][2][2];
#pragma unroll
                for (int mm = 0; mm < 2; ++mm)
#pragma unroll
                    for (int bj = 0; bj < 2; ++bj) { const float* p = xb + (size_t)(row0 + ai * HALF + (2 * mh + mm) * 16) * DM + col0 + bj * HALF; xv[mm][bj][0] = __builtin_nontemporal_load((const f32x4*)p); xv[mm][bj][1] = __builtin_nontemporal_load((const f32x4*)(p + 4)); }
                __builtin_amdgcn_sched_barrier(0);
#pragma unroll
                for (int mm = 0; mm < 2; ++mm) {
                    const int m = 2 * mh + mm; const int row = row0 + ai * HALF + m * 16; const size_t ro = (size_t)row * DM + col0; float s = 0.f;
#pragma unroll
                    for (int bj = 0; bj < 2; ++bj) {
                        const f32x4 a0 = acc[ai][bj][m][0], a1 = acc[ai][bj][m][1];
                        const f32x4 v0 = a0 + xv[mm][bj][0], v1 = a1 + xv[mm][bj][1];
                        s += ((v0[0] * v0[0] + v0[1] * v0[1]) + (v0[2] * v0[2] + v0[3] * v0[3])) + ((v1[0] * v1[0] + v1[1] * v1[1]) + (v1[2] * v1[2] + v1[3] * v1[3]));
                        u32x4 y; y.x = cvt_pk_bf16(v0[0], v0[1]); y.y = cvt_pk_bf16(v0[2], v0[3]); y.z = cvt_pk_bf16(v1[0], v1[1]); y.w = cvt_pk_bf16(v1[2], v1[3]);
                        *(u32x4*)(x1b + ro + bj * HALF) = y;
                    }
                    s += __shfl_xor(s, 16); s += __shfl_xor(s, 32);
                    if (fq == 0) red[(ai * HALF + wr * 64 + m * 16 + fr) * 4 + wc] = s;
                }
                __builtin_amdgcn_sched_barrier(0);
            }
        __syncthreads();
        const int t = threadIdx.x;
        if (t < 256) { const f32x4 v = *(const PG8_LAS f32x4*)(red + t * 4); ssq[(size_t)(u.pm * BM + t) * 4 + u.pn] = (v[0] + v[1]) + (v[2] + v[3]); }
    }
};

template <int CTRL> __device__ __forceinline__ float dpp_row(float v) { return __builtin_bit_cast(float, __builtin_amdgcn_update_dpp(0, __builtin_bit_cast(int, v), CTRL, 0xF, 0xF, false)); }
struct EpiGateUp {
    static constexpr bool PERM = true, AFTER_DRAIN = false, PREFETCH = false, TWICE = false, PRELOAD = true; struct Pre { f32x4 s[2]; };
    bf16_t* act; float* ge; float* ue; const float* ssq; const float* cw; const float* cb; PG8_LAS float* xch; int second = 0;
    static constexpr int ncols = DFF, chbase = 0;
    __device__ __forceinline__ void preload(const Unit& u, int wr, int wc, int lane, Pre& pre) const {
#pragma unroll
        for (int ai = 0; ai < 2; ++ai) pre.s[ai] = *(const f32x4*)(ssq + (size_t)(u.pm * BM + ai * HALF + wr * 64 + lane) * 4);
        const int wid = wr * 4 + wc, j = wid >> 1, half = wid & 1;
        const float* src = (j < 3 ? cw + (size_t)j * DFF : cb) + chbase + u.pn * 128 + half * 64 + lane;
        __builtin_amdgcn_global_load_lds((const unsigned*)src, (PG8_LAS unsigned*)(xch + 1024 + j * 128 + half * 64), 4, 0, 0);
    }
    __device__ __forceinline__ void operator()(f32x4 (&acc)[2][2][4][2], const Unit& u, int wr, int wc, int fr, int fq, const Pre& pre) const {
        asm volatile("" : "+v"(fr), "+v"(fq));
        const int lane = fr + 16 * fq, wid = wr * 4 + wc;
        const int ch0 = u.pn * 128 + 32 * wc + 8 * fq;
        const int lprev = (lane & 48) | ((fr + 15) & 15), lnext = (lane & 48) | ((fr + 1) & 15);
#pragma unroll
        for (int ai = 0; ai < 2; ++ai) {
            const int crow0 = u.pm * BM + ai * HALF + wr * 64;
            const float rs_own = __builtin_amdgcn_rsqf(((pre.s[ai][0] + pre.s[ai][1]) + (pre.s[ai][2] + pre.s[ai][3])) * (1.0f / 1024.0f) + 1e-6f);
#pragma unroll
            for (int m = 0; m < 4; ++m) {
                const float rstd = second ? 1.0f : __shfl(rs_own, 16 * m + fr);
                const float rsu = second ? 1.0f : rstd * (-0.6931471805599453f);
#pragma unroll
                for (int n = 0; n < 2; ++n) { acc[ai][0][m][n] *= rstd; acc[ai][1][m][n] *= rsu; }
            }
            if (fr == 0)  { PG8_LAS float* p = xch + (((wid * 2 + ai) * 2 + 0) * 4 + fq) * 8; *(PG8_LAS f32x4*)p = acc[ai][0][0][0]; *(PG8_LAS f32x4*)(p + 4) = acc[ai][0][0][1]; }
            if (fr == 15) { PG8_LAS float* p = xch + (((wid * 2 + ai) * 2 + 1) * 4 + fq) * 8; *(PG8_LAS f32x4*)p = acc[ai][0][3][0]; *(PG8_LAS f32x4*)(p + 4) = acc[ai][0][3][1]; }
            const int q = 2 * ai + wr;
            if (q == 0 && fr < 2) {
                float* g = ge + ((size_t)u.pm * 4 + fr) * ncols + ch0;
                *(f32x4*)g = acc[ai][0][0][0]; *(f32x4*)(g + 4) = acc[ai][0][0][1];
                if (fr == 0) { float* p = ue + ((size_t)u.pm * 2) * ncols + ch0; *(f32x4*)p = acc[ai][1][0][0] * (-LOG2E); *(f32x4*)(p + 4) = acc[ai][1][0][1] * (-LOG2E); }
            }
            if (q == 3 && fr >= 14) {
                float* g = ge + ((size_t)u.pm * 4 + (fr - 12)) * ncols + ch0;
                *(f32x4*)g = acc[ai][0][3][0]; *(f32x4*)(g + 4) = acc[ai][0][3][1];
                if (fr == 15) { float* p = ue + ((size_t)u.pm * 2 + 1) * ncols + ch0; *(f32x4*)p = acc[ai][1][3][0] * (-LOG2E); *(f32x4*)(p + 4) = acc[ai][1][3][1] * (-LOG2E); }
            }
        }
        if (wid == 0) { PG8_LAS f32x4* wp = (PG8_LAS f32x4*)(xch + 1024) + lane; wp[0] = wp[0] * (-LOG2E); wp[64] = wp[64] * (-LOG2E); }
        __syncthreads();
#pragma unroll
        for (int ai = 0; ai < 2; ++ai) {
            const int crow0 = u.pm * BM + ai * HALF + wr * 64;
            const int q = 2 * ai + wr, qp = (q + 3) & 3, qn = (q + 1) & 3;
            unsigned pk[2][4][2];
#pragma unroll
            for (int n = 0; n < 2; ++n) {
                const PG8_LAS float* wl = xch + 1024 + 32 * wc + 8 * fq + 4 * n;
                const f32x4 w0 = *(const PG8_LAS f32x4*)(wl), w1 = *(const PG8_LAS f32x4*)(wl + 128), w2 = *(const PG8_LAS f32x4*)(wl + 256), bb = *(const PG8_LAS f32x4*)(wl + 384);
                const f32x4 pvx = *(const PG8_LAS f32x4*)(xch + (((((qp & 1) * 4 + wc) * 2 + (qp >> 1)) * 2 + 1) * 4 + fq) * 8 + 4 * n);
                const f32x4 nxx = *(const PG8_LAS f32x4*)(xch + (((((qn & 1) * 4 + wc) * 2 + (qn >> 1)) * 2 + 0) * 4 + fq) * 8 + 4 * n);
#pragma unroll
                for (int jp = 0; jp < 2; ++jp) {
                    const f32x2 w0p = {w0[2 * jp], w0[2 * jp + 1]}, w1p = {w1[2 * jp], w1[2 * jp + 1]}, w2p = {w2[2 * jp], w2[2 * jp + 1]}, bbp = {bb[2 * jp], bb[2 * jp + 1]};
                    f32x2 g[4], R[4], L[4];
#pragma unroll
                    for (int m = 0; m < 4; ++m) { g[m] = (f32x2){acc[ai][0][m][n][2 * jp], acc[ai][0][m][n][2 * jp + 1]};
                        R[m] = (f32x2){dpp_row<0x121>(g[m].x), dpp_row<0x121>(g[m].y)}; L[m] = (f32x2){dpp_row<0x12F>(g[m].x), dpp_row<0x12F>(g[m].y)}; }
                    const f32x2 pvx2 = {pvx[2 * jp], pvx[2 * jp + 1]}, nxx2 = {nxx[2 * jp], nxx[2 * jp + 1]};
#pragma unroll
                    for (int m = 0; m < 4; ++m) {
                        const f32x2 pv = (fr == 0) ? (m > 0 ? R[m > 0 ? m - 1 : 0] : pvx2) : R[m];
                        const f32x2 nx = (fr == 15) ? (m < 3 ? L[m < 3 ? m + 1 : 3] : nxx2) : L[m];
                        const f32x2 cvs = bbp + w0p * pv + w1p * g[m] + w2p * nx;
                        f32x2 d = {__builtin_amdgcn_exp2f(cvs.x), __builtin_amdgcn_exp2f(cvs.y)}; d = d + 1.0f;
                        const f32x2 r = {__builtin_amdgcn_rcpf(d.x), __builtin_amdgcn_rcpf(d.y)};
                        const f32x2 upv = {acc[ai][1][m][n][2 * jp], acc[ai][1][m][n][2 * jp + 1]};
                        const f32x2 o = (cvs * r) * upv;
                        pk[n][m][jp] = cvt_pk_bf16(o.x, o.y);
                    }
                }
                __builtin_amdgcn_sched_barrier(0);
            }
#pragma unroll
            for (int m = 0; m < 4; ++m) {
                const bool edge = (q == 0 && m == 0 && fr == 0) || (q == 3 && m == 3 && fr == 15);
                if (!edge) { u32x4 w; w.x = pk[0][m][0]; w.y = pk[0][m][1]; w.z = pk[1][m][0]; w.w = pk[1][m][1];
                    *(u32x4*)(act + (size_t)(crow0 + m * 16 + fr) * ncols + ch0) = w; }
            }
        }
    }
};

struct EpiDown {
    static constexpr bool PERM = true, AFTER_DRAIN = false, PREFETCH = false, TWICE = false, PRELOAD = false; struct Pre {};
    __device__ __forceinline__ void prefetch(const Unit& u, PG8_LAS unsigned char* lds) const {
        const int t = threadIdx.x; const float* xb = (u.pm * BM < M_PROMPT) ? xp : (xs - (size_t)M_PROMPT * DM);
        PG8_LAS unsigned* dummy = (PG8_LAS unsigned*)(lds + 131072 + 4096 + (t >> 6) * 256);
#pragma unroll
        for (int i = 0; i < 4; ++i) { const int L = t + 512 * i; __builtin_amdgcn_global_load_lds((const unsigned*)(xb + (size_t)(u.pm * BM + (L >> 3)) * DM + u.pn * BM + (L & 7) * 32), dummy, 4, 0, 0); }
#pragma unroll
        for (int i = 0; i < 2; ++i) { const int L = t + 512 * i; __builtin_amdgcn_global_load_lds((const unsigned*)(delta + (size_t)(u.pm * BM + (L >> 2)) * DM + u.pn * BM + (L & 3) * 64), dummy, 4, 0, 0); }
    }
    const float* xp; const float* xs; const bf16_t* delta; float* out; int second = 0;
    __device__ __forceinline__ void operator()(f32x4 (&acc)[2][2][4][2], const Unit& u, int wr, int wc, int fr, int fq) const {
        asm volatile("" : "+v"(fr), "+v"(fq));
        const int row0 = u.pm * BM + wr * 64 + fr, col0 = u.pn * BM + wc * 32 + 8 * fq;
        const float* xb = (u.pm * BM < M_PROMPT) ? xp : (xs - (size_t)M_PROMPT * DM);
        u32x4 dv[2][4][2];
#pragma unroll
        for (int ai = 0; ai < 2; ++ai)
#pragma unroll
            for (int m = 0; m < 4; ++m)
#pragma unroll
                for (int bj = 0; bj < 2; ++bj) dv[ai][m][bj] = __builtin_nontemporal_load((const u32x4*)(delta + (size_t)(row0 + ai * HALF + m * 16) * DM + col0 + bj * HALF));
        __builtin_amdgcn_sched_barrier(0);
#pragma unroll
        for (int ai = 0; ai < 2; ++ai)
#pragma unroll
            for (int m = 0; m < 4; ++m)
#pragma unroll
                for (int bj = 0; bj < 2; ++bj) { const size_t ro = (size_t)(row0 + ai * HALF + m * 16) * DM + col0 + bj * HALF;
                    const u32x4 d = dv[ai][m][bj]; f32x4 d0, d1;
                    d0[0] = __uint_as_float(d.x << 16); d0[1] = __uint_as_float(d.x & 0xffff0000u); d0[2] = __uint_as_float(d.y << 16); d0[3] = __uint_as_float(d.y & 0xffff0000u);
                    d1[0] = __uint_as_float(d.z << 16); d1[1] = __uint_as_float(d.z & 0xffff0000u); d1[2] = __uint_as_float(d.w << 16); d1[3] = __uint_as_float(d.w & 0xffff0000u);
                    *(f32x4*)(out + ro) = d0 + acc[ai][bj][m][0];
                    *(f32x4*)(out + ro + 4) = d1 + acc[ai][bj][m][1];
                }
    }
};
template <class Epi, class Sched, bool ALIGN_EPI = false, bool SP2 = false>
__device__ __forceinline__ void gemm_phase(PG8_LAS unsigned char* lds, const Gemm g, const Sched& S, const Epi& E) {
    const int tid = threadIdx.x, wid = __builtin_amdgcn_readfirstlane(tid >> 6), lane = tid & 63, wr = wid >> 2, wc = wid & 3, fr = lane & 15, fq = lane >> 4;
    const int K = g.K, nt = K / BK;
    unsigned voffA[2], voffB[2];
#pragma unroll
    for (int i = 0; i < 2; ++i) { int R, C; stage_rc(tid * 16 + i * 8192, R, C); const int Rb = Epi::PERM ? ((R & ~31) + perm32(R & 31)) : R;
        voffA[i] = (unsigned)(R * K + C) * 2u; voffB[i] = (unsigned)(Rb * K + C) * 2u; }
    const size_t kstep = (size_t)(BK * 2);
    const size_t hstep = (size_t)HALF * K * 2;
    const size_t tstep = 2 * hstep;
    const unsigned ldsw = (unsigned)wid * 1024u;
    const int aoff = lds_byte(wr * 64 + fr, fq * 8), boff = lds_byte(wc * 32 + fr, fq * 8);
#define PG8_SA(b, h) (((b) * 2 + (h)) * HTB)
#define PG8_SB(b, h) ((4 + (b) * 2 + (h)) * HTB)
#define PG8_STAGE(bufoff, gbase, voff) do { _Pragma("unroll") for (int _i = 0; _i < 2; ++_i) \
        __builtin_amdgcn_global_load_lds((const unsigned*)((const char*)(gbase) + (voff)[_i]), (PG8_LAS unsigned*)(lds + (bufoff) + ldsw + _i * 8192), 16, 0, 0); } while (0)
#define PG8_LDA(dst, b, h) do { _Pragma("unroll") for (int m = 0; m < 4; ++m) _Pragma("unroll") for (int k = 0; k < 2; ++k) dst[m][k] = *(const PG8_LAS bf16x8*)(lds + PG8_SA(b, h) + aoff + m * 2048 + k * 1024); } while (0)
#define PG8_LDB(dst, b, h) do { _Pragma("unroll") for (int n = 0; n < 2; ++n) _Pragma("unroll") for (int k = 0; k < 2; ++k) dst[n][k] = *(const PG8_LAS bf16x8*)(lds + PG8_SB(b, h) + boff + n * 2048 + k * 1024); } while (0)
#define PG8_MMA(ai, bj, At, Bt) do { __builtin_amdgcn_s_setprio(1); _Pragma("unroll") for (int m = 0; m < 4; ++m) _Pragma("unroll") for (int n = 0; n < 2; ++n) _Pragma("unroll") for (int k = 0; k < 2; ++k) \
        acc[ai][bj][m][n] = __builtin_amdgcn_mfma_f32_16x16x32_bf16(Bt[n][k], At[m][k], acc[ai][bj][m][n], 0, 0, 0); __builtin_amdgcn_s_setprio(0); } while (0)
#define PG8_WAIT_V(n) asm volatile("s_waitcnt vmcnt(" #n ")" ::: "memory")
#define PG8_WAIT_L(n) asm volatile("s_waitcnt lgkmcnt(" #n ")" ::: "memory")
#define PG8_BAR __builtin_amdgcn_s_barrier()
#define PG8_SCHED __builtin_amdgcn_sched_barrier(0)
    Unit cur, nxt; int ui = 0;
    typename Epi::Pre pre;
    if (!S.next(0, cur)) return;
    f32x4 acc[2][2][4][2];
#pragma unroll
    for (int a = 0; a < 2; ++a)
#pragma unroll
        for (int b = 0; b < 2; ++b)
#pragma unroll
            for (int m = 0; m < 4; ++m)
#pragma unroll
                for (int n = 0; n < 2; ++n) acc[a][b][m][n] = (f32x4){0.f, 0.f, 0.f, 0.f};
    bf16x8 At[4][2], B0[2][2], B1[2][2];
    const char* cA = (const char*)g.A + (size_t)cur.pm * tstep; const char* cB = (const char*)g.Bt + (size_t)cur.pn * tstep;
    S.a_ready(cur);
    if constexpr (Epi::PREFETCH) E.prefetch(cur, lds);
    if constexpr (SP2) {
        PG8_STAGE(PG8_SB(0, 0), cB, voffB); PG8_STAGE(PG8_SB(0, 1), cB + hstep, voffB); PG8_STAGE(PG8_SA(0, 0), cA, voffA); PG8_STAGE(PG8_SA(0, 1), cA + hstep, voffA);
        if (wr == 1) PG8_BAR;
        PG8_WAIT_V(2); PG8_BAR;
        PG8_STAGE(PG8_SB(1, 0), cB + kstep, voffB); PG8_STAGE(PG8_SA(1, 0), cA + kstep, voffA); PG8_STAGE(PG8_SB(1, 1), cB + hstep + kstep, voffB);
        PG8_WAIT_V(6); PG8_BAR;
    } else {
        PG8_STAGE(PG8_SB(0, 0), cB, voffB); PG8_STAGE(PG8_SA(0, 0), cA, voffA); PG8_STAGE(PG8_SB(0, 1), cB + hstep, voffB); PG8_STAGE(PG8_SA(0, 1), cA + hstep, voffA);
        if (wr == 1) PG8_BAR;
        PG8_WAIT_V(4); PG8_BAR;
        PG8_STAGE(PG8_SB(1, 0), cB + kstep, voffB); PG8_STAGE(PG8_SA(1, 0), cA + kstep, voffA); PG8_STAGE(PG8_SB(1, 1), cB + hstep + kstep, voffB);
        PG8_WAIT_V(6); PG8_BAR;
    }
    for (;;) {
        const bool has_next = S.next(ui + 1, nxt);
        const char* nA = has_next ? (const char*)g.A + (size_t)nxt.pm * tstep : cA; const char* nB = has_next ? (const char*)g.Bt + (size_t)nxt.pn * tstep : cB;
        for (int t = 0; t < nt; t += 2) {
            const bool last = (t == nt - 2);
            const char* a1 = cA + (size_t)(t + 1) * kstep;
            const char* a2 = last ? nA : cA + (size_t)(t + 2) * kstep; const char* b2 = last ? nB : cB + (size_t)(t + 2) * kstep;
            const char* a3 = a2 + kstep; const char* b3 = b2 + kstep;
            if (last && has_next) S.a_ready(nxt);
            if constexpr (Epi::PRELOAD) { if (last) E.preload(cur, wr, wc, lane, pre); }
            if constexpr (SP2) {
            PG8_LDB(B0, 0, 0); PG8_LDB(B1, 0, 1); PG8_SCHED; PG8_LDA(At, 0, 0); PG8_STAGE(PG8_SA(1, 1), a1 + hstep, voffA);
            PG8_WAIT_V(8); PG8_WAIT_L(0); PG8_BAR; PG8_MMA(0, 0, At, B0); PG8_MMA(0, 1, At, B1); PG8_BAR; PG8_SCHED;
            PG8_LDA(At, 0, 1); PG8_STAGE(PG8_SB(0, 0), b2, voffB); PG8_STAGE(PG8_SB(0, 1), b2 + hstep, voffB); PG8_STAGE(PG8_SA(0, 0), a2, voffA);
            PG8_WAIT_V(8); PG8_WAIT_L(0); PG8_BAR; PG8_MMA(1, 0, At, B0); PG8_MMA(1, 1, At, B1); PG8_BAR; PG8_SCHED;
            PG8_LDB(B0, 1, 0); PG8_LDB(B1, 1, 1); PG8_SCHED; PG8_LDA(At, 1, 0); PG8_STAGE(PG8_SA(0, 1), a2 + hstep, voffA);
            PG8_WAIT_V(8); PG8_WAIT_L(0); PG8_BAR; PG8_MMA(0, 0, At, B0); PG8_MMA(0, 1, At, B1); PG8_BAR; PG8_SCHED;
            PG8_LDA(At, 1, 1); PG8_STAGE(PG8_SB(1, 0), b3, voffB); PG8_STAGE(PG8_SB(1, 1), b3 + hstep, voffB); PG8_STAGE(PG8_SA(1, 0), a3, voffA);
            PG8_WAIT_V(8); PG8_WAIT_L(0); PG8_BAR; PG8_MMA(1, 0, At, B0); PG8_MMA(1, 1, At, B1); PG8_BAR; PG8_SCHED;
            } else {
            PG8_LDB(B0, 0, 0); PG8_SCHED; PG8_LDA(At, 0, 0); PG8_STAGE(PG8_SA(1, 1), a1 + hstep, voffA);
            PG8_WAIT_L(8); PG8_BAR; PG8_WAIT_L(0); PG8_MMA(0, 0, At, B0); PG8_BAR; PG8_SCHED;
            PG8_LDB(B1, 0, 1); PG8_STAGE(PG8_SB(0, 0), b2, voffB);
            PG8_BAR; PG8_WAIT_L(0); PG8_MMA(0, 1, At, B1); PG8_BAR;
            PG8_LDA(At, 0, 1); PG8_STAGE(PG8_SA(0, 0), a2, voffA);
            PG8_BAR; PG8_WAIT_L(0); PG8_MMA(1, 0, At, B0); PG8_BAR; PG8_SCHED;
            PG8_STAGE(PG8_SB(0, 1), b2 + hstep, voffB);
            PG8_WAIT_V(6); PG8_BAR; PG8_MMA(1, 1, At, B1); PG8_BAR;
            PG8_LDB(B0, 1, 0); PG8_SCHED; PG8_LDA(At, 1, 0); PG8_STAGE(PG8_SA(0, 1), a2 + hstep, voffA);
            PG8_WAIT_L(8); PG8_BAR; PG8_WAIT_L(0); PG8_MMA(0, 0, At, B0); PG8_BAR; PG8_SCHED;
            PG8_LDB(B1, 1, 1); PG8_STAGE(PG8_SB(1, 0), b3, voffB);
            PG8_BAR; PG8_WAIT_L(0); PG8_MMA(0, 1, At, B1); PG8_BAR;
            PG8_LDA(At, 1, 1); PG8_STAGE(PG8_SA(1, 0), a3, voffA);
            PG8_BAR; PG8_WAIT_L(0); PG8_MMA(1, 0, At, B0); PG8_BAR; PG8_SCHED;
            PG8_STAGE(PG8_SB(1, 1), b3 + hstep, voffB);
            PG8_WAIT_V(6); PG8_BAR; PG8_MMA(1, 1, At, B1); PG8_BAR;
            }
        }
        if constexpr (ALIGN_EPI) { if (wr == 0) PG8_BAR; }
        if constexpr (!Epi::AFTER_DRAIN) { if constexpr (Epi::PRELOAD) E(acc, cur, wr, wc, fr, fq, pre); else E(acc, cur, wr, wc, fr, fq); S.done(cur); }
#ifdef EPI2X
        if constexpr (Epi::TWICE) { Epi E2 = E; E2.second = 1; E2(acc, cur, wr, wc, fr, fq); }
#endif
        if (!has_next) break;
#pragma unroll
        for (int a = 0; a < 2; ++a)
#pragma unroll
            for (int b = 0; b < 2; ++b)
#pragma unroll
                for (int m = 0; m < 4; ++m)
#pragma unroll
                    for (int n = 0; n < 2; ++n) acc[a][b][m][n] = (f32x4){0.f, 0.f, 0.f, 0.f};
        cur = nxt; cA = nA; cB = nB; ++ui;
        if constexpr (Epi::PREFETCH) E.prefetch(cur, lds);
        if constexpr (ALIGN_EPI) { if (wr == 1) PG8_BAR; }
    }
    PG8_WAIT_V(0);
    if constexpr (!ALIGN_EPI) { if (wr == 0) PG8_BAR; }
    PG8_BAR;
    if constexpr (Epi::AFTER_DRAIN) { E.fused(acc, cur, wr, wc, fr, fq, lds, wid, lane); S.done(cur); }
#undef PG8_SA
#undef PG8_SB
#undef PG8_STAGE
#undef PG8_LDA
#undef PG8_LDB
#undef PG8_MMA
#undef PG8_WAIT_V
#undef PG8_WAIT_L
#undef PG8_BAR
#undef PG8_SCHED
}
}
#define LAS __attribute__((address_space(3)))
typedef unsigned short bf16;
typedef unsigned v4u __attribute__((ext_vector_type(4)));
typedef unsigned v2u __attribute__((ext_vector_type(2)));
typedef float f32x4 __attribute__((ext_vector_type(4)));
typedef float f32x16 __attribute__((ext_vector_type(16)));
typedef short bf16x8 __attribute__((ext_vector_type(8)));
typedef short s16x4 __attribute__((ext_vector_type(4)));
using pg8::cvt_pk_bf16; using pg8::M_TOK; using pg8::DM; using pg8::M_PROMPT; using pg8::DFF; using pg8::LOG2E; using pg8::seq_bounds; using pg8::fast_silu; using pg8::fast_sigmoid;
constexpr int NWAVES = 8, NTHR = 512;
constexpr int LDS_BYTES = 147456;
constexpr size_t MiB = 1u << 20;
constexpr size_t WS_WIN = 0, WS_WO = 4 * MiB, WS_WD = 6 * MiB, WS_SSQ = 12 * MiB, WS_BAR = 12 * MiB + 512 * 1024, BAR_BYTES = 16384;
constexpr size_t WS_H = 16 * MiB;
constexpr size_t WS_Q = 80 * MiB, WS_K = 112 * MiB, WS_VT = 120 * MiB, WS_U = 128 * MiB;
constexpr size_t WS_ACT = 16 * MiB;
constexpr size_t WS_DELTA = 192 * MiB, WS_END = 256 * MiB;
constexpr size_t DO_X1B = 0, DO_WGU = 64 * MiB, DO_GE = 76 * MiB, DO_UE = 99 * MiB;

__device__ __forceinline__ float wave_sum(float v) {
#pragma unroll
    for (int o = 1; o < 64; o <<= 1) v += __shfl_xor(v, o);
    return v;
}
__device__ __forceinline__ float wave_max(float v) {
#pragma unroll
    for (int o = 1; o < 64; o <<= 1) v = fmaxf(v, __shfl_xor(v, o));
    return v;
}
__device__ __forceinline__ void transpose_item(const float* W, int N, int k0, int n0, bf16* dst, int dpitch, const float* kscale, LAS float* scr, int lane) {
    float wv[32];
#pragma unroll
    for (int i = 0; i < 32; ++i) { const int kk = 2 * i + (lane >> 5); wv[i] = W[(size_t)(k0 + kk) * N + n0 + (lane & 31)]; }
    if (kscale) {
        float ks[32];
#pragma unroll
        for (int i = 0; i < 32; ++i) ks[i] = kscale[k0 + 2 * i + (lane >> 5)];
#pragma unroll
        for (int i = 0; i < 32; ++i) wv[i] *= ks[i];
    }
#pragma unroll
    for (int i = 0; i < 32; ++i) { const int kk = 2 * i + (lane >> 5); scr[kk * 33 + (lane & 31)] = wv[i]; }
    asm volatile("s_waitcnt lgkmcnt(0)" ::: "memory");
    const int c = lane & 7;
#pragma unroll
    for (int j = 0; j < 4; ++j) { const int n = (lane >> 3) + 8 * j; const LAS float* s = scr + (8 * c) * 33 + n;
        v4u o; o.x = cvt_pk_bf16(s[0 * 33], s[1 * 33]); o.y = cvt_pk_bf16(s[2 * 33], s[3 * 33]); o.z = cvt_pk_bf16(s[4 * 33], s[5 * 33]); o.w = cvt_pk_bf16(s[6 * 33], s[7 * 33]);
        *(v4u*)(dst + (size_t)n * dpitch + 8 * c) = o; }
    asm volatile("s_waitcnt lgkmcnt(0)" ::: "memory");
}

struct Args {
    const float *xp, *xs, *norm1_g, *w_in, *q_norm_g, *k_norm_g, *attn_sink, *conv_dw_w, *conv_dw_b, *conv_ln_g, *conv_ln_b, *w_out, *norm2_g, *w_gate, *w_up, *ffn_dw_w, *ffn_dw_b, *w_down;
    float* out; unsigned char* ws; int ph_lo, ph_hi;
};

__device__ __forceinline__ void phase0(const Args& A, LAS unsigned char* lds, int gw, int NGW, int wave, int lane, int part) {
    unsigned char* ws = A.ws;
    LAS float* scr = (LAS float*)(lds + wave * 16384);
    constexpr int I_IN = 16 * 56, I_O = 16 * 32, I_G = 16 * 88, I_D = 44 * 32;
    constexpr int NITEMS = I_IN + I_O + 2 * I_G + I_D;
    const int it_lo = part ? I_IN : 0, it_hi = part ? NITEMS : I_IN;
    for (int it = it_lo + gw; it < it_hi; it += NGW) {
        int r = it;
        if (r < I_IN) {
            const int kb = r / 56, nb = r % 56, n0 = 32 * nb; int drow;
            if (n0 < 768) { const int pn = n0 >> 8, wc = (n0 >> 6) & 3, bj = (n0 >> 5) & 1; drow = 256 * pn + 128 * bj + 32 * wc; }
            else if (n0 < 1280) { const int ch = n0 - 768; drow = 256 * (3 + (ch >> 7)) + (ch & 127); }
            else { const int ch = n0 - 1280; drow = 256 * (3 + (ch >> 7)) + 128 + (ch & 127); }
            transpose_item(A.w_in, 1792, 64 * kb, n0, (bf16*)(ws + WS_WIN) + (size_t)drow * 1024 + 64 * kb, 1024, nullptr, scr, lane); continue; }
        r -= I_IN;
        if (r < I_O) { const int kb = r / 32, nb = r % 32; transpose_item(A.w_out, 1024, 64 * kb, 32 * nb, (bf16*)(ws + WS_WO) + (size_t)(32 * nb) * 1024 + 64 * kb, 1024, nullptr, scr, lane); continue; }
        r -= I_O;
        if (r < 2 * I_G) { const int up = r >= I_G; if (up) r -= I_G; const int kb = r / 88, nb = r % 88, ch = 32 * nb; const int drow = 256 * (ch >> 7) + 128 * up + (ch & 127);
            transpose_item(up ? A.w_up : A.w_gate, DFF, 64 * kb, ch, (bf16*)((unsigned char*)A.out + DO_WGU) + (size_t)drow * 1024 + 64 * kb, 1024, A.norm2_g, scr, lane); continue; }
        r -= 2 * I_G;
        { const int kb = r / 32, nb = r % 32, k0 = 64 * kb;
          transpose_item(A.w_down, 1024, k0, 32 * nb, (bf16*)(ws + WS_WD) + (size_t)(32 * nb) * DFF + k0, DFF, nullptr, scr, lane); }
    }
    if (part) return;
    f32x4 g[4];
#pragma unroll
    for (int j = 0; j < 4; ++j) g[j] = ((const f32x4*)A.norm1_g)[lane + 64 * j];
    bf16* H = (bf16*)(ws + WS_H);
    for (int m = gw; m < M_TOK; m += NGW) {
        const float* xrow = (m < M_PROMPT) ? A.xp + (size_t)m * DM : A.xs + (size_t)(m - M_PROMPT) * DM;
        f32x4 v[4]; float s = 0.f;
#pragma unroll
        for (int j = 0; j < 4; ++j) { v[j] = ((const f32x4*)xrow)[lane + 64 * j]; s += (v[j][0] * v[j][0] + v[j][1] * v[j][1]) + (v[j][2] * v[j][2] + v[j][3] * v[j][3]); }
        const float rs = __builtin_amdgcn_rsqf(wave_sum(s) * (1.0f / DM) + 1e-6f);
        uint2* o8 = (uint2*)(H + (size_t)m * DM) + lane;
#pragma unroll
        for (int j = 0; j < 4; ++j) { const f32x4 y = v[j] * rs * g[j]; uint2 w; w.x = cvt_pk_bf16(y[0], y[1]); w.y = cvt_pk_bf16(y[2], y[3]); o8[64 * j] = w; }
    }
}

constexpr int KP = 144, VP = 776;
constexpr int LDS_KOFF = 0, LDS_VOFF = 384 * KP;
__device__ __forceinline__ void attn_item(const Args& A, LAS unsigned char* lds, int item, int tid, int wave, int lane, float bound) {
    const bf16* Q = (const bf16*)(A.ws + WS_Q); const bf16* Kg = (const bf16*)(A.ws + WS_K); const bf16* VT = (const bf16*)(A.ws + WS_VT); bf16* MIX = (bf16*)(A.ws + WS_H);
    const int blk = item >> 1, kvh = item & 1, q0 = blk * 128, band0 = q0 - 128;
    int s0, s1; seq_bounds(q0, s0, s1);
    const int vlo = (q0 == s0) ? 128 : 0, vhi = (q0 + 128 == s1) ? 256 : 384;
    const int hl = wave >> 1, head = kvh * 4 + hl, r = lane & 31, h = lane >> 5;
    const float sink = A.attn_sink[head];
    bf16x8 qf0[4];
    { const bf16* qrow = Q + (size_t)(band0 + 128 + 64 * (wave & 1) + r) * 512 + head * 64 + 8 * h;
#pragma unroll
      for (int kk = 0; kk < 4; ++kk) qf0[kk] = *(const bf16x8*)(qrow + 16 * kk); }
    {
        v4u kreg[6], vreg[6];
#pragma unroll
        for (int q = 0; q < 6; ++q) { const int c = tid + NTHR * q, i = c >> 3, part = c & 7, ic = min(max(i, vlo), vhi - 1);
            kreg[q] = *(const v4u*)(Kg + (size_t)(band0 + ic) * 128 + kvh * 64 + part * 8); }
#pragma unroll
        for (int q = 0; q < 6; ++q) { const int c = tid + NTHR * q, d = c / 48, part = c % 48, ic = min(max(part * 8, vlo), vhi - 8);
            vreg[q] = *(const v4u*)(VT + (size_t)(kvh * 64 + d) * M_TOK + band0 + ic); }
#pragma unroll
        for (int q = 0; q < 6; ++q) { const int c = tid + NTHR * q, i = c >> 3, part = c & 7; *(LAS v4u*)(lds + LDS_KOFF + i * KP + part * 16) = kreg[q]; }
#pragma unroll
        for (int q = 0; q < 6; ++q) { const int c = tid + NTHR * q, d = c / 48, part = c % 48;
            LAS v2u* p = (LAS v2u*)(lds + LDS_VOFF + d * VP + part * 16); p[0] = (v2u){vreg[q].x, vreg[q].y}; p[1] = (v2u){vreg[q].z, vreg[q].w}; }
    }
    __syncthreads();
    const float slope2 = LOG2E * __builtin_amdgcn_exp2f(-(float)(head + 1));
    const float m2 = LOG2E * fmaxf(bound, sink), sinkterm = __builtin_amdgcn_exp2f(LOG2E * sink - m2);
#pragma unroll 1
    for (int qs = 0; qs < 2; ++qs) {
        const int qt = 128 + 64 * (wave & 1) + 32 * qs;
        const bf16* qrow = Q + (size_t)(band0 + qt + r) * 512 + head * 64 + 8 * h;
        bf16x8 qf[4];
        if (qs == 0) {
#pragma unroll
            for (int kk = 0; kk < 4; ++kk) qf[kk] = qf0[kk];
        } else {
#pragma unroll
            for (int kk = 0; kk < 4; ++kk) qf[kk] = *(const bf16x8*)(qrow + 16 * kk);
        }
        f32x16 O0, O1, OS, NEG;
#pragma unroll
        for (int i = 0; i < 16; ++i) { O0[i] = 0.f; O1[i] = 0.f; OS[i] = 0.f; NEG[i] = -m2; }
        const bf16x8 ones = {(short)0x3f80, (short)0x3f80, (short)0x3f80, (short)0x3f80, (short)0x3f80, (short)0x3f80, (short)0x3f80, (short)0x3f80};
        const int kb_lo = max(qt - 128, vlo), kb_hi = min(qt + 160, vhi);
#pragma unroll 2
        for (int kb = kb_lo; kb < kb_hi; kb += 32) {
            f32x16 S;
            const LAS unsigned char* kp = lds + LDS_KOFF + (kb + r) * KP + h * 16;
#pragma unroll
            for (int kk = 0; kk < 4; ++kk) { const bf16x8 kf = *(const LAS bf16x8*)(kp + kk * 32); S = __builtin_amdgcn_mfma_f32_32x32x16_bf16(kf, qf[kk], kk ? S : NEG, 0, 0, 0); }
            const float dbase = (float)(qt + r - kb - 4 * h);
            float p[16];
            if (kb == qt - 128 || kb == qt + 128) {
#pragma unroll
                for (int i = 0; i < 16; ++i) {
                    const float d = dbase - (float)((i & 3) + 8 * (i >> 2));
                    const float e = __builtin_amdgcn_exp2f(S[i] - slope2 * fabsf(d));
                    p[i] = (fabsf(d) <= 128.0f) ? e : 0.f;
                }
            } else {
#pragma unroll
                for (int i = 0; i < 16; ++i) {
                    const float d = dbase - (float)((i & 3) + 8 * (i >> 2));
                    p[i] = __builtin_amdgcn_exp2f(S[i] - slope2 * fabsf(d));
                }
            }
#pragma unroll
            for (int s = 0; s < 2; ++s) {
                v4u pk; pk.x = cvt_pk_bf16(p[8 * s], p[8 * s + 1]); pk.y = cvt_pk_bf16(p[8 * s + 2], p[8 * s + 3]); pk.z = cvt_pk_bf16(p[8 * s + 4], p[8 * s + 5]); pk.w = cvt_pk_bf16(p[8 * s + 6], p[8 * s + 7]);
                const bf16x8 ps = __builtin_bit_cast(bf16x8, pk);
                OS = __builtin_amdgcn_mfma_f32_32x32x16_bf16(ones, ps, OS, 0, 0, 0);
                const LAS unsigned char* vp = lds + LDS_VOFF + r * VP + (kb + 16 * s + 4 * h) * 2;
                { const s16x4 lo = *(const LAS s16x4*)(vp), hi = *(const LAS s16x4*)(vp + 16);
                  const bf16x8 vf = __builtin_shufflevector(lo, hi, 0, 1, 2, 3, 4, 5, 6, 7); O0 = __builtin_amdgcn_mfma_f32_32x32x16_bf16(vf, ps, O0, 0, 0, 0); }
                { const s16x4 lo = *(const LAS s16x4*)(vp + 32 * VP), hi = *(const LAS s16x4*)(vp + 32 * VP + 16);
                  const bf16x8 vf = __builtin_shufflevector(lo, hi, 0, 1, 2, 3, 4, 5, 6, 7); O1 = __builtin_amdgcn_mfma_f32_32x32x16_bf16(vf, ps, O1, 0, 0, 0); }
            }
        }
        const float l = OS[0];
        const float inv = 1.0f / (l + sinkterm);
        bf16* orow = MIX + (size_t)(band0 + qt + r) * DM + head * 64 + 4 * h;
#pragma unroll
        for (int g = 0; g < 4; ++g) {
            uint2 w; w.x = cvt_pk_bf16(O0[4 * g] * inv, O0[4 * g + 1] * inv); w.y = cvt_pk_bf16(O0[4 * g + 2] * inv, O0[4 * g + 3] * inv); *(uint2*)(orow + 8 * g) = w;
            uint2 x; x.x = cvt_pk_bf16(O1[4 * g] * inv, O1[4 * g + 1] * inv); x.y = cvt_pk_bf16(O1[4 * g + 2] * inv, O1[4 * g + 3] * inv); *(uint2*)(orow + 32 + 8 * g) = x;
        }
    }
    __syncthreads();
}

constexpr int LDS_ST = 96 * 1024;
typedef float f32x2 __attribute__((ext_vector_type(2)));
__device__ __forceinline__ void conv_item(const Args& A, LAS unsigned char* lds, int item, int tid, int wave, int lane, const f32x2 (&w)[31], f32x2 bias, f32x2 lg, f32x2 lb) {
    const bf16* U = (const bf16*)(A.ws + WS_U); bf16* MIX = (bf16*)(A.ws + WS_H);
    const int t0 = item * 64; int s0, s1; seq_bounds(t0, s0, s1);
    for (int i = wave; i < 94; i += NWAVES) {
        const int tok = t0 - 15 + i;
        if (tok >= s0 && tok < s1) __builtin_amdgcn_global_load_lds((const unsigned*)(U + (size_t)tok * 512 + lane * 8), (LAS unsigned*)(lds + i * 1024), 16, 0, 0);
        else *(LAS v4u*)(lds + i * 1024 + lane * 16) = (v4u){0u, 0u, 0u, 0u};
    }
    const int cp = tid & 255, tgb = tid >> 8;
    asm volatile("s_waitcnt vmcnt(0)" ::: "memory");
    __syncthreads();
    LAS float* ST = (LAS float*)(lds + LDS_ST);
#pragma unroll 1
    for (int it = 0; it < 4; ++it) {
        const int tg = tgb + 2 * it;
        f32x2 res[8];
#pragma unroll
        for (int t = 0; t < 8; ++t) res[t] = bias;
        const LAS unsigned* xp = (const LAS unsigned*)(lds + (8 * tg) * 1024 + cp * 4);
        unsigned xr[2][8];
#pragma unroll
        for (int q = 0; q < 8; ++q) xr[0][q] = xp[q * 256];
#pragma unroll
        for (int c8 = 0; c8 < 5; ++c8) {
            if (c8 < 4) {
#pragma unroll
                for (int q = 0; q < 8; ++q) { const int ii = 8 * (c8 + 1) + q; if (ii < 38) xr[(c8 + 1) & 1][q] = xp[ii * 256]; }
            }
            __builtin_amdgcn_sched_barrier(0);
#pragma unroll
            for (int q = 0; q < 8; ++q) { const int ii = 8 * c8 + q; if (ii < 38) {
                const unsigned xv = xr[c8 & 1][q];
                const f32x2 x2 = {__uint_as_float(xv << 16), __uint_as_float(xv & 0xffff0000u)};
#pragma unroll
                for (int t = 0; t < 8; ++t) { const int j = ii - t; if (j >= 0 && j <= 30) res[t] += w[j] * x2; } } }
            __builtin_amdgcn_sched_barrier(0);
        }
        float v[16];
#pragma unroll
        for (int t = 0; t < 8; ++t) { v[2 * t] = res[t].x + res[t].y; v[2 * t + 1] = res[t].x * res[t].x + res[t].y * res[t].y; }
#pragma unroll
        for (int i = 0; i < 8; ++i) { const bool up = lane & 32; const float send = up ? v[i] : v[i + 8], keep = up ? v[i + 8] : v[i]; v[i] = keep + __shfl_xor(send, 32); }
#pragma unroll
        for (int i = 0; i < 4; ++i) { const bool up = lane & 16; const float send = up ? v[i] : v[i + 4], keep = up ? v[i + 4] : v[i]; v[i] = keep + __shfl_xor(send, 16); }
#pragma unroll
        for (int i = 0; i < 2; ++i) { const bool up = lane & 8; const float send = up ? v[i] : v[i + 2], keep = up ? v[i + 2] : v[i]; v[i] = keep + __shfl_xor(send, 8); }
        { const bool up = lane & 4; const float send = up ? v[0] : v[1], keep = up ? v[1] : v[0]; v[0] = keep + __shfl_xor(send, 4); }
        v[0] += __shfl_xor(v[0], 2); v[0] += __shfl_xor(v[0], 1);
        if ((lane & 3) == 0) { const int idx = ((lane >> 5) & 1) * 8 + ((lane >> 4) & 1) * 4 + ((lane >> 3) & 1) * 2 + ((lane >> 2) & 1);
            ST[((8 * tg + (idx >> 1)) * 4 + (wave & 3)) * 2 + (idx & 1)] = v[0]; }
        __syncthreads();
#pragma unroll
        for (int t = 0; t < 8; ++t) {
            const LAS f32x4* sp = (const LAS f32x4*)(ST + (8 * tg + t) * 8); const f32x4 a = sp[0], b = sp[1];
            const float mean = ((a[0] + a[2]) + (b[0] + b[2])) * (1.0f / 512.0f), ex2 = ((a[1] + a[3]) + (b[1] + b[3])) * (1.0f / 512.0f);
            const float rstd = __builtin_amdgcn_rsqf(fmaxf(ex2 - mean * mean, 0.f) + 1e-5f);
            const f32x2 y = (res[t] - mean) * rstd * lg + lb;
            *(unsigned*)(MIX + (size_t)(t0 + 8 * tg + t) * DM + 512 + 2 * cp) = cvt_pk_bf16(fast_silu(y.x), fast_silu(y.y));
        }
    }
    __syncthreads();
}

__device__ __forceinline__ void fix_edges(const Args& A, int gtid, int gthreads) {
    constexpr int ncols = DFF;
    const float* __restrict__ ge = (const float*)((unsigned char*)A.out + DO_GE); const float* __restrict__ ue = (const float*)((unsigned char*)A.out + DO_UE); bf16* __restrict__ act = (bf16*)(A.ws + WS_ACT);
    const int ng = ncols >> 2, total = 128 * 2 * ng;
    constexpr int NB_ = 2;
    for (int idx0 = gtid; idx0 < total; idx0 += NB_ * gthreads) {
        f32x4 pv[NB_], cur[NB_], nx[NB_], up[NB_], w0[NB_], w1[NB_], w2[NB_], bb[NB_]; int row[NB_], col[NB_]; bool ok[NB_];
        const f32x4 zero = {0.f, 0.f, 0.f, 0.f};
#pragma unroll
        for (int q = 0; q < NB_; ++q) {
            const int idx = idx0 + q * gthreads; ok[q] = idx < total; const int id = ok[q] ? idx : gtid;
            const int cg4 = id % ng, rw = id / ng, which = rw & 1, chunk = rw >> 1; col[q] = 4 * cg4;
            row[q] = 256 * chunk + (which ? 255 : 0); int s0, s1; seq_bounds(row[q], s0, s1);
            const float* gc = ge + (size_t)chunk * 4 * ncols + col[q];
            if (which == 0) { pv[q] = (row[q] == s0) ? zero : *(const f32x4*)(gc - ncols); cur[q] = *(const f32x4*)(gc); nx[q] = *(const f32x4*)(gc + ncols); up[q] = *(const f32x4*)(ue + ((size_t)chunk * 2) * ncols + col[q]); }
            else { pv[q] = *(const f32x4*)(gc + 2 * ncols); cur[q] = *(const f32x4*)(gc + 3 * ncols); nx[q] = (row[q] + 1 == s1) ? zero : *(const f32x4*)(gc + 4 * ncols); up[q] = *(const f32x4*)(ue + ((size_t)chunk * 2 + 1) * ncols + col[q]); }
            w0[q] = *(const f32x4*)(A.ffn_dw_w + col[q]); w1[q] = *(const f32x4*)(A.ffn_dw_w + DFF + col[q]); w2[q] = *(const f32x4*)(A.ffn_dw_w + 2 * DFF + col[q]); bb[q] = *(const f32x4*)(A.ffn_dw_b + col[q]);
        }
#pragma unroll
        for (int q = 0; q < NB_; ++q) {
            float o[4];
#pragma unroll
            for (int j = 0; j < 4; ++j) { const float cv = bb[q][j] + w0[q][j] * pv[q][j] + w1[q][j] * cur[q][j] + w2[q][j] * nx[q][j]; o[j] = fast_silu(cv) * up[q][j]; }
            uint2 w; w.x = cvt_pk_bf16(o[0], o[1]); w.y = cvt_pk_bf16(o[2], o[3]);
            if (ok[q]) *(uint2*)(act + (size_t)row[q] * ncols + col[q]) = w;
        }
    }
}

#define XB_TMO      128
#define XB_XCNT(j)  (256  + 64 * (j))
#define XB_XSUB(j)  (1280 + 64 * (j))
#define XB_XGEN(j)  (2304 + 64 * (j))
#define XB_TOP      3328
#define XB_TOPGEN   3392
#define XCD_BAR_WORDS 3456
#define XB_SPIN_CAP (1u << 18)

__device__ __forceinline__ unsigned xb_ld(unsigned* p)              { return __hip_atomic_load(p, __ATOMIC_RELAXED, __HIP_MEMORY_SCOPE_AGENT); }
__device__ __forceinline__ unsigned xb_add(unsigned* p, unsigned v) { return __hip_atomic_fetch_add(p, v, __ATOMIC_RELAXED, __HIP_MEMORY_SCOPE_AGENT); }
__device__ __forceinline__ unsigned xb_xcc_id() { return (unsigned)__builtin_amdgcn_s_getreg((3 << 11) | 20) & 0xFu; }
#define XB_SPIN(cond, bar) do { unsigned _sp = 0; while (cond) { __builtin_amdgcn_s_sleep(1); \
    if ((++_sp & 255u) == 0u) { if (xb_ld(&(bar)[XB_TMO])) break; if (_sp > XB_SPIN_CAP) { atomicAdd(&(bar)[XB_TMO], 1u); break; } } } } while (0)

struct XcdBarrier {
    unsigned* bar; unsigned x;
    volatile LAS unsigned* st;
};

__device__ __forceinline__ XcdBarrier xcd_barrier_post(unsigned* bar, volatile LAS unsigned* st) {
    XcdBarrier b; b.bar = bar; b.x = xb_xcc_id(); b.st = st;
    if (threadIdx.x == 0) (void)xb_add(&bar[XB_XCNT(b.x)], 1u);
    return b;
}
__device__ __forceinline__ void xcd_barrier_complete(unsigned* bar, unsigned x, unsigned& nloc, unsigned& nx) {
    const unsigned G = gridDim.x * gridDim.y * gridDim.z;
    unsigned sum, cnt, mine, sp = 0u;
    for (;;) {
        sum = 0u; cnt = 0u; mine = 0u;
#pragma unroll
        for (unsigned j = 0; j < 16; ++j) { const unsigned c = xb_ld(&bar[XB_XCNT(j)]); sum += c; cnt += (c > 0u) ? 1u : 0u; mine = (j == x) ? c : mine; }
        if (sum == G) break;
        __builtin_amdgcn_s_sleep(1);
        if ((++sp & 255u) == 0u) { if (xb_ld(&bar[XB_TMO])) break; if (sp > XB_SPIN_CAP) { atomicAdd(&bar[XB_TMO], 1u); break; } }
    }
    nloc = mine > 0u ? mine : 1u; nx = cnt > 0u ? cnt : 1u;
}

__device__ __forceinline__ void xcd_barrier(const XcdBarrier& b) {
    asm volatile("s_waitcnt vmcnt(0)" ::: "memory");
    __syncthreads();
    if (threadIdx.x == 0) {
        unsigned* bar = b.bar;
        __builtin_amdgcn_s_waitcnt(0);
        unsigned nloc = b.st[0], nx = b.st[1];
        if (nloc == 0u) { xcd_barrier_complete(bar, b.x, nloc, nx); b.st[0] = nloc; b.st[1] = nx; }
        const unsigned old = xb_add(&bar[XB_XSUB(b.x)], 1u);
        const unsigned gen = old / nloc;
        if (old + 1u == (gen + 1u) * nloc) {
            __builtin_amdgcn_fence(__ATOMIC_RELEASE, "agent");
            asm volatile("s_waitcnt vmcnt(0)" ::: "memory");
            const unsigned og = xb_add(&bar[XB_TOP], 1u);
            const unsigned tg = og / nx;
            if (og + 1u == (tg + 1u) * nx) xb_add(&bar[XB_TOPGEN], 1u);
            else XB_SPIN(xb_ld(&bar[XB_TOPGEN]) == tg, bar);
            __builtin_amdgcn_fence(__ATOMIC_ACQUIRE, "agent");
            xb_add(&bar[XB_XGEN(b.x)], 1u);
            asm volatile("s_waitcnt vmcnt(0)" ::: "memory");
        } else {
            XB_SPIN(xb_ld(&bar[XB_XGEN(b.x)]) == gen, bar);
            __builtin_amdgcn_fence(__ATOMIC_ACQUIRE, "agent");
            asm volatile("s_waitcnt vmcnt(0)" ::: "memory");
        }
    }
    __syncthreads();
}
__device__ __forceinline__ void skew_delay(int group, int ticks_per_group) {
    const unsigned long long t0 = __builtin_amdgcn_s_memrealtime(); const unsigned long long d = (unsigned long long)(group * ticks_per_group);
    while (__builtin_amdgcn_s_memrealtime() - t0 < d) __builtin_amdgcn_s_sleep(8);
}
#ifndef SKEW3
#define SKEW3 0
#endif
#ifndef SKEW5
#define SKEW5 0
#endif
__global__ void __launch_bounds__(NTHR, 2) hymba_fwd(Args A) {
    extern __shared__ __attribute__((aligned(16))) unsigned char lds_raw[];
    LAS unsigned char* lds = (LAS unsigned char*)lds_raw;
    cg::grid_group grid = cg::this_grid();
    const int tid = threadIdx.x, lane = tid & 63, wave = __builtin_amdgcn_readfirstlane(tid >> 6);
    const int G = gridDim.x, bx = blockIdx.x;
    const int gw = bx * NWAVES + wave, NGW = G * NWAVES;
    unsigned char* ws = A.ws; unsigned char* dob = (unsigned char*)A.out;
    const int lo = A.ph_lo, hi = A.ph_hi;
    volatile LAS unsigned* xb_st = (volatile LAS unsigned*)(lds + 131072 + 8192);
    if (tid < 4) xb_st[tid] = 0u;
    __syncthreads();
    const XcdBarrier xbar = xcd_barrier_post((unsigned*)(ws + WS_BAR), xb_st);
    if (lo > 1000) grid.sync();
#ifndef PMASK
#define PMASK 0x7f
#endif
#define IN(k) (((PMASK >> (k)) & 1) && lo <= (k) && (k) < hi)
#ifndef REPMASK
#define REPMASK 0
#endif
#ifndef XSYNC
#define XSYNC 0
#endif
#define REPS(k) (((REPMASK >> (k)) & 1) ? 2 : 1)
#define SEAM(k) do { if (IN(k) && IN((k) + 1)) { xcd_barrier(xbar); if ((k) == 0) for (int xs_ = 0; xs_ < XSYNC; ++xs_) xcd_barrier(xbar); } } while (0)
    if (IN(0)) for (int rep = 0; rep < REPS(0); ++rep) phase0(A, lds, gw, NGW, wave, lane, 0);
    SEAM(0);
    if (IN(1)) {
        pg8::Gemm g{(const pg8::bf16_t*)(ws + WS_H), (const pg8::bf16_t*)(ws + WS_WIN), M_TOK, 1792, 1024}; pg8::StaticOrder S; S.init(M_TOK, 1792, G, bx); S.rep = REPS(1);
        pg8::EpiInProj E{(pg8::bf16_t*)(ws + WS_Q), (pg8::bf16_t*)(ws + WS_K), (pg8::bf16_t*)(ws + WS_VT), (pg8::bf16_t*)(ws + WS_U), A.q_norm_g, A.k_norm_g};
        pg8::gemm_phase<pg8::EpiInProj, pg8::StaticOrder, true, true>(lds, g, S, E);
        { const int nfull = (896 % G) ? (896 % G) : G;
          if (nfull < G) { if (bx >= nfull) phase0(A, lds, (bx - nfull) * NWAVES + wave, (G - nfull) * NWAVES, wave, lane, 1); }
          else phase0(A, lds, gw, NGW, wave, lane, 1); }
    }
    float bound = 0.f;
    if (IN(2)) { const float gqm = wave_max(fabsf(A.q_norm_g[lane])), gkm = wave_max(fabsf(A.k_norm_g[lane])); bound = 8.0f * gqm * gkm; }
    SEAM(1);
    if (IN(2)) {
#ifndef NO_ATTN
        for (int it = bx; it < 512 * REPS(2); it += G) attn_item(A, lds, it & 511, tid, wave, lane, bound);
#endif
#ifndef NO_CONV
        {
            const int cp = tid & 255;
            f32x2 w[31];
#pragma unroll
            for (int j = 0; j < 31; ++j) { const float2 t = *(const float2*)(A.conv_dw_w + j * 512 + 2 * cp); w[j] = (f32x2){t.x, t.y}; }
            const float2 b_ = *(const float2*)(A.conv_dw_b + 2 * cp), g_ = *(const float2*)(A.conv_ln_g + 2 * cp), l_ = *(const float2*)(A.conv_ln_b + 2 * cp);
            const f32x2 bias = {b_.x, b_.y}, lg = {g_.x, g_.y}, lb = {l_.x, l_.y};
#pragma unroll 1
            for (int it = bx; it < 512 * REPS(7); it += G) conv_item(A, lds, it & 511, tid, wave, lane, w, bias, lg, lb);
        }
#endif
    }
    SEAM(2);
    if (IN(3)) {
        pg8::Gemm g{(const pg8::bf16_t*)(ws + WS_H), (const pg8::bf16_t*)(ws + WS_WO), M_TOK, 1024, 1024}; pg8::StaticOrder S; S.init(M_TOK, 1024, G, bx); S.rep = REPS(3);
        if (SKEW3) skew_delay((bx >> 3) & 3, SKEW3);
        pg8::EpiOutProj E{A.xp, A.xs, nullptr, (pg8::bf16_t*)(ws + WS_DELTA), (float*)(ws + WS_SSQ), (LAS float*)(lds + 131072)};
        pg8::gemm_phase<pg8::EpiOutProj, pg8::StaticOrder, true, true>(lds, g, S, E);
    }
    SEAM(3);
    if (IN(4)) {
        pg8::Gemm g{(const pg8::bf16_t*)(ws + WS_DELTA), (const pg8::bf16_t*)(dob + DO_WGU), M_TOK, 2 * DFF, 1024}; pg8::StaticOrder S; S.init(M_TOK, 2 * DFF, G, bx); S.rep = REPS(4);
        pg8::EpiGateUp E{(pg8::bf16_t*)(ws + WS_ACT), (float*)(dob + DO_GE), (float*)(dob + DO_UE), (const float*)(ws + WS_SSQ), A.ffn_dw_w, A.ffn_dw_b, (LAS float*)(lds + 131072)};
        pg8::gemm_phase<pg8::EpiGateUp, pg8::StaticOrder, true, true>(lds, g, S, E);
    }
    SEAM(4);
    if (IN(5)) for (int rep = 0; rep < REPS(5); ++rep) fix_edges(A, bx * NTHR + tid, G * NTHR);
    SEAM(5);
    if (IN(6)) {
        pg8::Gemm g{(const pg8::bf16_t*)(ws + WS_ACT), (const pg8::bf16_t*)(ws + WS_WD), M_TOK, 1024, DFF}; pg8::StaticOrder S; S.init(M_TOK, 1024, G, bx); S.rep = REPS(6);
        pg8::EpiDown E{A.xp, A.xs, (const pg8::bf16_t*)(ws + WS_DELTA), A.out};
        if (SKEW5) skew_delay((bx >> 3) & 3, SKEW5);
        pg8::gemm_phase<pg8::EpiDown, pg8::StaticOrder, true, true>(lds, g, S, E);
    }
#undef IN
#undef SEAM
}

#ifndef N_LAUNCH_PER_PHASE
#define N_LAUNCH_PER_PHASE 0
#endif
extern "C" void kernel_launch(void* const* d_in, const int* in_sizes, int n_in, void* d_out, int out_size, void* d_ws, size_t ws_size, hipStream_t stream) {
    static int grid = 0;
    if (grid == 0) {
        if (n_in != 18 || out_size != M_TOK * DM || ws_size < WS_END) { fprintf(stderr, "kernel_launch: unexpected shapes (n_in %d out %d ws %zu)\n", n_in, out_size, ws_size); grid = -1; return; }
        int dev = 0, cus = 0, per_cu = 0;
        hipGetDevice(&dev); hipDeviceGetAttribute(&cus, hipDeviceAttributeMultiprocessorCount, dev);
        if (hipFuncSetAttribute((const void*)hymba_fwd, hipFuncAttributeMaxDynamicSharedMemorySize, LDS_BYTES) != hipSuccess) { fprintf(stderr, "kernel_launch: hipFuncSetAttribute failed\n"); grid = -1; return; }
        if (hipOccupancyMaxActiveBlocksPerMultiprocessor(&per_cu, (const void*)hymba_fwd, NTHR, LDS_BYTES) != hipSuccess || per_cu < 1) { fprintf(stderr, "kernel_launch: occupancy query says %d\n", per_cu); per_cu = 1; }
        (void)hipGetLastError();
        grid = cus * 1;
    }
    if (grid < 0) return;
    if (hipMemsetAsync((char*)d_ws + WS_BAR, 0, BAR_BYTES, stream) != hipSuccess) { fprintf(stderr, "kernel_launch: memset failed\n"); return; }
    Args a{};
    const float** slots = (const float**)&a;
    for (int i = 0; i < 18; ++i) slots[i] = (const float*)d_in[i];
    a.out = (float*)d_out; a.ws = (unsigned char*)d_ws;
#if N_LAUNCH_PER_PHASE
    for (int p = 0; p < 7; ++p) { a.ph_lo = p; a.ph_hi = p + 1; hipLaunchKernelGGL(hymba_fwd, dim3(grid), dim3(NTHR), LDS_BYTES, stream, a); }
#else
    a.ph_lo = 0; a.ph_hi = 7;
    void* args[] = {&a};
    hipError_t e = hipLaunchCooperativeKernel((const void*)hymba_fwd, dim3(grid), dim3(NTHR), args, LDS_BYTES, stream);
    if (e != hipSuccess) fprintf(stderr, "cooperative launch failed: %s (grid %d)\n", hipGetErrorString(e), grid);
#endif
}
```
